# Optimizing an MI355X kernel written in HIP

```python
import jax, jax.numpy as jnp
from jax import lax
import numpy as np

D_MODEL = 1024
BATCH = 2
SEQ = 8192
DEPTH = 4
DEC_BATCH = 128
DEC_SEQ = 1
PAST_LEN = 8192
PAGE_SIZE = 128

HEAD_DIM = 64
N_HEADS = 8
N_KV_HEADS = 2
GQA_GROUP = N_HEADS // N_KV_HEADS
WINDOW = 128
D_ATTN = N_HEADS * HEAD_DIM
D_KV = N_KV_HEADS * HEAD_DIM
D_LRU = 256
N_LRU_BLOCKS = 4
LRU_BLOCK = D_LRU // N_LRU_BLOCKS
LRU_CONV = 4
LRU_C = 8.0
D_SC = 256
SC_CONV = 3
D_MIX = D_ATTN + D_LRU + D_SC
D_IN = D_ATTN + 2 * D_KV + 2 * D_LRU + 3 * D_SC
D_FF = 2816
FFN_CONV = 3
EPS = 1e-6

kernel_name = "hymba_style_swa_rglru_shortconv_decoder_step"


def rmsnorm(x, g):
    xf = x.astype(jnp.float32)
    y = xf * lax.rsqrt(jnp.mean(xf * xf, axis=-1, keepdims=True) + EPS)
    return (y * g.astype(jnp.float32)).astype(x.dtype)


def causal_conv(buf, u, w):
    T = u.shape[1]
    K = w.shape[0]
    xp = jnp.concatenate([buf, u], axis=1)
    y = xp[:, 0:T] * w[0]
    for k in range(1, K):
        y = y + xp[:, k:k + T] * w[k]
    return y, xp[:, T:]


def sink_softmax(s, sink):
    m = jnp.maximum(jnp.max(s, axis=-1, keepdims=True), sink)
    p = jnp.exp(s - m)
    return p / (jnp.sum(p, axis=-1, keepdims=True) + jnp.exp(sink - m))


def attn_prompt(q, k, v, sinks):
    B, T, _ = q.shape
    nb = T // WINDOW
    qb = q.reshape(B, nb, WINDOW, N_KV_HEADS, GQA_GROUP, HEAD_DIM)
    kb = k.reshape(B, nb, WINDOW, N_KV_HEADS, HEAD_DIM)
    vb = v.reshape(B, nb, WINDOW, N_KV_HEADS, HEAD_DIM)
    pad = ((0, 0), (1, 0), (0, 0), (0, 0), (0, 0))
    kk = jnp.concatenate([jnp.pad(kb, pad)[:, :-1], kb], axis=2)
    vv = jnp.concatenate([jnp.pad(vb, pad)[:, :-1], vb], axis=2)
    s = jnp.einsum('bnqkgd,bnskd->bnkgqs', qb, kk).astype(jnp.float32) * (HEAD_DIM ** -0.5)
    qi = jnp.arange(WINDOW)[:, None] + WINDOW
    kj = jnp.arange(2 * WINDOW)[None, :]
    diff = qi - kj
    band = (diff >= 0) & (diff <= WINDOW)
    first = (jnp.arange(nb)[:, None, None] == 0) & (kj[None] < WINDOW)
    mask = band[None] & ~first
    s = jnp.where(mask[None, :, None, None], s, -jnp.inf)
    sink = sinks.reshape(N_KV_HEADS, GQA_GROUP)[:, :, None, None].astype(jnp.float32)
    p = sink_softmax(s, sink).astype(v.dtype)
    o = jnp.einsum('bnkgqs,bnskd->bnqkgd', p, vv).reshape(B, T, D_ATTN)
    k_new = k[:, -WINDOW:].reshape(B, WINDOW, N_KV_HEADS, HEAD_DIM)
    v_new = v[:, -WINDOW:].reshape(B, WINDOW, N_KV_HEADS, HEAD_DIM)
    return o, k_new, v_new


def attn_sample(q, k, v, cache_k, cache_v, sinks):
    B, T, _ = q.shape
    W = cache_k.shape[1]
    kk = jnp.concatenate([cache_k, k.reshape(B, T, N_KV_HEADS, HEAD_DIM)], axis=1)
    vv = jnp.concatenate([cache_v, v.reshape(B, T, N_KV_HEADS, HEAD_DIM)], axis=1)
    qg = q.reshape(B, T, N_KV_HEADS, GQA_GROUP, HEAD_DIM)
    s = jnp.einsum('btkgd,bskd->bkgts', qg, kk).astype(jnp.float32) * (HEAD_DIM ** -0.5)
    diff = (W + jnp.arange(T))[:, None] - jnp.arange(W + T)[None, :]
    mask = (diff >= 0) & (diff <= WINDOW)
    s = jnp.where(mask, s, -jnp.inf)
    sink = sinks.reshape(N_KV_HEADS, GQA_GROUP)[:, :, None, None].astype(jnp.float32)
    p = sink_softmax(s, sink).astype(v.dtype)
    o = jnp.einsum('bkgts,bskd->btkgd', p, vv).reshape(B, T, D_ATTN)
    return o, kk[:, -W:], vv[:, -W:]


def rglru(xc, h0, wa, ba, wi, bi, lam):
    B, T, _ = xc.shape
    xh = xc.reshape(B, T, N_LRU_BLOCKS, LRU_BLOCK)
    r = jax.nn.sigmoid(jnp.einsum('btnc,ncd->btnd', xh, wa).reshape(B, T, D_LRU) + ba)
    i = jax.nn.sigmoid(jnp.einsum('btnc,ncd->btnd', xh, wi).reshape(B, T, D_LRU) + bi)
    log_a = -LRU_C * r * jax.nn.softplus(-lam)
    a = jnp.exp(log_a)
    bx = jnp.sqrt(-jnp.expm1(2.0 * log_a)) * (i * xc)
    bx = bx.at[:, 0].add(a[:, 0] * h0)

    def combine(left, right):
        a1, b1 = left
        a2, b2 = right
        return a1 * a2, a2 * b1 + b2

    _, h = lax.associative_scan(combine, (a, bx), axis=1)
    return h, h[:, -1]


def decoder_layer(x, attn_cache, h0, lru_buf, sc_buf, ffn_buf,
                  g_mix, w_in, sinks, lru_conv_w, lru_conv_b, lru_wa, lru_ba, lru_wi, lru_bi,
                  lru_lambda, sc_conv_w, g_out, w_out, g_ffn, w_up, ffn_conv_w, w_down):
    h = rmsnorm(x, g_mix)
    z = h @ w_in
    cuts = np.cumsum([D_ATTN, D_KV, D_KV, D_LRU, D_LRU, D_SC, D_SC]).tolist()
    q, k, v, lru_x, lru_g, sc_b, sc_c, sc_u = jnp.split(z, cuts, axis=-1)
    if attn_cache is None:
        a_out, k_new, v_new = attn_prompt(q, k, v, sinks)
    else:
        a_out, k_new, v_new = attn_sample(q, k, v, attn_cache[0], attn_cache[1], sinks)
    xc, lru_buf_new = causal_conv(lru_buf, lru_x, lru_conv_w)
    hseq, h_last = rglru(xc + lru_conv_b, h0, lru_wa, lru_ba, lru_wi, lru_bi, lru_lambda)
    b_out = hseq * jax.nn.gelu(lru_g)
    sc_conv, sc_buf_new = causal_conv(sc_buf, sc_c * sc_u, sc_conv_w)
    c_out = sc_b * sc_conv
    merged = jnp.concatenate([
        rmsnorm(a_out, g_out[:D_ATTN]),
        rmsnorm(b_out, g_out[D_ATTN:D_ATTN + D_LRU]),
        rmsnorm(c_out, g_out[D_ATTN + D_LRU:])], axis=-1)
    x = x + merged @ w_out
    up = rmsnorm(x, g_ffn) @ w_up
    upc, ffn_buf_new = causal_conv(ffn_buf, up, ffn_conv_w)
    u, gt = jnp.split(upc, 2, axis=-1)
    x = x + (jax.nn.silu(gt) * u) @ w_down
    return x, (k_new, v_new, h_last, lru_buf_new, sc_buf_new, ffn_buf_new)


def setup_inputs(seed: int = 0) -> dict:
    key = jax.random.key(seed)
    ks = jax.random.split(key, 32)
    nrm = jax.random.normal
    f32 = jnp.float32
    win = min(WINDOW, PAST_LEN)
    u = jax.random.uniform(ks[20], (DEPTH, D_LRU), f32, 0.9, 0.999)
    s = u ** (1.0 / LRU_C)
    lam = jnp.log(s) - jnp.log1p(-s)
    return {
        "x_prompt": nrm(ks[0], (BATCH, SEQ, D_MODEL), f32),
        "x_sample": nrm(ks[1], (DEC_BATCH, DEC_SEQ, D_MODEL), f32),
        "cache_k": nrm(ks[2], (DEPTH, DEC_BATCH, win, N_KV_HEADS, HEAD_DIM), f32),
        "cache_v": nrm(ks[3], (DEPTH, DEC_BATCH, win, N_KV_HEADS, HEAD_DIM), f32),
        "state_rglru": 0.5 * nrm(ks[4], (DEPTH, DEC_BATCH, D_LRU), f32),
        "state_lru_conv": 0.5 * nrm(ks[5], (DEPTH, DEC_BATCH, LRU_CONV - 1, D_LRU), f32),
        "state_sconv": 0.5 * nrm(ks[6], (DEPTH, DEC_BATCH, SC_CONV - 1, D_SC), f32),
        "state_ffn_conv": 0.5 * nrm(ks[7], (DEPTH, DEC_BATCH, FFN_CONV - 1, 2 * D_FF), f32),
        "g_mix": 1.0 + 0.02 * nrm(ks[8], (DEPTH, D_MODEL), f32),
        "w_in": nrm(ks[9], (DEPTH, D_MODEL, D_IN), f32) * D_MODEL ** -0.5,
        "sinks": 0.5 * nrm(ks[10], (DEPTH, N_HEADS), f32),
        "lru_conv_w": nrm(ks[11], (DEPTH, LRU_CONV, D_LRU), f32) * LRU_CONV ** -0.5,
        "lru_conv_b": 0.01 * nrm(ks[12], (DEPTH, D_LRU), f32),
        "lru_wa": nrm(ks[13], (DEPTH, N_LRU_BLOCKS, LRU_BLOCK, LRU_BLOCK), f32) * LRU_BLOCK ** -0.5,
        "lru_ba": 0.01 * nrm(ks[14], (DEPTH, D_LRU), f32),
        "lru_wi": nrm(ks[15], (DEPTH, N_LRU_BLOCKS, LRU_BLOCK, LRU_BLOCK), f32) * LRU_BLOCK ** -0.5,
        "lru_bi": 0.01 * nrm(ks[16], (DEPTH, D_LRU), f32),
        "lru_lambda": lam,
        "sc_conv_w": nrm(ks[17], (DEPTH, SC_CONV, D_SC), f32) * SC_CONV ** -0.5,
        "g_out": 1.0 + 0.02 * nrm(ks[18], (DEPTH, D_MIX), f32),
        "w_out": nrm(ks[19], (DEPTH, D_MIX, D_MODEL), f32) * D_MIX ** -0.5,
        "g_ffn": 1.0 + 0.02 * nrm(ks[21], (DEPTH, D_MODEL), f32),
        "w_up": nrm(ks[22], (DEPTH, D_MODEL, 2 * D_FF), f32) * D_MODEL ** -0.5,
        "ffn_conv_w": nrm(ks[23], (DEPTH, FFN_CONV, 2 * D_FF), f32) * FFN_CONV ** -0.5,
        "w_down": nrm(ks[24], (DEPTH, D_FF, D_MODEL), f32) * D_FF ** -0.5,
        "g_final": 1.0 + 0.02 * nrm(ks[25], (D_MODEL,), f32),
    }


def _stack(states, i):
    return jnp.stack([s[i] for s in states])


def reference(x_prompt, x_sample, cache_k, cache_v, state_rglru, state_lru_conv, state_sconv,
              state_ffn_conv, g_mix, w_in, sinks, lru_conv_w, lru_conv_b, lru_wa, lru_ba,
              lru_wi, lru_bi, lru_lambda, sc_conv_w, g_out, w_out, g_ffn, w_up, ffn_conv_w,
              w_down, g_final):
    B = x_prompt.shape[0]
    dt = x_prompt.dtype
    h0_p = jnp.zeros((B, D_LRU), dt)
    lru_buf_p = jnp.zeros((B, LRU_CONV - 1, D_LRU), dt)
    sc_buf_p = jnp.zeros((B, SC_CONV - 1, D_SC), dt)
    ffn_buf_p = jnp.zeros((B, FFN_CONV - 1, 2 * D_FF), dt)
    xp, xs = x_prompt, x_sample
    p_states, s_states = [], []
    for l in range(DEPTH):
        lw = (g_mix[l], w_in[l], sinks[l], lru_conv_w[l], lru_conv_b[l], lru_wa[l], lru_ba[l],
              lru_wi[l], lru_bi[l], lru_lambda[l], sc_conv_w[l], g_out[l], w_out[l], g_ffn[l],
              w_up[l], ffn_conv_w[l], w_down[l])
        xp, sp = decoder_layer(xp, None, h0_p, lru_buf_p, sc_buf_p, ffn_buf_p, *lw)
        xs, ss = decoder_layer(xs, (cache_k[l], cache_v[l]), state_rglru[l], state_lru_conv[l],
                               state_sconv[l], state_ffn_conv[l], *lw)
        p_states.append(sp)
        s_states.append(ss)
    y_prompt = rmsnorm(xp, g_final)
    y_sample = rmsnorm(xs, g_final)
    new_cache_k_prompt = _stack(p_states, 0)
    new_cache_v_prompt = _stack(p_states, 1)
    new_state_rglru_prompt = _stack(p_states, 2)
    new_state_lru_conv_prompt = _stack(p_states, 3)
    new_state_sconv_prompt = _stack(p_states, 4)
    new_state_ffn_conv_prompt = _stack(p_states, 5)
    new_cache_k_sample = _stack(s_states, 0)
    new_cache_v_sample = _stack(s_states, 1)
    new_state_rglru_sample = _stack(s_states, 2)
    new_state_lru_conv_sample = _stack(s_states, 3)
    new_state_sconv_sample = _stack(s_states, 4)
    new_state_ffn_conv_sample = _stack(s_states, 5)
    return (y_prompt, y_sample,
            new_cache_k_prompt, new_cache_v_prompt, new_state_rglru_prompt,
            new_state_lru_conv_prompt, new_state_sconv_prompt, new_state_ffn_conv_prompt,
            new_cache_k_sample, new_cache_v_sample, new_state_rglru_sample,
            new_state_lru_conv_sample, new_state_sconv_sample, new_state_ffn_conv_sample)
```

```cpp
#include <hip/hip_runtime.h>
#include <hip/hip_cooperative_groups.h>
#include <cstdio>
#include <cstdint>
namespace cg = cooperative_groups;
namespace pg8 {
#define PG8_LAS __attribute__((address_space(3)))
typedef unsigned short bf16_t;
typedef short bf16x8 __attribute__((ext_vector_type(8)));
typedef float f32x4 __attribute__((ext_vector_type(4)));
typedef unsigned u32x4 __attribute__((ext_vector_type(4)));
constexpr int BM = 256, BK = 64, HALF = 128, HTB = HALF * BK * 2  , STAGE_BYTES = 8 * HTB, NXCD = 8, WGM = 8;

__host__ __device__ __forceinline__ int lds_byte(int r, int c) { const int st = (r >> 4) * 2 + (c >> 5), rr = r & 15, cc = c & 31, ob = rr * 64 + cc * 2; return st * 1024 + (ob ^ (((ob >> 9) & 1) << 5)); }
__host__ __device__ __forceinline__ void stage_rc(int b, int& R, int& C) { const int st = b / 1024, sb = b % 1024, swz = sb ^ (((sb >> 9) & 1) << 5); R = (st >> 1) * 16 + swz / 64; C = (st & 1) * 32 + (swz % 64) / 2; }
__host__ __device__ __forceinline__ int perm32(int rho) { const int n = rho >> 4, i = rho & 15; return 8 * (i >> 2) + 4 * n + (i & 3); }

struct Unit { int pm, pn; };
struct Gemm { const bf16_t* A; const bf16_t* Bt; int M, N, K; };

struct StaticOrder {
    int nM, nN, nwg, G, c;
    __host__ __device__ void init(int M, int N, int G_, int c_) { nM = M / BM; nN = N / BM; nwg = nM * nN; G = G_; c = c_; }
    __host__ __device__ bool next(int i, Unit& u) const {
        const long L = (long)i * G + c; if (L >= nwg) return false;
        int wgid = (int)L; { const int q = nwg / NXCD, r = nwg % NXCD, xcd = wgid % NXCD, off = wgid / NXCD; wgid = (xcd < r ? xcd * (q + 1) : r * (q + 1) + (xcd - r) * q) + off; }
        const int nig = WGM * nN, gid = wgid / nig, fm = gid * WGM, gsz = (nM - fm) < WGM ? (nM - fm) : WGM;
        u.pm = fm + ((wgid % nig) % gsz); u.pn = (wgid % nig) / gsz; return true;
    }
    __device__ __forceinline__ void a_ready(const Unit&) const {}
    __device__ __forceinline__ void done(const Unit&) const {}
};

__device__ __forceinline__ unsigned cvt_pk_bf16(float lo, float hi) { unsigned r; asm volatile("v_cvt_pk_bf16_f32 %0, %1, %2" : "=v"(r) : "v"(lo), "v"(hi)); return r; }
typedef float f32x2 __attribute__((ext_vector_type(2)));
__device__ __forceinline__ f32x2 gelu_pk(f32x2 v) {
    const f32x2 av = __builtin_elementwise_abs(v), d = av * 0.2316418882f + 1.0f;
    f32x2 t; t.x = __builtin_amdgcn_rcpf(d.x); t.y = __builtin_amdgcn_rcpf(d.y);
    f32x2 q = t * 0.5307027145f + (-0.7265760135f); q = q * t + 0.7107068705f; q = q * t + (-0.142248368f); q = q * t + 0.127414796f; q = q * t;
    const f32x2 s = (v * v) * (-0.72134752044f);
    f32x2 e; e.x = __builtin_amdgcn_exp2f(s.x); e.y = __builtin_amdgcn_exp2f(s.y);
    const f32x2 m = v * (q * e), r = v - m;
    f32x2 o; o.x = v.x < 0.f ? m.x : r.x; o.y = v.y < 0.f ? m.y : r.y; return o;
}

template <int ACT  > struct EpiBf16 {
    static constexpr bool PERM = true, AFTER_DRAIN = false; static_assert(ACT == 0 || ACT == 1, "EpiBf16: ACT is 0 (none) or 1 (gelu_pk)");
    bf16_t* O; int ldc; const float* bias; int split_cols; size_t split_stride; float scale0;
    __device__ __forceinline__ void operator()(const f32x4 (&acc)[2][2][4][2], const Unit& u, int wr, int wc, int fr, int fq) const {
        const int row0 = u.pm * BM + wr * 64 + fr; int colt = u.pn * BM; bf16_t* base = O;
        float sc = 1.f; if (split_cols) { const int t = colt / split_cols; base += (size_t)t * split_stride; colt -= t * split_cols; if (t == 0) sc = scale0; }
        const int col0 = colt + wc * 32 + 8 * fq, bcol0 = u.pn * BM + wc * 32 + 8 * fq;
        f32x4 bv[2][2];
#pragma unroll
        for (int bj = 0; bj < 2; ++bj)
#pragma unroll
            for (int n = 0; n < 2; ++n) bv[bj][n] = bias ? *(const f32x4*)(bias + bcol0 + bj * HALF + 4 * n) : (f32x4){0.f, 0.f, 0.f, 0.f};
#pragma unroll
        for (int ai = 0; ai < 2; ++ai)
#pragma unroll
            for (int m = 0; m < 4; ++m) { bf16_t* rowp = base + (size_t)(row0 + ai * HALF + m * 16) * ldc + col0;
#pragma unroll
                for (int bj = 0; bj < 2; ++bj) { f32x4 v0 = acc[ai][bj][m][0] + bv[bj][0], v1 = acc[ai][bj][m][1] + bv[bj][1];
                    if (ACT == 1) { f32x2 a = gelu_pk((f32x2){v0[0], v0[1]}), b = gelu_pk((f32x2){v0[2], v0[3]}), c = gelu_pk((f32x2){v1[0], v1[1]}), d = gelu_pk((f32x2){v1[2], v1[3]});
                        v0 = (f32x4){a.x, a.y, b.x, b.y}; v1 = (f32x4){c.x, c.y, d.x, d.y}; }
                    v0 = v0 * sc; v1 = v1 * sc; u32x4 w; w.x = cvt_pk_bf16(v0[0], v0[1]); w.y = cvt_pk_bf16(v0[2], v0[3]); w.z = cvt_pk_bf16(v1[0], v1[1]); w.w = cvt_pk_bf16(v1[2], v1[3]);
                    *(u32x4*)(rowp + bj * HALF) = w; } }
    }
};

struct PanelStats {
    unsigned* xbuf;
    unsigned* cnt;
    unsigned* tmo;
    int ntn; float eps;
    unsigned code;
    __device__ __forceinline__ bool run(const f32x4 (&v)[2][2][4][2], const Unit& u, int wr, int wc, int fr, int fq, PG8_LAS unsigned char* lds, int wid, int lane) const {
        typedef float f32x2v __attribute__((ext_vector_type(2)));
        PG8_LAS f32x2v* P = (PG8_LAS f32x2v*)lds;
        PG8_LAS f32x2v* S = (PG8_LAS f32x2v*)(lds + 8192);
        PG8_LAS unsigned* flag = (PG8_LAS unsigned*)(lds + 8192 + 2048);
#pragma unroll
        for (int ai = 0; ai < 2; ++ai)
#pragma unroll
            for (int m = 0; m < 4; ++m) {
                float s = 0.f;
#pragma unroll
                for (int bj = 0; bj < 2; ++bj)
#pragma unroll
                    for (int n = 0; n < 2; ++n) { const f32x4 x = v[ai][bj][m][n]; s += (x[0] + x[1]) + (x[2] + x[3]); }
                s += __shfl_xor(s, 16); s += __shfl_xor(s, 32);
                const float mw = s * (1.0f / 64.0f); float q = 0.f;
#pragma unroll
                for (int bj = 0; bj < 2; ++bj)
#pragma unroll
                    for (int n = 0; n < 2; ++n) { const f32x4 d = v[ai][bj][m][n] - mw; q += (d[0] * d[0] + d[1] * d[1]) + (d[2] * d[2] + d[3] * d[3]); }
                q += __shfl_xor(q, 16); q += __shfl_xor(q, 32);
                if (fq == 0) P[(ai * HALF + wr * 64 + m * 16 + fr) * 4 + wc] = (f32x2v){mw, q};
            }
        asm volatile("s_waitcnt lgkmcnt(0)" ::: "memory"); __builtin_amdgcn_s_barrier(); asm volatile("" ::: "memory");
#if defined(BROKEN_EXCHANGE_NO_WAIT)
#warning BROKEN CONTROL BUILD: the row-statistics exchange does not wait; results are wrong by design
        if (blockIdx.x >= 64) { const long long t0_ = clock64(); while (clock64() - t0_ < 60000) __builtin_amdgcn_s_sleep(8); }
#endif
        const int row = wid * 32 + (lane & 31);
        if (lane < 32) {
            const f32x2v a = P[row * 4 + 0], b = P[row * 4 + 1], c = P[row * 4 + 2], d = P[row * 4 + 3];
            const float mt = (a.x + b.x + c.x + d.x) * 0.25f;
            const float da = a.x - mt, db = b.x - mt, dc = c.x - mt, dd = d.x - mt;
            const float m2 = (a.y + b.y) + (c.y + d.y) + 64.0f * ((da * da + db * db) + (dc * dc + dd * dd));
            unsigned long long* slot = (unsigned long long*)xbuf + ((size_t)(u.pm * BM + row) * 4 + u.pn);
            __hip_atomic_store(slot, ((unsigned long long)__float_as_uint(m2) << 32) | __float_as_uint(mt), __ATOMIC_RELAXED, __HIP_MEMORY_SCOPE_AGENT);
        }
        asm volatile("s_waitcnt vmcnt(0)" ::: "memory");
        if (lane == 0) __hip_atomic_fetch_add(cnt + 64 * u.pm, 1u, __ATOMIC_RELAXED, __HIP_MEMORY_SCOPE_AGENT);
        if (wid == 0) {
            bool dead = false; const unsigned long long t0 = __builtin_amdgcn_s_memrealtime(); const unsigned want = 8u * (unsigned)ntn;
            for (;;) {
#if defined(BROKEN_EXCHANGE_NO_WAIT)
                break;
#endif
                if ((unsigned)__builtin_amdgcn_readfirstlane(__hip_atomic_load(cnt + 64 * u.pm, __ATOMIC_RELAXED, __HIP_MEMORY_SCOPE_AGENT)) >= want) break;
                if (__builtin_amdgcn_s_memrealtime() - t0 > 2000000ull) {
                    if (lane == 0) { unsigned expect = 0u; __hip_atomic_compare_exchange_strong(tmo + 1, &expect, code | (unsigned)(u.pm & 0xff), __ATOMIC_RELAXED, __ATOMIC_RELAXED, __HIP_MEMORY_SCOPE_AGENT);
                                     __hip_atomic_store(tmo, 1u, __ATOMIC_RELAXED, __HIP_MEMORY_SCOPE_AGENT); }
                    dead = true; break; }
                __builtin_amdgcn_s_sleep(2);
            }
            __builtin_amdgcn_fence(__ATOMIC_ACQUIRE, "agent");
            if (lane == 0) flag[0] = dead ? 1u : 0u;
        }
        asm volatile("s_waitcnt vmcnt(0) lgkmcnt(0)" ::: "memory"); __builtin_amdgcn_s_barrier(); asm volatile("" ::: "memory");
        const bool bad = flag[0] != 0u;
        if (lane < 32) {
            const unsigned long long* slot = (const unsigned long long*)xbuf + (size_t)(u.pm * BM + row) * 4; float mt[4], m2[4]; float ms = 0.f;
#pragma unroll
            for (int t = 0; t < 4; ++t) { if (t < ntn) { const unsigned long long w = __hip_atomic_load(slot + t, __ATOMIC_RELAXED, __HIP_MEMORY_SCOPE_AGENT); mt[t] = __uint_as_float((unsigned)w); m2[t] = __uint_as_float((unsigned)(w >> 32)); } else { mt[t] = 0.f; m2[t] = 0.f; } ms += mt[t]; }
            const float mean = ms / (float)ntn; float q = 0.f;
#pragma unroll
            for (int t = 0; t < 4; ++t) if (t < ntn) { const float dm = mt[t] - mean; q += m2[t] + 256.0f * dm * dm; }
            S[row] = (f32x2v){mean, 1.0f / sqrtf(q / (256.0f * (float)ntn) + eps)};
        }
        asm volatile("s_waitcnt lgkmcnt(0)" ::: "memory"); __builtin_amdgcn_s_barrier(); asm volatile("" ::: "memory");
        return bad;
    }
};
struct EpiLnRes {
    static constexpr bool PERM = false, AFTER_DRAIN = true;
    const float* base; float* out; int ldc; const float* bias; PanelStats st; unsigned poison;
    __device__ __forceinline__ void fused(f32x4 (&acc)[2][2][4][2], const Unit& u, int wr, int wc, int fr, int fq, PG8_LAS unsigned char* lds, int wid, int lane) const {
        typedef float f32x2v __attribute__((ext_vector_type(2)));
        const PG8_LAS f32x2v* S = (const PG8_LAS f32x2v*)(lds + 8192);
        const int col0 = u.pn * BM + wc * 32 + 4 * fq;
#pragma unroll
        for (int bj = 0; bj < 2; ++bj)
#pragma unroll
            for (int n = 0; n < 2; ++n) { const f32x4 bv = bias ? *(const f32x4*)(bias + col0 + bj * HALF + n * 16) : (f32x4){0.f, 0.f, 0.f, 0.f};
#pragma unroll
                for (int ai = 0; ai < 2; ++ai)
#pragma unroll
                    for (int m = 0; m < 4; ++m) acc[ai][bj][m][n] += bv; }
        f32x4 pre[4][2][2];
#pragma unroll
        for (int m = 0; m < 4; ++m) { const size_t off = (size_t)(u.pm * BM + wr * 64 + m * 16 + fr) * ldc + col0;
#pragma unroll
            for (int bj = 0; bj < 2; ++bj)
#pragma unroll
                for (int n = 0; n < 2; ++n) pre[m][bj][n] = *(const f32x4*)(base + off + bj * HALF + n * 16); }
        const bool bad = st.run(acc, u, wr, wc, fr, fq, lds, wid, lane) || poison != 0u;
        const float qnan = __builtin_nanf("");
#pragma unroll
        for (int ai = 0; ai < 2; ++ai)
#pragma unroll
            for (int m = 0; m < 4; ++m) { const int r = ai * HALF + wr * 64 + m * 16 + fr; const f32x2v sr = S[r]; const size_t off = (size_t)(u.pm * BM + r) * ldc + col0;
#pragma unroll
                for (int bj = 0; bj < 2; ++bj)
#pragma unroll
                    for (int n = 0; n < 2; ++n) { const f32x4 bs = ai == 0 ? pre[m][bj][n] : *(const f32x4*)(base + off + bj * HALF + n * 16); f32x4 o = bs + (acc[ai][bj][m][n] - sr.x) * sr.y;
                        if (bad) o = (f32x4){qnan, qnan, qnan, qnan}; *(f32x4*)(out + off + bj * HALF + n * 16) = o; }
                if (m & 1) asm volatile("" ::: "memory"); }
    }
};
struct EpiLnResLn {
    static constexpr bool PERM = false, AFTER_DRAIN = true;
    const float* base; float* out; bf16_t* xn; int ldc; const float* bias; PanelStats st1, st2; unsigned poison;
    __device__ __forceinline__ void fused(f32x4 (&acc)[2][2][4][2], const Unit& u, int wr, int wc, int fr, int fq, PG8_LAS unsigned char* lds, int wid, int lane) const {
        typedef float f32x2v __attribute__((ext_vector_type(2))); typedef unsigned u32x2v __attribute__((ext_vector_type(2)));
        const PG8_LAS f32x2v* S = (const PG8_LAS f32x2v*)(lds + 8192);
        const int col0 = u.pn * BM + wc * 32 + 4 * fq;
#pragma unroll
        for (int bj = 0; bj < 2; ++bj)
#pragma unroll
            for (int n = 0; n < 2; ++n) { const f32x4 bv = bias ? *(const f32x4*)(bias + col0 + bj * HALF + n * 16) : (f32x4){0.f, 0.f, 0.f, 0.f};
#pragma unroll
                for (int ai = 0; ai < 2; ++ai)
#pragma unroll
                    for (int m = 0; m < 4; ++m) acc[ai][bj][m][n] += bv; }
        bool bad = st1.run(acc, u, wr, wc, fr, fq, lds, wid, lane) || poison != 0u;
        const float qnan = __builtin_nanf("");
#pragma unroll
        for (int ai = 0; ai < 2; ++ai)
#pragma unroll
            for (int m = 0; m < 4; ++m) { const int r = ai * HALF + wr * 64 + m * 16 + fr; const f32x2v sr = S[r]; const size_t off = (size_t)(u.pm * BM + r) * ldc + col0;
#pragma unroll
                for (int bj = 0; bj < 2; ++bj)
#pragma unroll
                    for (int n = 0; n < 2; ++n) { const f32x4 bs = *(const f32x4*)(base + off + bj * HALF + n * 16); acc[ai][bj][m][n] = bs + (acc[ai][bj][m][n] - sr.x) * sr.y; }
                asm volatile("" : "+v"(acc[ai][0][m][0]), "+v"(acc[ai][0][m][1]), "+v"(acc[ai][1][m][0]), "+v"(acc[ai][1][m][1]));
                if (m & 1) asm volatile("" ::: "memory"); }
        const bool bad1 = bad;
        bad = st2.run(acc, u, wr, wc, fr, fq, lds, wid, lane) || bad;
#pragma unroll
        for (int ai = 0; ai < 2; ++ai)
#pragma unroll
            for (int m = 0; m < 4; ++m) { const int r = ai * HALF + wr * 64 + m * 16 + fr; const f32x2v sr = S[r]; const size_t off = (size_t)(u.pm * BM + r) * ldc + col0;
#pragma unroll
                for (int bj = 0; bj < 2; ++bj)
#pragma unroll
                    for (int n = 0; n < 2; ++n) { const f32x4 x1 = acc[ai][bj][m][n]; *(f32x4*)(out + off + bj * HALF + n * 16) = bad1 ? (f32x4){qnan, qnan, qnan, qnan} : x1;
                        const f32x4 o = (x1 - sr.x) * sr.y; u32x2v w; w.x = cvt_pk_bf16(o[0], o[1]); w.y = cvt_pk_bf16(o[2], o[3]);
                        if (bad) { w.x = 0x7fc07fc0u; w.y = 0x7fc07fc0u; } *(u32x2v*)(xn + off + bj * HALF + n * 16) = w; }
                asm volatile("" ::: "memory"); }
    }
};

template <class Epi, class Sched, bool ALIGN_EPI = false, bool SP2 = false, bool AMAP = false>
__device__ __forceinline__ void gemm_phase(PG8_LAS unsigned char* lds, const Gemm g, const Sched& S, const Epi& E) {
    int tid_o = threadIdx.x; asm volatile("" : "+v"(tid_o)); const int tid = tid_o, wid = __builtin_amdgcn_readfirstlane(tid >> 6), lane = tid & 63, wr = wid >> 2, wc = wid & 3, fr = lane & 15, fq = lane >> 4;
    const int K = g.K, nt = K / BK;
    unsigned voffA[2], voffB[2];
#pragma unroll
    for (int i = 0; i < 2; ++i) { int R, C; stage_rc(tid * 16 + i * 8192, R, C); const int Rb = Epi::PERM ? ((R & ~31) + perm32(R & 31)) : R;
        const int Ra = AMAP ? ((R >> 6) * 126 + 8 * (R & 15) + ((R >> 4) & 3)) : R;
        voffA[i] = (unsigned)(Ra * K + C) * 2u; voffB[i] = (unsigned)(Rb * K + C) * 2u; }
    const size_t kstep = (size_t)(BK * 2);
    const size_t hstep = (size_t)HALF * K * 2;
    const size_t tstep = 2 * hstep;
    const size_t hstepA = AMAP ? (size_t)4 * K * 2 : hstep;
#define PG8_AROW(pm) (AMAP ? ((long)((pm) / 33) * 8192 + (long)((pm) % 33) * 252 - 2) : (long)(pm) * 256)
    const unsigned ldsw = (unsigned)wid * 1024u;
    const int aoff = lds_byte(wr * 64 + fr, fq * 8), boff = lds_byte(wc * 32 + fr, fq * 8);
#define PG8_SA(b, h) (((b) * 2 + (h)) * HTB)
#define PG8_SB(b, h) ((4 + (b) * 2 + (h)) * HTB)
#define PG8_STAGE(bufoff, gbase, voff) do { _Pragma("unroll") for (int _i = 0; _i < 2; ++_i) \
        __builtin_amdgcn_global_load_lds((const unsigned*)((const char*)(gbase) + (voff)[_i]), (PG8_LAS unsigned*)(lds + (bufoff) + ldsw + _i * 8192), 16, 0, 0); } while (0)
#define PG8_LDA(dst, b, h) do { _Pragma("unroll") for (int m = 0; m < 4; ++m) _Pragma("unroll") for (int k = 0; k < 2; ++k) dst[m][k] = *(const PG8_LAS bf16x8*)(lds + PG8_SA(b, h) + aoff + m * 2048 + k * 1024); } while (0)
#define PG8_LDB(dst, b, h) do { _Pragma("unroll") for (int n = 0; n < 2; ++n) _Pragma("unroll") for (int k = 0; k < 2; ++k) dst[n][k] = *(const PG8_LAS bf16x8*)(lds + PG8_SB(b, h) + boff + n * 2048 + k * 1024); } while (0)
#define PG8_MMA(ai, bj, At, Bt) do { __builtin_amdgcn_s_setprio(1); _Pragma("unroll") for (int m = 0; m < 4; ++m) _Pragma("unroll") for (int n = 0; n < 2; ++n) _Pragma("unroll") for (int k = 0; k < 2; ++k) \
        acc[ai][bj][m][n] = __builtin_amdgcn_mfma_f32_16x16x32_bf16(Bt[n][k], At[m][k], acc[ai][bj][m][n], 0, 0, 0); __builtin_amdgcn_s_setprio(0); } while (0)
#define PG8_WAIT_V(n) asm volatile("s_waitcnt vmcnt(" #n ")" ::: "memory")
#define PG8_WAIT_L(n) asm volatile("s_waitcnt lgkmcnt(" #n ")" ::: "memory")
#define PG8_BAR __builtin_amdgcn_s_barrier()
#define PG8_SCHED __builtin_amdgcn_sched_barrier(0)
    Unit cur, nxt; int ui = 0;
    if (!S.next(0, cur)) return;
    f32x4 acc[2][2][4][2];
#pragma unroll
    for (int a = 0; a < 2; ++a)
#pragma unroll
        for (int b = 0; b < 2; ++b)
#pragma unroll
            for (int m = 0; m < 4; ++m)
#pragma unroll
                for (int n = 0; n < 2; ++n) acc[a][b][m][n] = (f32x4){0.f, 0.f, 0.f, 0.f};
    bf16x8 At[4][2], B0[2][2], B1[2][2];
    const char* cA = (const char*)g.A + PG8_AROW(cur.pm) * (long)K * 2; const char* cB = (const char*)g.Bt + (size_t)cur.pn * tstep;
    S.a_ready(cur);
    if constexpr (SP2) {
        PG8_STAGE(PG8_SB(0, 0), cB, voffB); PG8_STAGE(PG8_SB(0, 1), cB + hstep, voffB); PG8_STAGE(PG8_SA(0, 0), cA, voffA); PG8_STAGE(PG8_SA(0, 1), cA + hstepA, voffA);
        if (wr == 1) PG8_BAR;
        PG8_WAIT_V(2); PG8_BAR;
        PG8_STAGE(PG8_SB(1, 0), cB + kstep, voffB); PG8_STAGE(PG8_SA(1, 0), cA + kstep, voffA); PG8_STAGE(PG8_SB(1, 1), cB + hstep + kstep, voffB);
        PG8_WAIT_V(6); PG8_BAR;
    } else {
        PG8_STAGE(PG8_SB(0, 0), cB, voffB); PG8_STAGE(PG8_SA(0, 0), cA, voffA); PG8_STAGE(PG8_SB(0, 1), cB + hstep, voffB); PG8_STAGE(PG8_SA(0, 1), cA + hstepA, voffA);
        if (wr == 1) PG8_BAR;
        PG8_WAIT_V(4); PG8_BAR;
        PG8_STAGE(PG8_SB(1, 0), cB + kstep, voffB); PG8_STAGE(PG8_SA(1, 0), cA + kstep, voffA); PG8_STAGE(PG8_SB(1, 1), cB + hstep + kstep, voffB);
        PG8_WAIT_V(6); PG8_BAR;
    }
    for (;;) {
        const bool has_next = S.next(ui + 1, nxt);
        const char* nA = has_next ? (const char*)g.A + PG8_AROW(nxt.pm) * (long)K * 2 : cA; const char* nB = has_next ? (const char*)g.Bt + (size_t)nxt.pn * tstep : cB;
        for (int t = 0; t < nt; t += 2) {
            const bool last = (t == nt - 2);
            const char* a1 = cA + (size_t)(t + 1) * kstep;
            const char* a2 = last ? nA : cA + (size_t)(t + 2) * kstep; const char* b2 = last ? nB : cB + (size_t)(t + 2) * kstep;
            const char* a3 = a2 + kstep; const char* b3 = b2 + kstep;
            if (last && has_next) S.a_ready(nxt);
            if constexpr (SP2) {
            PG8_LDB(B0, 0, 0); PG8_LDB(B1, 0, 1); PG8_SCHED; PG8_LDA(At, 0, 0); PG8_STAGE(PG8_SA(1, 1), a1 + hstepA, voffA);
            PG8_WAIT_V(8); PG8_WAIT_L(0); PG8_BAR; PG8_MMA(0, 0, At, B0); PG8_MMA(0, 1, At, B1); PG8_BAR; PG8_SCHED;
            PG8_LDA(At, 0, 1); PG8_STAGE(PG8_SB(0, 0), b2, voffB); PG8_STAGE(PG8_SB(0, 1), b2 + hstep, voffB); PG8_STAGE(PG8_SA(0, 0), a2, voffA);
            PG8_WAIT_V(8); PG8_WAIT_L(0); PG8_BAR; PG8_MMA(1, 0, At, B0); PG8_MMA(1, 1, At, B1); PG8_BAR; PG8_SCHED;
            PG8_LDB(B0, 1, 0); PG8_LDB(B1, 1, 1); PG8_SCHED; PG8_LDA(At, 1, 0); PG8_STAGE(PG8_SA(0, 1), a2 + hstepA, voffA);
            PG8_WAIT_V(8); PG8_WAIT_L(0); PG8_BAR; PG8_MMA(0, 0, At, B0); PG8_MMA(0, 1, At, B1); PG8_BAR; PG8_SCHED;
            PG8_LDA(At, 1, 1); PG8_STAGE(PG8_SB(1, 0), b3, voffB); PG8_STAGE(PG8_SB(1, 1), b3 + hstep, voffB); PG8_STAGE(PG8_SA(1, 0), a3, voffA);
            PG8_WAIT_V(8); PG8_WAIT_L(0); PG8_BAR; PG8_MMA(1, 0, At, B0); PG8_MMA(1, 1, At, B1); PG8_BAR; PG8_SCHED;
            } else {
            PG8_LDB(B0, 0, 0); PG8_SCHED; PG8_LDA(At, 0, 0); PG8_STAGE(PG8_SA(1, 1), a1 + hstepA, voffA);
            PG8_WAIT_L(8); PG8_BAR; PG8_WAIT_L(0); PG8_MMA(0, 0, At, B0); PG8_BAR; PG8_SCHED;
            PG8_LDB(B1, 0, 1); PG8_STAGE(PG8_SB(0, 0), b2, voffB);
            PG8_BAR; PG8_WAIT_L(0); PG8_MMA(0, 1, At, B1); PG8_BAR;
            PG8_LDA(At, 0, 1); PG8_STAGE(PG8_SA(0, 0), a2, voffA);
            PG8_BAR; PG8_WAIT_L(0); PG8_MMA(1, 0, At, B0); PG8_BAR; PG8_SCHED;
            PG8_STAGE(PG8_SB(0, 1), b2 + hstep, voffB);
            PG8_WAIT_V(6); PG8_BAR; PG8_MMA(1, 1, At, B1); PG8_BAR;
            PG8_LDB(B0, 1, 0); PG8_SCHED; PG8_LDA(At, 1, 0); PG8_STAGE(PG8_SA(0, 1), a2 + hstepA, voffA);
            PG8_WAIT_L(8); PG8_BAR; PG8_WAIT_L(0); PG8_MMA(0, 0, At, B0); PG8_BAR; PG8_SCHED;
            PG8_LDB(B1, 1, 1); PG8_STAGE(PG8_SB(1, 0), b3, voffB);
            PG8_BAR; PG8_WAIT_L(0); PG8_MMA(0, 1, At, B1); PG8_BAR;
            PG8_LDA(At, 1, 1); PG8_STAGE(PG8_SA(1, 0), a3, voffA);
            PG8_BAR; PG8_WAIT_L(0); PG8_MMA(1, 0, At, B0); PG8_BAR; PG8_SCHED;
            PG8_STAGE(PG8_SB(1, 1), b3 + hstep, voffB);
            PG8_WAIT_V(6); PG8_BAR; PG8_MMA(1, 1, At, B1); PG8_BAR;
            }
        }
        if constexpr (ALIGN_EPI) { if (wr == 0) PG8_BAR; }
        if constexpr (!Epi::AFTER_DRAIN) { E(acc, cur, wr, wc, fr, fq); S.done(cur); }
        if (!has_next) break;
#pragma unroll
        for (int a = 0; a < 2; ++a)
#pragma unroll
            for (int b = 0; b < 2; ++b)
#pragma unroll
                for (int m = 0; m < 4; ++m)
#pragma unroll
                    for (int n = 0; n < 2; ++n) acc[a][b][m][n] = (f32x4){0.f, 0.f, 0.f, 0.f};
        cur = nxt; cA = nA; cB = nB; ++ui;
        if constexpr (ALIGN_EPI) { if (wr == 1) PG8_BAR; }
    }
    PG8_WAIT_V(0);
    if constexpr (!ALIGN_EPI) { if (wr == 0) PG8_BAR; }
    PG8_BAR;
    if constexpr (Epi::AFTER_DRAIN) { E.fused(acc, cur, wr, wc, fr, fq, lds, wid, lane); S.done(cur); }
#undef PG8_AROW
#undef PG8_SA
#undef PG8_SB
#undef PG8_STAGE
#undef PG8_LDA
#undef PG8_LDB
#undef PG8_MMA
#undef PG8_WAIT_V
#undef PG8_WAIT_L
#undef PG8_BAR
#undef PG8_SCHED
}
}

#define GAS __attribute__((address_space(1)))
#define LAS __attribute__((address_space(3)))
typedef unsigned short bf16;
typedef float f32x4 __attribute__((ext_vector_type(4)));
typedef float f32x2 __attribute__((ext_vector_type(2)));
typedef float f32x16 __attribute__((ext_vector_type(16)));
typedef short bf16x8 __attribute__((ext_vector_type(8)));
typedef unsigned u32x4 __attribute__((ext_vector_type(4)));
typedef unsigned u32x2 __attribute__((ext_vector_type(2)));

constexpr int DM = 1024, SEQ = 8192, NBATCH = 2, MP = NBATCH * SEQ, NS = 128, DEPTH = 4;
constexpr int DIN = 2048, DFF = 2816, DUP = 5632, DLRU = 256;
constexpr float EPS = 1e-6f;
constexpr int NWAVES = 8, NTHREADS = 512;
constexpr int LDS_BYTES = 147456;
constexpr int ZQ = 0, ZK = 512, ZV = 640, ZLX = 768, ZLG = 1024, ZSB = 1280, ZSC = 1536, ZSU = 1792;
constexpr size_t O_Y = 0, O_YS = 16777216, O_CKP = 16908288, O_CVP = 17039360, O_RGP = 17170432, O_LCP = 17172480, O_SCP = 17178624,
                 O_FFP = 17182720, O_CKS = 17272832, O_CVS = 25661440, O_RGS = 34050048, O_LCS = 34181120, O_SCS = 34574336, O_FFS = 34836480;
constexpr size_t MiB = 1u << 20;
constexpr size_t WS_LWT = 1 * MiB;
constexpr size_t WS_W = 2 * MiB, W_LAYER = 23592960;
constexpr size_t W_IN = 0, W_OUT = 4 * MiB, W_UP = 6 * MiB, W_DOWN = 17 * MiB;
constexpr size_t WS_XS = 92 * MiB;
constexpr size_t WS_ZS = WS_XS + 512 * 1024;
constexpr size_t WS_MGS = WS_ZS + 512 * 1024;
constexpr size_t WS_ACTS = WS_MGS + 256 * 1024;
constexpr size_t WS_AGGA = 95 * MiB, WS_AGGB = 95 * MiB + 512 * 1024;
constexpr size_t WS_Z = 96 * MiB;
constexpr size_t WS_MG = 160 * MiB;
constexpr size_t WS_HLOC = 192 * MiB, WS_CUMA = 208 * MiB;
constexpr size_t WS_XN = 192 * MiB;
constexpr size_t WS_ACT = 226 * MiB;
constexpr size_t WS_END = 316 * MiB;

__device__ __forceinline__ float bf2f(unsigned v) { return __uint_as_float(v << 16); }
__device__ __forceinline__ unsigned f2bf(float f) { unsigned u = __float_as_uint(f); return (u + 0x7fffu + ((u >> 16) & 1u)) >> 16; }
__device__ __forceinline__ unsigned pk2(float lo, float hi) { return f2bf(lo) | (f2bf(hi) << 16); }
__device__ __forceinline__ float wave_sum(float v) {
#pragma unroll
    for (int o = 1; o < 64; o <<= 1) v += __shfl_xor(v, o);
    return v;
}
__device__ __forceinline__ float wave_max(float v) {
#pragma unroll
    for (int o = 1; o < 64; o <<= 1) v = fmaxf(v, __shfl_xor(v, o));
    return v;
}
__device__ __forceinline__ float sigmoidf_(float x) { return 1.0f / (1.0f + __expf(-x)); }
__device__ __forceinline__ float gelu_tanh(float x) { const float u = 0.7978845608028654f * (x + 0.044715f * x * x * x); return 0.5f * x * (1.0f + tanhf(u)); }
__device__ __forceinline__ f32x4 ld_bf4(const bf16* p) { const u32x2 w = *(const u32x2*)p; return (f32x4){bf2f(w.x & 0xffffu), bf2f(w.x >> 16), bf2f(w.y & 0xffffu), bf2f(w.y >> 16)}; }
__device__ __forceinline__ void st_bf4(bf16* p, f32x4 v) { u32x2 w; w.x = pk2(v.x, v.y); w.y = pk2(v.z, v.w); *(u32x2*)p = w; }

struct Args { const float* in[26]; float* out; unsigned char* ws; };

struct EpiRes {
    static constexpr bool PERM = false, AFTER_DRAIN = false;
    const float* base; float* out;
    __device__ __forceinline__ void operator()(const pg8::f32x4 (&acc)[2][2][4][2], const pg8::Unit& u, int wr, int wc, int fr, int fq) const {
        const int row0 = u.pm * 256 + wr * 64 + fr, col0 = u.pn * 256 + wc * 32 + 4 * fq;
#pragma unroll
        for (int ai = 0; ai < 2; ++ai)
#pragma unroll
            for (int m = 0; m < 4; ++m) {
                const size_t off = (size_t)(row0 + ai * 128 + m * 16) * DM + col0;
#pragma unroll
                for (int bj = 0; bj < 2; ++bj)
#pragma unroll
                    for (int n = 0; n < 2; ++n) { const f32x4 bs = *(const f32x4*)(base + off + bj * 128 + n * 16); *(f32x4*)(out + off + bj * 128 + n * 16) = bs + acc[ai][bj][m][n]; }
                asm volatile("" ::: "memory");
            }
    }
};
struct EpiFfn {
    static constexpr bool PERM = false, AFTER_DRAIN = false;
    bf16* act; const float* cw; float* st_out;
    __device__ __forceinline__ void operator()(const pg8::f32x4 (&acc)[2][2][4][2], const pg8::Unit& u, int wr, int wc, int fr, int fq) const {
        const int bb = u.pm / 33, tt = u.pm % 33;
        const int t0 = tt * 252 + wr * 126 - 2 + 8 * fr;
#pragma unroll
        for (int n = 0; n < 2; ++n) {
            const int cu = u.pn * 128 + wc * 32 + 16 * n + 4 * fq;
            const f32x4 w0u = *(const f32x4*)(cw + cu), w1u = *(const f32x4*)(cw + DUP + cu), w2u = *(const f32x4*)(cw + 2 * DUP + cu);
            const f32x4 w0g = *(const f32x4*)(cw + DFF + cu), w1g = *(const f32x4*)(cw + DUP + DFF + cu), w2g = *(const f32x4*)(cw + 2 * DUP + DFF + cu);
            f32x4 pu6, pu7, pg6, pg7;
#pragma unroll
            for (int e = 0; e < 4; ++e) {
                pu6[e] = __shfl_up(acc[1][0][2][n][e], 1, 16); pu7[e] = __shfl_up(acc[1][0][3][n][e], 1, 16);
                pg6[e] = __shfl_up(acc[1][1][2][n][e], 1, 16); pg7[e] = __shfl_up(acc[1][1][3][n][e], 1, 16);
            }
#pragma unroll
            for (int j = 0; j < 8; ++j) {
                const f32x4 U = acc[j >> 2][0][j & 3][n], G = acc[j >> 2][1][j & 3][n];
                f32x4 um1 = (j >= 1) ? acc[(j - 1 >= 0 ? j - 1 : 0) >> 2][0][(j - 1 >= 0 ? j - 1 : 0) & 3][n] : pu7;
                f32x4 gm1 = (j >= 1) ? acc[(j - 1 >= 0 ? j - 1 : 0) >> 2][1][(j - 1 >= 0 ? j - 1 : 0) & 3][n] : pg7;
                f32x4 um2 = (j >= 2) ? acc[(j - 2 >= 0 ? j - 2 : 0) >> 2][0][(j - 2 >= 0 ? j - 2 : 0) & 3][n] : (j == 1 ? pu7 : pu6);
                f32x4 gm2 = (j >= 2) ? acc[(j - 2 >= 0 ? j - 2 : 0) >> 2][1][(j - 2 >= 0 ? j - 2 : 0) & 3][n] : (j == 1 ? pg7 : pg6);
                const int t = t0 + j;
                const f32x4 zero = (f32x4){0.f, 0.f, 0.f, 0.f};
                if (t < 1) { um1 = zero; gm1 = zero; }
                if (t < 2) { um2 = zero; gm2 = zero; }
                const f32x4 uc = w0u * um2 + w1u * um1 + w2u * U;
                const f32x4 gc = w0g * gm2 + w1g * gm1 + w2g * G;
                const bool valid = (8 * fr + j >= 2) && (t < SEQ);
                if (valid) {
                    f32x4 a;
#pragma unroll
                    for (int e = 0; e < 4; ++e) a[e] = uc[e] * gc[e] / (1.0f + __expf(-gc[e]));
                    st_bf4(act + (size_t)(bb * SEQ + t) * DFF + cu, a);
                    if (t >= SEQ - 2) {
                        float* so = st_out + (size_t)(bb * 2 + (t - (SEQ - 2))) * DUP + cu;
                        *(f32x4*)so = U; *(f32x4*)(so + DFF) = G;
                    }
                }
            }
        }
    }
};

template <int MODE>
__device__ __forceinline__ void small_gemm_unit(int j, const void* Ap, const float* gain, const bf16* Bt, int K,
                                                bf16* obf, int ldo, const float* base, float* outf,
                                                const float* cw, const float* fbuf, float* fst) {
    int tid_o = threadIdx.x; asm volatile("" : "+v"(tid_o)); const int tid = tid_o, w = tid >> 6, lane = tid & 63, fr = lane & 15, fq = lane >> 4;
    const int row = 16 * w + fr;
    int bn0, bn1;
    if (MODE == 2) { bn0 = 256 * ((16 * j) / 128) + ((16 * j) % 128); bn1 = bn0 + 128; } else { bn0 = 32 * j; bn1 = bn0 + 16; }
    const bf16* b0p = Bt + (size_t)(bn0 + fr) * K + 8 * fq;
    const bf16* b1p = Bt + (size_t)(bn1 + fr) * K + 8 * fq;
    pg8::f32x4 acc0 = {0.f, 0.f, 0.f, 0.f}, acc1 = {0.f, 0.f, 0.f, 0.f};
    float ssq = 0.f;
    if (MODE == 1) {
        const bf16* ap = (const bf16*)Ap + (size_t)row * K + 8 * fq;
#pragma unroll 4
        for (int k0 = 0; k0 < K; k0 += 32) {
            const bf16x8 a = *(const bf16x8*)(ap + k0), b0 = *(const bf16x8*)(b0p + k0), b1 = *(const bf16x8*)(b1p + k0);
            acc0 = __builtin_amdgcn_mfma_f32_16x16x32_bf16(b0, a, acc0, 0, 0, 0);
            acc1 = __builtin_amdgcn_mfma_f32_16x16x32_bf16(b1, a, acc1, 0, 0, 0);
        }
    } else {
        const float* ap = (const float*)Ap + (size_t)row * K + 8 * fq;
        const float* gp = gain + 8 * fq;
#pragma unroll 4
        for (int k0 = 0; k0 < K; k0 += 32) {
            const f32x4 x0 = *(const f32x4*)(ap + k0), x1 = *(const f32x4*)(ap + k0 + 4), g0 = *(const f32x4*)(gp + k0), g1 = *(const f32x4*)(gp + k0 + 4);
            ssq += (x0.x * x0.x + x0.y * x0.y) + (x0.z * x0.z + x0.w * x0.w) + (x1.x * x1.x + x1.y * x1.y) + (x1.z * x1.z + x1.w * x1.w);
            u32x4 pa; pa.x = pk2(x0.x * g0.x, x0.y * g0.y); pa.y = pk2(x0.z * g0.z, x0.w * g0.w); pa.z = pk2(x1.x * g1.x, x1.y * g1.y); pa.w = pk2(x1.z * g1.z, x1.w * g1.w);
            const bf16x8 a = __builtin_bit_cast(bf16x8, pa), b0 = *(const bf16x8*)(b0p + k0), b1 = *(const bf16x8*)(b1p + k0);
            acc0 = __builtin_amdgcn_mfma_f32_16x16x32_bf16(b0, a, acc0, 0, 0, 0);
            acc1 = __builtin_amdgcn_mfma_f32_16x16x32_bf16(b1, a, acc1, 0, 0, 0);
        }
        ssq += __shfl_xor(ssq, 16); ssq += __shfl_xor(ssq, 32);
    }
    if (MODE == 0) {
        const float rs = rsqrtf(ssq * (1.0f / DM) + EPS);
        bf16* o = obf + (size_t)row * ldo + 32 * j + 4 * fq;
        st_bf4(o, acc0 * rs); st_bf4(o + 16, acc1 * rs);
    } else if (MODE == 1) {
        const size_t off = (size_t)row * DM + 32 * j + 4 * fq;
        const f32x4 r0 = *(const f32x4*)(base + off), r1 = *(const f32x4*)(base + off + 16);
        *(f32x4*)(outf + off) = r0 + acc0; *(f32x4*)(outf + off + 16) = r1 + acc1;
    } else {
        const float rs = rsqrtf(ssq * (1.0f / DM) + EPS);
        const int cu = 16 * j + 4 * fq;
        const f32x4 U = acc0 * rs, G = acc1 * rs;
        const float* b0r = fbuf + (size_t)(row * 2 + 0) * DUP + cu; const float* b1r = fbuf + (size_t)(row * 2 + 1) * DUP + cu;
        const f32x4 u0 = *(const f32x4*)b0r, u1 = *(const f32x4*)b1r, g0 = *(const f32x4*)(b0r + DFF), g1 = *(const f32x4*)(b1r + DFF);
        const f32x4 uc = *(const f32x4*)(cw + cu) * u0 + *(const f32x4*)(cw + DUP + cu) * u1 + *(const f32x4*)(cw + 2 * DUP + cu) * U;
        const f32x4 gc = *(const f32x4*)(cw + DFF + cu) * g0 + *(const f32x4*)(cw + DUP + DFF + cu) * g1 + *(const f32x4*)(cw + 2 * DUP + DFF + cu) * G;
        f32x4 a;
#pragma unroll
        for (int e = 0; e < 4; ++e) a[e] = uc[e] * gc[e] / (1.0f + __expf(-gc[e]));
        st_bf4(obf + (size_t)row * DFF + cu, a);
        float* s0 = fst + (size_t)(row * 2 + 0) * DUP + cu; float* s1 = fst + (size_t)(row * 2 + 1) * DUP + cu;
        *(f32x4*)s0 = u1; *(f32x4*)(s0 + DFF) = g1; *(f32x4*)s1 = U; *(f32x4*)(s1 + DFF) = G;
    }
}

__device__ __forceinline__ void transpose_item(const float* W, int K, int N, bf16* WT, int upmap, LAS float* scr, int item, int lane) {
    const int nblk = N / 32, kb = item / nblk, nb = item % nblk, k0 = 64 * kb, n0 = 32 * nb;
#pragma unroll 8
    for (int i = 0; i < 32; ++i) { const int kk = 2 * i + (lane >> 5); scr[kk * 33 + (lane & 31)] = W[(size_t)(k0 + kk) * N + n0 + (lane & 31)]; }
    asm volatile("s_waitcnt lgkmcnt(0)" ::: "memory");
    int r0 = n0;
    if (upmap) { r0 = (n0 < DFF) ? (256 * (n0 / 128) + (n0 % 128)) : (256 * ((n0 - DFF) / 128) + 128 + ((n0 - DFF) % 128)); }
    const int c = lane & 7;
#pragma unroll
    for (int j = 0; j < 4; ++j) { const int n = (lane >> 3) + 8 * j; const LAS float* s = scr + (8 * c) * 33 + n;
        u32x4 o; o.x = pk2(s[0 * 33], s[1 * 33]); o.y = pk2(s[2 * 33], s[3 * 33]); o.z = pk2(s[4 * 33], s[5 * 33]); o.w = pk2(s[6 * 33], s[7 * 33]);
        *(u32x4*)(WT + (size_t)(r0 + n) * K + k0 + 8 * c) = o; }
    asm volatile("s_waitcnt lgkmcnt(0)" ::: "memory");
}
__device__ __forceinline__ void rms_row_bf16(const float* xrow, const float* g, bf16* orow, int lane) {
    f32x4 v[4]; float s = 0.f;
#pragma unroll
    for (int j = 0; j < 4; ++j) { v[j] = *(const f32x4*)(xrow + 4 * lane + 256 * j); s += (v[j].x * v[j].x + v[j].y * v[j].y) + (v[j].z * v[j].z + v[j].w * v[j].w); }
    const float rs = rsqrtf(wave_sum(s) * (1.0f / DM) + EPS);
#pragma unroll
    for (int j = 0; j < 4; ++j) { const f32x4 gg = *(const f32x4*)(g + 4 * lane + 256 * j); st_bf4(orow + 4 * lane + 256 * j, v[j] * gg * rs); }
}
__device__ __forceinline__ void rms_row_f32(const float* xrow, const float* g, float* orow, int lane) {
    f32x4 v[4]; float s = 0.f;
#pragma unroll
    for (int j = 0; j < 4; ++j) { v[j] = *(const f32x4*)(xrow + 4 * lane + 256 * j); s += (v[j].x * v[j].x + v[j].y * v[j].y) + (v[j].z * v[j].z + v[j].w * v[j].w); }
    const float rs = rsqrtf(wave_sum(s) * (1.0f / DM) + EPS);
#pragma unroll
    for (int j = 0; j < 4; ++j) { const f32x4 gg = *(const f32x4*)(g + 4 * lane + 256 * j); *(f32x4*)(orow + 4 * lane + 256 * j) = v[j] * gg * rs; }
}

__device__ __forceinline__ void attn_prompt_unit(LAS unsigned char* lds, int b, int t0, const bf16* Z, bf16* MG, const float* sinks, const float* gout,
                                                 float* ck_out, float* cv_out) {
    int tid_o = threadIdx.x; asm volatile("" : "+v"(tid_o)); const int tid = tid_o, h = __builtin_amdgcn_readfirstlane(tid >> 6), lane = tid & 63, qi = lane & 31, hi = lane >> 5, g = h >> 2;
    LAS bf16* Ks = (LAS bf16*)lds;
    LAS bf16* Vt = (LAS bf16*)(lds + 55296);
    LAS float* SS = (LAS float*)(lds + 55296 + 51200);
    const bool wr_cache = (t0 >= SEQ - 128);
    for (int c = tid; c < 3072; c += NTHREADS) {
        const int row = c >> 4, part = c & 15, gg = part >> 3, d8 = part & 7;
        const int tok = t0 - 128 + row;
        u32x4 kv = (u32x4){0u, 0u, 0u, 0u}, vv = (u32x4){0u, 0u, 0u, 0u};
        if (tok >= 0) { const bf16* zr = Z + (size_t)(b * SEQ + tok) * DIN + gg * 64 + d8 * 8; kv = *(const u32x4*)(zr + ZK); vv = *(const u32x4*)(zr + ZV); }
        *(LAS u32x4*)(Ks + (gg * 192 + row) * 72 + d8 * 8) = kv;
        LAS bf16* vt = Vt + (gg * 64 + d8 * 8) * 200 + row;
        vt[0 * 200] = (bf16)(vv.x & 0xffffu); vt[1 * 200] = (bf16)(vv.x >> 16); vt[2 * 200] = (bf16)(vv.y & 0xffffu); vt[3 * 200] = (bf16)(vv.y >> 16);
        vt[4 * 200] = (bf16)(vv.z & 0xffffu); vt[5 * 200] = (bf16)(vv.z >> 16); vt[6 * 200] = (bf16)(vv.w & 0xffffu); vt[7 * 200] = (bf16)(vv.w >> 16);
        if (wr_cache && row >= 128) {
            const size_t o = ((size_t)(tok - (SEQ - 128)) * 2 + gg) * 64 + d8 * 8;
            *(f32x4*)(ck_out + o) = (f32x4){bf2f(kv.x & 0xffffu), bf2f(kv.x >> 16), bf2f(kv.y & 0xffffu), bf2f(kv.y >> 16)};
            *(f32x4*)(ck_out + o + 4) = (f32x4){bf2f(kv.z & 0xffffu), bf2f(kv.z >> 16), bf2f(kv.w & 0xffffu), bf2f(kv.w >> 16)};
            *(f32x4*)(cv_out + o) = (f32x4){bf2f(vv.x & 0xffffu), bf2f(vv.x >> 16), bf2f(vv.y & 0xffffu), bf2f(vv.y >> 16)};
            *(f32x4*)(cv_out + o + 4) = (f32x4){bf2f(vv.z & 0xffffu), bf2f(vv.z >> 16), bf2f(vv.w & 0xffffu), bf2f(vv.w >> 16)};
        }
    }
    __syncthreads();
    const float L2E = 1.4426950408889634f;
    const float sc = 0.125f * L2E, sinkl = sinks[h] * L2E;
    f32x16 O[2][2];
#pragma unroll
    for (int sub = 0; sub < 2; ++sub) {
        bf16x8 qf[4];
        const bf16* qp = Z + (size_t)(b * SEQ + t0 + 32 * sub + qi) * DIN + ZQ + 64 * h + 8 * hi;
#pragma unroll
        for (int st = 0; st < 4; ++st) qf[st] = *(const bf16x8*)(qp + 16 * st);
        f32x16 S[5];
#pragma unroll
        for (int kt = 0; kt < 5; ++kt) {
#pragma unroll
            for (int r = 0; r < 16; ++r) S[kt][r] = 0.f;
            const LAS bf16* kp = Ks + (g * 192 + 32 * sub + 32 * kt + qi) * 72 + 8 * hi;
#pragma unroll
            for (int st = 0; st < 4; ++st) { const bf16x8 kf = *(const LAS bf16x8*)(kp + 16 * st); S[kt] = __builtin_amdgcn_mfma_f32_32x32x16_bf16(kf, qf[st], S[kt], 0, 0, 0); }
        }
        float m = sinkl;
#pragma unroll
        for (int kt = 0; kt < 5; ++kt)
#pragma unroll
            for (int r = 0; r < 16; ++r) {
                const int keyrow = 8 * (r >> 2) + 4 * hi + (r & 3);
                bool valid = true;
                if (kt == 0) valid = keyrow >= qi;
                if (kt == 4) valid = keyrow <= qi;
                if (t0 - 128 + 32 * sub + 32 * kt + keyrow < 0) valid = false;
                const float s = valid ? S[kt][r] * sc : -INFINITY;
                S[kt][r] = s; m = fmaxf(m, s);
            }
        m = fmaxf(m, __shfl_xor(m, 32));
        float sum = 0.f;
#pragma unroll
        for (int kt = 0; kt < 5; ++kt)
#pragma unroll
            for (int r = 0; r < 16; ++r) { const float p = exp2f(S[kt][r] - m); S[kt][r] = p; sum += p; }
        sum += __shfl_xor(sum, 32);
        sum += exp2f(sinkl - m);
        const float inv = 1.0f / sum;
        f32x16 o0, o1;
#pragma unroll
        for (int r = 0; r < 16; ++r) { o0[r] = 0.f; o1[r] = 0.f; }
#pragma unroll
        for (int kt = 0; kt < 5; ++kt)
#pragma unroll
            for (int hf = 0; hf < 2; ++hf) {
                u32x4 pw; pw.x = pk2(S[kt][8 * hf + 0], S[kt][8 * hf + 1]); pw.y = pk2(S[kt][8 * hf + 2], S[kt][8 * hf + 3]);
                pw.z = pk2(S[kt][8 * hf + 4], S[kt][8 * hf + 5]); pw.w = pk2(S[kt][8 * hf + 6], S[kt][8 * hf + 7]);
                const bf16x8 pb = __builtin_bit_cast(bf16x8, pw);
                const int kb = 32 * sub + 32 * kt + 16 * hf + 4 * hi;
                const LAS bf16* v0 = Vt + (g * 64 + qi) * 200 + kb;
                const LAS bf16* v1 = Vt + (g * 64 + 32 + qi) * 200 + kb;
                u32x4 a0, a1; const u32x2 x0 = *(const LAS u32x2*)v0, x1 = *(const LAS u32x2*)(v0 + 8), y0 = *(const LAS u32x2*)v1, y1 = *(const LAS u32x2*)(v1 + 8);
                a0.x = x0.x; a0.y = x0.y; a0.z = x1.x; a0.w = x1.y; a1.x = y0.x; a1.y = y0.y; a1.z = y1.x; a1.w = y1.y;
                o0 = __builtin_amdgcn_mfma_f32_32x32x16_bf16(__builtin_bit_cast(bf16x8, a0), pb, o0, 0, 0, 0);
                o1 = __builtin_amdgcn_mfma_f32_32x32x16_bf16(__builtin_bit_cast(bf16x8, a1), pb, o1, 0, 0, 0);
            }
        float q2 = 0.f;
#pragma unroll
        for (int r = 0; r < 16; ++r) { o0[r] *= inv; o1[r] *= inv; q2 += o0[r] * o0[r] + o1[r] * o1[r]; }
        q2 += __shfl_xor(q2, 32);
        if (hi == 0) SS[(sub * 8 + h) * 32 + qi] = q2;
        O[sub][0] = o0; O[sub][1] = o1;
    }
    __syncthreads();
#pragma unroll
    for (int sub = 0; sub < 2; ++sub) {
        float tot = 0.f;
#pragma unroll
        for (int hh = 0; hh < 8; ++hh) tot += SS[(sub * 8 + hh) * 32 + qi];
        const float rs = rsqrtf(tot * (1.0f / 512.0f) + EPS);
        bf16* op = MG + (size_t)(b * SEQ + t0 + 32 * sub + qi) * DM + 64 * h;
#pragma unroll
        for (int dt = 0; dt < 2; ++dt)
#pragma unroll
            for (int rq = 0; rq < 4; ++rq) {
                const int d = 32 * dt + 8 * rq + 4 * hi;
                const f32x4 gg = *(const f32x4*)(gout + 64 * h + d);
                f32x4 v; v.x = O[sub][dt][4 * rq + 0]; v.y = O[sub][dt][4 * rq + 1]; v.z = O[sub][dt][4 * rq + 2]; v.w = O[sub][dt][4 * rq + 3];
                st_bf4(op + d, v * gg * rs);
            }
    }
    __syncthreads();
}

__device__ __forceinline__ void attn_sample_unit(LAS unsigned char* lds, int s, const bf16* ZS, bf16* MGS, const float* sinks, const float* gout,
                                                 const float* ck, const float* cv, float* cko, float* cvo) {
    int tid_o = threadIdx.x; asm volatile("" : "+v"(tid_o)); const int tid = tid_o, w = tid >> 6, lane = tid & 63, g = lane >> 5, dd = 2 * (lane & 31);
    LAS float* QS = (LAS float*)lds;
    LAS float* SC = (LAS float*)(lds + 2048);
    LAS float* OP = (LAS float*)(lds + 2048 + 4352);
    LAS float* RED = (LAS float*)(lds + 2048 + 4352 + 16384);
    const bf16* zr = ZS + (size_t)s * DIN;
    QS[tid] = bf2f(zr[ZQ + tid]);
    __syncthreads();
    float q0[4], q1[4];
#pragma unroll
    for (int hh = 0; hh < 4; ++hh) { q0[hh] = QS[(4 * g + hh) * 64 + dd]; q1[hh] = QS[(4 * g + hh) * 64 + dd + 1]; }
    const float* ckb = ck + (size_t)s * 128 * 128; float* ckob = cko + (size_t)s * 128 * 128;
    const float* cvb = cv + (size_t)s * 128 * 128; float* cvob = cvo + (size_t)s * 128 * 128;
    for (int j = w; j < 129; j += 8) {
        f32x2 kv;
        if (j < 128) kv = *(const f32x2*)(ckb + j * 128 + 2 * lane);
        else { const unsigned u = *(const unsigned*)(zr + ZK + 2 * lane); kv.x = bf2f(u & 0xffffu); kv.y = bf2f(u >> 16); }
        if (j >= 1) *(f32x2*)(ckob + (j - 1) * 128 + 2 * lane) = kv;
        float p[4];
#pragma unroll
        for (int hh = 0; hh < 4; ++hh) { p[hh] = kv.x * q0[hh] + kv.y * q1[hh];
#pragma unroll
            for (int o = 1; o < 32; o <<= 1) p[hh] += __shfl_xor(p[hh], o); }
        if ((lane & 31) == 0) {
#pragma unroll
            for (int hh = 0; hh < 4; ++hh) SC[(4 * g + hh) * 136 + j] = p[hh] * 0.125f;
        }
    }
    __syncthreads();
    {
        const float sink = sinks[w];
        const float s0 = SC[w * 136 + lane], s1 = SC[w * 136 + 64 + lane], s2 = (lane == 0) ? SC[w * 136 + 128] : -INFINITY;
        const float m = fmaxf(wave_max(fmaxf(fmaxf(s0, s1), s2)), sink);
        const float p0 = __expf(s0 - m), p1 = __expf(s1 - m), p2 = (lane == 0) ? __expf(s2 - m) : 0.f;
        const float inv = 1.0f / (wave_sum(p0 + p1 + p2) + __expf(sink - m));
        SC[w * 136 + lane] = p0 * inv; SC[w * 136 + 64 + lane] = p1 * inv; if (lane == 0) SC[w * 136 + 128] = p2 * inv;
    }
    __syncthreads();
    float a0[4] = {0.f, 0.f, 0.f, 0.f}, a1[4] = {0.f, 0.f, 0.f, 0.f};
    for (int j = w; j < 129; j += 8) {
        f32x2 vv;
        if (j < 128) vv = *(const f32x2*)(cvb + j * 128 + 2 * lane);
        else { const unsigned u = *(const unsigned*)(zr + ZV + 2 * lane); vv.x = bf2f(u & 0xffffu); vv.y = bf2f(u >> 16); }
        if (j >= 1) *(f32x2*)(cvob + (j - 1) * 128 + 2 * lane) = vv;
#pragma unroll
        for (int hh = 0; hh < 4; ++hh) { const float pj = SC[(4 * g + hh) * 136 + j]; a0[hh] += pj * vv.x; a1[hh] += pj * vv.y; }
    }
#pragma unroll
    for (int hh = 0; hh < 4; ++hh) { OP[w * 512 + (4 * g + hh) * 64 + dd] = a0[hh]; OP[w * 512 + (4 * g + hh) * 64 + dd + 1] = a1[hh]; }
    __syncthreads();
    float o = 0.f;
#pragma unroll
    for (int ww = 0; ww < 8; ++ww) o += OP[ww * 512 + tid];
    const float q2 = wave_sum(o * o);
    if (lane == 0) RED[w] = q2;
    __syncthreads();
    float tot = 0.f;
#pragma unroll
    for (int ww = 0; ww < 8; ++ww) tot += RED[ww];
    const float rs = rsqrtf(tot * (1.0f / 512.0f) + EPS);
    MGS[(size_t)s * DM + tid] = (bf16)f2bf(o * rs * gout[tid]);
    __syncthreads();
}

__device__ __forceinline__ void sconv_unit(bool sample, int b, int t0, const bf16* Zp, bf16* MGp, const float* cw, const float* gout,
                                           const float* sbuf, float* st_out) {
    int tid_o = threadIdx.x; asm volatile("" : "+v"(tid_o)); const int tid = tid_o, w = tid >> 6, lane = tid & 63, c = 4 * lane;
    const f32x4 w0 = *(const f32x4*)(cw + c), w1 = *(const f32x4*)(cw + 256 + c), w2 = *(const f32x4*)(cw + 512 + c), gg = *(const f32x4*)(gout + 768 + c);
    for (int it = 0; it < 8; ++it) {
        const int tok = it * 8 + w;
        f32x4 vcur, vm1, vm2; size_t row;
        if (!sample) {
            const int t = t0 + tok; row = (size_t)b * SEQ + t;
            const bf16* zr = Zp + row * DIN;
            vcur = ld_bf4(zr + ZSC + c) * ld_bf4(zr + ZSU + c);
            vm1 = (f32x4){0.f, 0.f, 0.f, 0.f}; vm2 = vm1;
            if (t >= 1) vm1 = ld_bf4(zr - DIN + ZSC + c) * ld_bf4(zr - DIN + ZSU + c);
            if (t >= 2) vm2 = ld_bf4(zr - 2 * DIN + ZSC + c) * ld_bf4(zr - 2 * DIN + ZSU + c);
            if (t >= SEQ - 2) *(f32x4*)(st_out + (size_t)(b * 2 + (t - (SEQ - 2))) * 256 + c) = vcur;
        } else {
            row = t0 + tok;
            const bf16* zr = Zp + row * DIN;
            vcur = ld_bf4(zr + ZSC + c) * ld_bf4(zr + ZSU + c);
            vm2 = *(const f32x4*)(sbuf + (row * 2 + 0) * 256 + c); vm1 = *(const f32x4*)(sbuf + (row * 2 + 1) * 256 + c);
            *(f32x4*)(st_out + (row * 2 + 0) * 256 + c) = vm1; *(f32x4*)(st_out + (row * 2 + 1) * 256 + c) = vcur;
        }
        const f32x4 conv = w0 * vm2 + w1 * vm1 + w2 * vcur;
        const f32x4 co = ld_bf4(Zp + row * DIN + ZSB + c) * conv;
        const float rs = rsqrtf(wave_sum((co.x * co.x + co.y * co.y) + (co.z * co.z + co.w * co.w)) * (1.0f / 256.0f) + EPS);
        st_bf4(MGp + row * DM + 768 + c, co * gg * rs);
    }
}

struct LruW { const float *cw, *cb, *ba, *bi, *lam, *gout; const bf16* lwt; };
__device__ __forceinline__ void lru_unit(LAS unsigned char* lds, bool sample, int b, int t0, const bf16* Zp, bf16* MGp, const LruW W,
                                         float* hloc, float* cuma, float* agga, float* aggb,
                                         const float* lbuf, const float* h0, float* lc_out, float* rg_out) {
    int tid_o = threadIdx.x; asm volatile("" : "+v"(tid_o)); const int tid = tid_o, w = __builtin_amdgcn_readfirstlane(tid >> 6), lane = tid & 63;
    LAS float* XC = (LAS float*)lds;
    LAS bf16* XB = (LAS bf16*)(lds + 65536);
    LAS float* AA = (LAS float*)(lds + 65536);
    {
        const int cp = tid & 127, tg = tid >> 7, c = 2 * cp;
        const f32x2 k0 = *(const f32x2*)(W.cw + c), k1 = *(const f32x2*)(W.cw + 256 + c), k2 = *(const f32x2*)(W.cw + 512 + c), k3 = *(const f32x2*)(W.cw + 768 + c), bb = *(const f32x2*)(W.cb + c);
        if (!sample) {
            f32x2 xm3 = {0.f, 0.f}, xm2 = {0.f, 0.f}, xm1 = {0.f, 0.f};
            const int tb = t0 + 16 * tg;
            const bf16* zc = Zp + ((size_t)b * SEQ + tb) * DIN + ZLX + c;
            if (tb >= 3) { const unsigned u = *(const unsigned*)(zc - 3 * DIN); xm3 = (f32x2){bf2f(u & 0xffffu), bf2f(u >> 16)}; }
            if (tb >= 2) { const unsigned u = *(const unsigned*)(zc - 2 * DIN); xm2 = (f32x2){bf2f(u & 0xffffu), bf2f(u >> 16)}; }
            if (tb >= 1) { const unsigned u = *(const unsigned*)(zc - 1 * DIN); xm1 = (f32x2){bf2f(u & 0xffffu), bf2f(u >> 16)}; }
#pragma unroll 4
            for (int i = 0; i < 16; ++i) {
                const unsigned u = *(const unsigned*)(zc + (size_t)i * DIN); const f32x2 x = (f32x2){bf2f(u & 0xffffu), bf2f(u >> 16)};
                const f32x2 xc = k0 * xm3 + k1 * xm2 + k2 * xm1 + k3 * x + bb;
                const int tok = 16 * tg + i;
                *(LAS f32x2*)(XC + tok * 256 + c) = xc; *(LAS unsigned*)(XB + tok * 264 + c) = pk2(xc.x, xc.y);
                if (tb + i >= SEQ - 3) *(f32x2*)(lc_out + (size_t)(b * 3 + (tb + i - (SEQ - 3))) * 256 + c) = x;
                xm3 = xm2; xm2 = xm1; xm1 = x;
            }
        } else {
#pragma unroll 4
            for (int i = 0; i < 16; ++i) {
                const int tok = 16 * tg + i; const size_t s = t0 + tok;
                const unsigned u = *(const unsigned*)(Zp + s * DIN + ZLX + c); const f32x2 x = (f32x2){bf2f(u & 0xffffu), bf2f(u >> 16)};
                const f32x2 xm3 = *(const f32x2*)(lbuf + (s * 3 + 0) * 256 + c), xm2 = *(const f32x2*)(lbuf + (s * 3 + 1) * 256 + c), xm1 = *(const f32x2*)(lbuf + (s * 3 + 2) * 256 + c);
                const f32x2 xc = k0 * xm3 + k1 * xm2 + k2 * xm1 + k3 * x + bb;
                *(LAS f32x2*)(XC + tok * 256 + c) = xc; *(LAS unsigned*)(XB + tok * 264 + c) = pk2(xc.x, xc.y);
                *(f32x2*)(lc_out + (s * 3 + 0) * 256 + c) = xm2; *(f32x2*)(lc_out + (s * 3 + 1) * 256 + c) = xm1; *(f32x2*)(lc_out + (s * 3 + 2) * 256 + c) = x;
            }
        }
    }
    __syncthreads();
    const int blk = w & 3, dh = w >> 2, qi = lane & 31, hi = lane >> 5, ch = 64 * blk + 32 * dh + qi;
    f32x16 ar[2], ai[2];
    {
        bf16x8 bw[2][4];
#pragma unroll
        for (int gt = 0; gt < 2; ++gt)
#pragma unroll
            for (int st = 0; st < 4; ++st) bw[gt][st] = *(const bf16x8*)(W.lwt + ((size_t)(gt * 4 + blk) * 64 + 32 * dh + qi) * 64 + 16 * st + 8 * hi);
#pragma unroll
        for (int tt = 0; tt < 2; ++tt) {
#pragma unroll
            for (int r = 0; r < 16; ++r) { ar[tt][r] = 0.f; ai[tt][r] = 0.f; }
#pragma unroll
            for (int st = 0; st < 4; ++st) {
                const bf16x8 af = *(const LAS bf16x8*)(XB + (32 * tt + qi) * 264 + 64 * blk + 16 * st + 8 * hi);
                ar[tt] = __builtin_amdgcn_mfma_f32_32x32x16_bf16(af, bw[0][st], ar[tt], 0, 0, 0);
                ai[tt] = __builtin_amdgcn_mfma_f32_32x32x16_bf16(af, bw[1][st], ai[tt], 0, 0, 0);
            }
        }
    }
    __syncthreads();
    {
        const float ba = W.ba[ch], bi = W.bi[ch], lam = W.lam[ch];
        const float c8 = -8.0f * log1pf(__expf(-lam));
#pragma unroll
        for (int tt = 0; tt < 2; ++tt)
#pragma unroll
            for (int r = 0; r < 16; ++r) {
                const int tok = 32 * tt + 8 * (r >> 2) + 4 * hi + (r & 3);
                const float xc = XC[tok * 256 + ch];
                const float rg = sigmoidf_(ar[tt][r] + ba), ig = sigmoidf_(ai[tt][r] + bi);
                const float la = c8 * rg, a = __expf(la), mult = sqrtf(fmaxf(-expm1f(2.0f * la), 0.f));
                AA[tok * 256 + ch] = a; XC[tok * 256 + ch] = mult * ig * xc;
            }
    }
    __syncthreads();
    if (!sample) {
        if (tid < 256) {
            float hh = 0.f, cum = 1.f;
            const size_t rb = ((size_t)b * SEQ + t0) * 256 + tid;
#pragma unroll 4
            for (int tok = 0; tok < 64; ++tok) {
                const float a = AA[tok * 256 + tid]; hh = a * hh + XC[tok * 256 + tid]; cum *= a;
                hloc[rb + (size_t)tok * 256] = hh; cuma[rb + (size_t)tok * 256] = cum;
            }
            const int chunk = t0 >> 6;
            agga[(size_t)(b * 128 + chunk) * 256 + tid] = cum; aggb[(size_t)(b * 128 + chunk) * 256 + tid] = hh;
        }
    } else {
        const int c = tid & 255;
        for (int tok = (tid >> 8) * 32; tok < (tid >> 8) * 32 + 32; ++tok) {
            const size_t s = t0 + tok;
            const float hh = AA[tok * 256 + c] * h0[s * 256 + c] + XC[tok * 256 + c];
            rg_out[s * 256 + c] = hh;
            XC[tok * 256 + c] = hh * gelu_tanh(bf2f(Zp[s * DIN + ZLG + c]));
        }
        __syncthreads();
        for (int it = 0; it < 8; ++it) {
            const int tok = it * 8 + w; const size_t s = t0 + tok;
            const f32x4 v = *(const LAS f32x4*)(XC + tok * 256 + 4 * lane);
            const float rs = rsqrtf(wave_sum((v.x * v.x + v.y * v.y) + (v.z * v.z + v.w * v.w)) * (1.0f / 256.0f) + EPS);
            st_bf4(MGp + s * DM + 512 + 4 * lane, v * *(const f32x4*)(W.gout + 512 + 4 * lane) * rs);
        }
    }
    __syncthreads();
}

__device__ __forceinline__ void lru_fix_unit(LAS unsigned char* lds, int b, int chunk, const bf16* Z, bf16* MG, const float* gout,
                                             const float* hloc, const float* cuma, const float* agga, const float* aggb, float* rg_out) {
    int tid_o = threadIdx.x; asm volatile("" : "+v"(tid_o)); const int tid = tid_o, w = tid >> 6, lane = tid & 63;
    LAS float* CR = (LAS float*)lds;
    if (tid < 256) {
        float carry = 0.f;
        const float* pa = agga + (size_t)b * 128 * 256 + tid; const float* pb = aggb + (size_t)b * 128 * 256 + tid;
#pragma unroll 8
        for (int j = 0; j < chunk; ++j) carry = pa[(size_t)j * 256] * carry + pb[(size_t)j * 256];
        CR[tid] = carry;
    }
    __syncthreads();
    const f32x4 cr = *(const LAS f32x4*)(CR + 4 * lane), gg = *(const f32x4*)(gout + 512 + 4 * lane);
    for (int it = 0; it < 8; ++it) {
        const int t = chunk * 64 + it * 8 + w; const size_t row = (size_t)b * SEQ + t;
        const f32x4 hl = *(const f32x4*)(hloc + row * 256 + 4 * lane), ca = *(const f32x4*)(cuma + row * 256 + 4 * lane);
        const f32x4 hh = hl + ca * cr;
        const f32x4 gt = ld_bf4(Z + row * DIN + ZLG + 4 * lane);
        f32x4 bo; bo.x = hh.x * gelu_tanh(gt.x); bo.y = hh.y * gelu_tanh(gt.y); bo.z = hh.z * gelu_tanh(gt.z); bo.w = hh.w * gelu_tanh(gt.w);
        const float rs = rsqrtf(wave_sum((bo.x * bo.x + bo.y * bo.y) + (bo.z * bo.z + bo.w * bo.w)) * (1.0f / 256.0f) + EPS);
        st_bf4(MG + row * DM + 512 + 4 * lane, bo * gg * rs);
        if (t == SEQ - 1) *(f32x4*)(rg_out + (size_t)b * 256 + 4 * lane) = hh;
    }
    __syncthreads();
}

typedef const Args __attribute__((address_space(4))) * KArgsP;
__device__ __forceinline__ KArgsP kargs() { KArgsP p = (KArgsP)__builtin_amdgcn_kernarg_segment_ptr(); asm volatile("" : "+s"(p)); return p; }
#define IN(i) (ka->in[i])
#define WSP(T, off) ((T*)(ka->ws + (off)))
#define OUTP(off) (ka->out + (off))
#define PHASE_VARS KArgsP ka = kargs(); int tid_o = threadIdx.x; asm volatile("" : "+v"(tid_o)); const int tid = tid_o, lane = tid & 63, wave = __builtin_amdgcn_readfirstlane(tid >> 6); \
    const int G = gridDim.x, cu = blockIdx.x, gw = cu * NWAVES + wave, NGW = G * NWAVES; (void)lane; (void)gw; (void)NGW; (void)ka;

__global__ void __launch_bounds__(NTHREADS, 2) fwd_megakernel(Args args) {
    extern __shared__ __attribute__((aligned(16))) unsigned char lds_raw[];
    LAS unsigned char* lds = (LAS unsigned char*)lds_raw;
    cg::grid_group grid = cg::this_grid();

    {
        PHASE_VARS
        LAS float* scr = (LAS float*)(lds + wave * 16384);
        constexpr int I_IN = 16 * 64, I_OUT = 16 * 32, I_UP = 16 * 176, I_DN = 44 * 32, I_L = I_IN + I_OUT + I_UP + I_DN;
        for (int it = gw; it < DEPTH * I_L; it += NGW) {
            const int l = it / I_L; int r = it % I_L;
            unsigned char* wl = ka->ws + WS_W + (size_t)l * W_LAYER;
            if (r < I_IN) { transpose_item(IN(9) + (size_t)l * DM * DIN, DM, DIN, (bf16*)(wl + W_IN), 0, scr, r, lane); continue; } r -= I_IN;
            if (r < I_OUT) { transpose_item(IN(20) + (size_t)l * DM * DM, DM, DM, (bf16*)(wl + W_OUT), 0, scr, r, lane); continue; } r -= I_OUT;
            if (r < I_UP) { transpose_item(IN(22) + (size_t)l * DM * DUP, DM, DUP, (bf16*)(wl + W_UP), 1, scr, r, lane); continue; } r -= I_UP;
            transpose_item(IN(24) + (size_t)l * DFF * DM, DFF, DM, (bf16*)(wl + W_DOWN), 0, scr, r, lane);
        }
        bf16* LWT = WSP(bf16, WS_LWT);
        for (int e = cu * NTHREADS + tid; e < DEPTH * 2 * 4 * 4096; e += G * NTHREADS) {
            const int c = e & 63, d = (e >> 6) & 63, blk = (e >> 12) & 3, gt = (e >> 14) & 1, l = e >> 15;
            const float* src = gt ? IN(15) : IN(13);
            LWT[e] = (bf16)f2bf(src[((size_t)(l * 4 + blk) * 64 + c) * 64 + d]);
        }
        const float* xp = IN(0); const float* g0 = IN(8); bf16* XN = WSP(bf16, WS_XN);
        for (int m = gw; m < MP; m += NGW) rms_row_bf16(xp + (size_t)m * DM, g0, XN + (size_t)m * DM, lane);
    }
    grid.sync();

#pragma nounroll
    for (int l = 0; l < DEPTH; ++l) {
        {
            PHASE_VARS
            const bf16* Win_t = (const bf16*)(ka->ws + WS_W + (size_t)l * W_LAYER + W_IN);
            pg8::Gemm g{WSP(bf16, WS_XN), Win_t, MP, DIN, DM}; pg8::StaticOrder S; S.init(MP, DIN, G, cu);
            pg8::EpiBf16<0> E{WSP(bf16, WS_Z), DIN, nullptr, 0, 0, 1.f};
#ifndef X_G1
            pg8::gemm_phase<pg8::EpiBf16<0>, pg8::StaticOrder, true, true, false>(lds, g, S, E);
#endif
            const float* xs_in = (l == 0) ? IN(1) : WSP(float, WS_XS);
            for (int j = cu; j < 64; j += G)
                small_gemm_unit<0>(j, xs_in, IN(8) + (size_t)l * DM, Win_t, DM, WSP(bf16, WS_ZS), DIN, nullptr, nullptr, nullptr, nullptr, nullptr);
        }
        grid.sync();

        {
            PHASE_VARS
            const float* gout = IN(19) + (size_t)l * DM;
            const float* sinks = IN(10) + l * 8;
            for (int idx = cu; idx < 900; idx += G) {
                if (idx < 256) {
                    const int b = idx >> 7, qb = idx & 127;
#ifndef X_AP
                    attn_prompt_unit(lds, b, qb * 64, WSP(bf16, WS_Z), WSP(bf16, WS_MG), sinks, gout, OUTP(O_CKP) + (size_t)(l * 2 + b) * 16384, OUTP(O_CVP) + (size_t)(l * 2 + b) * 16384);
#endif
                } else if (idx < 514) {
                    LruW LW{IN(11) + (size_t)l * 4 * 256, IN(12) + (size_t)l * 256, IN(14) + (size_t)l * 256, IN(16) + (size_t)l * 256,
                            IN(17) + (size_t)l * 256, gout, WSP(bf16, WS_LWT) + (size_t)l * 2 * 4 * 4096};
                    if (idx < 512) {
                        const int u = idx - 256, b = u >> 7, chunk = u & 127;
#ifndef X_LP
                        lru_unit(lds, false, b, chunk * 64, WSP(bf16, WS_Z), WSP(bf16, WS_MG), LW, WSP(float, WS_HLOC), WSP(float, WS_CUMA), WSP(float, WS_AGGA), WSP(float, WS_AGGB),
                                 nullptr, nullptr, OUTP(O_LCP) + (size_t)l * 2 * 3 * 256, nullptr);
#endif
                    } else {
                        const int hf = idx - 512;
#ifndef X_LS
                        lru_unit(lds, true, 0, hf * 64, WSP(bf16, WS_ZS), WSP(bf16, WS_MGS), LW, nullptr, nullptr, nullptr, nullptr, IN(5) + (size_t)l * NS * 3 * 256, IN(4) + (size_t)l * NS * 256,
                                 OUTP(O_LCS) + (size_t)l * NS * 3 * 256, OUTP(O_RGS) + (size_t)l * NS * 256);
#endif
                    }
                } else if (idx < 770) {
                    const int u = idx - 514, b = u >> 7, tb = u & 127;
                    sconv_unit(false, b, tb * 64, WSP(bf16, WS_Z), WSP(bf16, WS_MG), IN(18) + (size_t)l * 3 * 256, gout, nullptr, OUTP(O_SCP) + (size_t)l * 2 * 2 * 256);
                } else if (idx < 772) {
                    const int hf = idx - 770;
                    sconv_unit(true, 0, hf * 64, WSP(bf16, WS_ZS), WSP(bf16, WS_MGS), IN(18) + (size_t)l * 3 * 256, gout, IN(6) + (size_t)l * NS * 2 * 256, OUTP(O_SCS) + (size_t)l * NS * 2 * 256);
                } else {
                    const int s = idx - 772;
#ifndef X_AS
                    attn_sample_unit(lds, s, WSP(bf16, WS_ZS), WSP(bf16, WS_MGS), sinks, gout, IN(2) + (size_t)l * NS * 16384, IN(3) + (size_t)l * NS * 16384,
                                     OUTP(O_CKS) + (size_t)l * NS * 16384, OUTP(O_CVS) + (size_t)l * NS * 16384);
#endif
                }
            }
        }
        grid.sync();

        {
            PHASE_VARS
            for (int idx = cu; idx < 256; idx += G)
                lru_fix_unit(lds, idx >> 7, idx & 127, WSP(bf16, WS_Z), WSP(bf16, WS_MG), IN(19) + (size_t)l * DM, WSP(float, WS_HLOC), WSP(float, WS_CUMA),
                             WSP(float, WS_AGGA), WSP(float, WS_AGGB), OUTP(O_RGP) + (size_t)l * 2 * 256);
        }
        grid.sync();

        {
            PHASE_VARS
            const bf16* Wout_t = (const bf16*)(ka->ws + WS_W + (size_t)l * W_LAYER + W_OUT);
            pg8::Gemm g{WSP(bf16, WS_MG), Wout_t, MP, DM, DM}; pg8::StaticOrder S; S.init(MP, DM, G, cu);
            EpiRes E{(l == 0) ? IN(0) : (const float*)OUTP(O_Y), OUTP(O_Y)};
#ifndef X_GR
            pg8::gemm_phase<EpiRes, pg8::StaticOrder, true, true, false>(lds, g, S, E);
#endif
            const float* xs_in = (l == 0) ? IN(1) : WSP(float, WS_XS);
            for (int j = cu; j < 32; j += G)
                small_gemm_unit<1>(j, WSP(bf16, WS_MGS), nullptr, Wout_t, DM, nullptr, 0, xs_in, WSP(float, WS_XS), nullptr, nullptr, nullptr);
        }
        grid.sync();

        {
            PHASE_VARS
            const float* Y = OUTP(O_Y); const float* gf = IN(21) + (size_t)l * DM; bf16* XN = WSP(bf16, WS_XN);
            for (int m = gw; m < MP; m += NGW) rms_row_bf16(Y + (size_t)m * DM, gf, XN + (size_t)m * DM, lane);
        }
        grid.sync();

        {
            PHASE_VARS
            const bf16* Wup_t = (const bf16*)(ka->ws + WS_W + (size_t)l * W_LAYER + W_UP);
            const float* fcw = IN(23) + (size_t)l * 3 * DUP;
            pg8::Gemm g{WSP(bf16, WS_XN), Wup_t, 66 * 256, DUP, DM}; pg8::StaticOrder S; S.init(66 * 256, DUP, G, cu);
            EpiFfn E{WSP(bf16, WS_ACT), fcw, OUTP(O_FFP) + (size_t)l * 2 * 2 * DUP};
#ifndef X_G3
            pg8::gemm_phase<EpiFfn, pg8::StaticOrder, true, true, true>(lds, g, S, E);
#endif
            const int nwg = 66 * 22, rem = nwg % G, n_idle = rem ? G - rem : G, first_idle = G - n_idle;
            if (cu >= first_idle)
                for (int j = cu - first_idle; j < 176; j += n_idle)
                    small_gemm_unit<2>(j, WSP(float, WS_XS), IN(21) + (size_t)l * DM, Wup_t, DM, WSP(bf16, WS_ACTS), 0, nullptr, nullptr, fcw,
                                       IN(7) + (size_t)l * NS * 2 * DUP, OUTP(O_FFS) + (size_t)l * NS * 2 * DUP);
        }
        grid.sync();

        {
            PHASE_VARS
            const bf16* Wdown_t = (const bf16*)(ka->ws + WS_W + (size_t)l * W_LAYER + W_DOWN);
            pg8::Gemm g{WSP(bf16, WS_ACT), Wdown_t, MP, DM, DFF}; pg8::StaticOrder S; S.init(MP, DM, G, cu);
            EpiRes E{OUTP(O_Y), OUTP(O_Y)};
#ifndef X_GR
            pg8::gemm_phase<EpiRes, pg8::StaticOrder, true, true, false>(lds, g, S, E);
#endif
            for (int j = cu; j < 32; j += G)
                small_gemm_unit<1>(j, WSP(bf16, WS_ACTS), nullptr, Wdown_t, DFF, nullptr, 0, WSP(float, WS_XS), WSP(float, WS_XS), nullptr, nullptr, nullptr);
        }
        grid.sync();

        {
            PHASE_VARS
            float* Y = OUTP(O_Y);
            if (l + 1 < DEPTH) {
                const float* gm = IN(8) + (size_t)(l + 1) * DM; bf16* XN = WSP(bf16, WS_XN);
                for (int m = gw; m < MP; m += NGW) rms_row_bf16(Y + (size_t)m * DM, gm, XN + (size_t)m * DM, lane);
            } else {
                const float* gfin = IN(25); const float* XS = WSP(float, WS_XS); float* ys = OUTP(O_YS);
                for (int m = gw; m < MP + NS; m += NGW) {
                    if (m < MP) rms_row_f32(Y + (size_t)m * DM, gfin, Y + (size_t)m * DM, lane);
                    else rms_row_f32(XS + (size_t)(m - MP) * DM, gfin, ys + (size_t)(m - MP) * DM, lane);
                }
            }
        }
        if (l + 1 < DEPTH) grid.sync();
    }
}

extern "C" void kernel_launch(void* const* d_in, const int* in_sizes, int n_in, void* d_out, int out_size, void* d_ws, size_t ws_size, hipStream_t stream) {
    static int grid = 0;
    if (grid == 0) {
        if (n_in != 26 || ws_size < WS_END) { fprintf(stderr, "kernel_launch: unexpected n_in %d / ws_size %zu\n", n_in, ws_size); grid = -1; return; }
        int dev = 0, cus = 0, per_cu = 0;
        hipGetDevice(&dev);
        hipDeviceGetAttribute(&cus, hipDeviceAttributeMultiprocessorCount, dev);
        hipFuncSetAttribute((const void*)fwd_megakernel, hipFuncAttributeMaxDynamicSharedMemorySize, LDS_BYTES);
        hipOccupancyMaxActiveBlocksPerMultiprocessor(&per_cu, (const void*)fwd_megakernel, NTHREADS, LDS_BYTES);
        if (per_cu < 1) per_cu = 1;
        (void)hipGetLastError();
        grid = cus;
    }
    if (grid < 0) return;
    Args a{};
    for (int i = 0; i < 26; ++i) a.in[i] = (const float*)d_in[i];
    a.out = (float*)d_out; a.ws = (unsigned char*)d_ws;
    void* kargs[] = {&a};
    hipError_t e = hipLaunchCooperativeKernel((const void*)fwd_megakernel, dim3(grid), dim3(NTHREADS), kargs, LDS_BYTES, stream);
    if (e != hipSuccess) fprintf(stderr, "cooperative launch failed: %s (grid %d)\n", hipGetErrorString(e), grid);
}
```

```cpp
#include <hip/hip_runtime.h>
#include <hip/hip_cooperative_groups.h>
#include <cstdio>
#include <cstdint>
namespace cg = cooperative_groups;
namespace pg8 {
#define PG8_LAS __attribute__((address_space(3)))
typedef unsigned short bf16_t;
typedef short bf16x8 __attribute__((ext_vector_type(8)));
typedef float f32x4 __attribute__((ext_vector_type(4)));
typedef unsigned u32x4 __attribute__((ext_vector_type(4)));
constexpr int BM = 256, BK = 64, HALF = 128, HTB = HALF * BK * 2  , STAGE_BYTES = 8 * HTB, NXCD = 8, WGM = 8;

__host__ __device__ __forceinline__ int lds_byte(int r, int c) { const int st = (r >> 4) * 2 + (c >> 5), rr = r & 15, cc = c & 31, ob = rr * 64 + cc * 2; return st * 1024 + (ob ^ (((ob >> 9) & 1) << 5)); }
__host__ __device__ __forceinline__ void stage_rc(int b, int& R, int& C) { const int st = b / 1024, sb = b % 1024, swz = sb ^ (((sb >> 9) & 1) << 5); R = (st >> 1) * 16 + swz / 64; C = (st & 1) * 32 + (swz % 64) / 2; }
__host__ __device__ __forceinline__ int perm32(int rho) { const int n = rho >> 4, i = rho & 15; return 8 * (i >> 2) + 4 * n + (i & 3); }

struct Unit { int pm, pn; };
struct Gemm { const bf16_t* A; const bf16_t* Bt; int M, N, K; };

struct StaticOrder {
    int nM, nN, nwg, G, c;
    __host__ __device__ void init(int M, int N, int G_, int c_) { nM = M / BM; nN = N / BM; nwg = nM * nN; G = G_; c = c_; }
    __host__ __device__ bool next(int i, Unit& u) const {
        const long L = (long)i * G + c; if (L >= nwg) return false;
        int wgid = (int)L; { const int q = nwg / NXCD, r = nwg % NXCD, xcd = wgid % NXCD, off = wgid / NXCD; wgid = (xcd < r ? xcd * (q + 1) : r * (q + 1) + (xcd - r) * q) + off; }
        const int nig = WGM * nN, gid = wgid / nig, fm = gid * WGM, gsz = (nM - fm) < WGM ? (nM - fm) : WGM;
        u.pm = fm + ((wgid % nig) % gsz); u.pn = (wgid % nig) / gsz; return true;
    }
    __device__ __forceinline__ void a_ready(const Unit&) const {}
    __device__ __forceinline__ void done(const Unit&) const {}
};

__device__ __forceinline__ unsigned cvt_pk_bf16(float lo, float hi) { unsigned r; asm volatile("v_cvt_pk_bf16_f32 %0, %1, %2" : "=v"(r) : "v"(lo), "v"(hi)); return r; }
typedef float f32x2 __attribute__((ext_vector_type(2)));
__device__ __forceinline__ f32x2 gelu_pk(f32x2 v) {
    const f32x2 av = __builtin_elementwise_abs(v), d = av * 0.2316418882f + 1.0f;
    f32x2 t; t.x = __builtin_amdgcn_rcpf(d.x); t.y = __builtin_amdgcn_rcpf(d.y);
    f32x2 q = t * 0.5307027145f + (-0.7265760135f); q = q * t + 0.7107068705f; q = q * t + (-0.142248368f); q = q * t + 0.127414796f; q = q * t;
    const f32x2 s = (v * v) * (-0.72134752044f);
    f32x2 e; e.x = __builtin_amdgcn_exp2f(s.x); e.y = __builtin_amdgcn_exp2f(s.y);
    const f32x2 m = v * (q * e), r = v - m;
    f32x2 o; o.x = v.x < 0.f ? m.x : r.x; o.y = v.y < 0.f ? m.y : r.y; return o;
}

template <int ACT  > struct EpiBf16 {
    static constexpr bool PERM = true, AFTER_DRAIN = false; static_assert(ACT == 0 || ACT == 1, "EpiBf16: ACT is 0 (none) or 1 (gelu_pk)");
    bf16_t* O; int ldc; const float* bias; int split_cols; size_t split_stride; float scale0;
    __device__ __forceinline__ void operator()(const f32x4 (&acc)[2][2][4][2], const Unit& u, int wr, int wc, int fr, int fq) const {
        const int row0 = u.pm * BM + wr * 64 + fr; int colt = u.pn * BM; bf16_t* base = O;
        float sc = 1.f; if (split_cols) { const int t = colt / split_cols; base += (size_t)t * split_stride; colt -= t * split_cols; if (t == 0) sc = scale0; }
        const int col0 = colt + wc * 32 + 8 * fq, bcol0 = u.pn * BM + wc * 32 + 8 * fq;
        f32x4 bv[2][2];
#pragma unroll
        for (int bj = 0; bj < 2; ++bj)
#pragma unroll
            for (int n = 0; n < 2; ++n) bv[bj][n] = bias ? *(const f32x4*)(bias + bcol0 + bj * HALF + 4 * n) : (f32x4){0.f, 0.f, 0.f, 0.f};
#pragma unroll
        for (int ai = 0; ai < 2; ++ai)
#pragma unroll
            for (int m = 0; m < 4; ++m) { bf16_t* rowp = base + (size_t)(row0 + ai * HALF + m * 16) * ldc + col0;
#pragma unroll
                for (int bj = 0; bj < 2; ++bj) { f32x4 v0 = acc[ai][bj][m][0] + bv[bj][0], v1 = acc[ai][bj][m][1] + bv[bj][1];
                    if (ACT == 1) { f32x2 a = gelu_pk((f32x2){v0[0], v0[1]}), b = gelu_pk((f32x2){v0[2], v0[3]}), c = gelu_pk((f32x2){v1[0], v1[1]}), d = gelu_pk((f32x2){v1[2], v1[3]});
                        v0 = (f32x4){a.x, a.y, b.x, b.y}; v1 = (f32x4){c.x, c.y, d.x, d.y}; }
                    v0 = v0 * sc; v1 = v1 * sc; u32x4 w; w.x = cvt_pk_bf16(v0[0], v0[1]); w.y = cvt_pk_bf16(v0[2], v0[3]); w.z = cvt_pk_bf16(v1[0], v1[1]); w.w = cvt_pk_bf16(v1[2], v1[3]);
                    *(u32x4*)(rowp + bj * HALF) = w; } }
    }
};

struct PanelStats {
    unsigned* xbuf;
    unsigned* cnt;
    unsigned* tmo;
    int ntn; float eps;
    unsigned code;
    __device__ __forceinline__ bool run(const f32x4 (&v)[2][2][4][2], const Unit& u, int wr, int wc, int fr, int fq, PG8_LAS unsigned char* lds, int wid, int lane) const {
        typedef float f32x2v __attribute__((ext_vector_type(2)));
        PG8_LAS f32x2v* P = (PG8_LAS f32x2v*)lds;
        PG8_LAS f32x2v* S = (PG8_LAS f32x2v*)(lds + 8192);
        PG8_LAS unsigned* flag = (PG8_LAS unsigned*)(lds + 8192 + 2048);
#pragma unroll
        for (int ai = 0; ai < 2; ++ai)
#pragma unroll
            for (int m = 0; m < 4; ++m) {
                float s = 0.f;
#pragma unroll
                for (int bj = 0; bj < 2; ++bj)
#pragma unroll
                    for (int n = 0; n < 2; ++n) { const f32x4 x = v[ai][bj][m][n]; s += (x[0] + x[1]) + (x[2] + x[3]); }
                s += __shfl_xor(s, 16); s += __shfl_xor(s, 32);
                const float mw = s * (1.0f / 64.0f); float q = 0.f;
#pragma unroll
                for (int bj = 0; bj < 2; ++bj)
#pragma unroll
                    for (int n = 0; n < 2; ++n) { const f32x4 d = v[ai][bj][m][n] - mw; q += (d[0] * d[0] + d[1] * d[1]) + (d[2] * d[2] + d[3] * d[3]); }
                q += __shfl_xor(q, 16); q += __shfl_xor(q, 32);
                if (fq == 0) P[(ai * HALF + wr * 64 + m * 16 + fr) * 4 + wc] = (f32x2v){mw, q};
            }
        asm volatile("s_waitcnt lgkmcnt(0)" ::: "memory"); __builtin_amdgcn_s_barrier(); asm volatile("" ::: "memory");
#if defined(BROKEN_EXCHANGE_NO_WAIT)
#warning BROKEN CONTROL BUILD: the row-statistics exchange does not wait; results are wrong by design
        if (blockIdx.x >= 64) { const long long t0_ = clock64(); while (clock64() - t0_ < 60000) __builtin_amdgcn_s_sleep(8); }
#endif
        const int row = wid * 32 + (lane & 31);
        if (lane < 32) {
            const f32x2v a = P[row * 4 + 0], b = P[row * 4 + 1], c = P[row * 4 + 2], d = P[row * 4 + 3];
            const float mt = (a.x + b.x + c.x + d.x) * 0.25f;
            const float da = a.x - mt, db = b.x - mt, dc = c.x - mt, dd = d.x - mt;
            const float m2 = (a.y + b.y) + (c.y + d.y) + 64.0f * ((da * da + db * db) + (dc * dc + dd * dd));
            unsigned long long* slot = (unsigned long long*)xbuf + ((size_t)(u.pm * BM + row) * 4 + u.pn);
            __hip_atomic_store(slot, ((unsigned long long)__float_as_uint(m2) << 32) | __float_as_uint(mt), __ATOMIC_RELAXED, __HIP_MEMORY_SCOPE_AGENT);
        }
        asm volatile("s_waitcnt vmcnt(0)" ::: "memory");
        if (lane == 0) __hip_atomic_fetch_add(cnt + 64 * u.pm, 1u, __ATOMIC_RELAXED, __HIP_MEMORY_SCOPE_AGENT);
        if (wid == 0) {
            bool dead = false; const unsigned long long t0 = __builtin_amdgcn_s_memrealtime(); const unsigned want = 8u * (unsigned)ntn;
            for (;;) {
#if defined(BROKEN_EXCHANGE_NO_WAIT)
                break;
#endif
                if ((unsigned)__builtin_amdgcn_readfirstlane(__hip_atomic_load(cnt + 64 * u.pm, __ATOMIC_RELAXED, __HIP_MEMORY_SCOPE_AGENT)) >= want) break;
                if (__builtin_amdgcn_s_memrealtime() - t0 > 2000000ull) {
                    if (lane == 0) { unsigned expect = 0u; __hip_atomic_compare_exchange_strong(tmo + 1, &expect, code | (unsigned)(u.pm & 0xff), __ATOMIC_RELAXED, __ATOMIC_RELAXED, __HIP_MEMORY_SCOPE_AGENT);
                                     __hip_atomic_store(tmo, 1u, __ATOMIC_RELAXED, __HIP_MEMORY_SCOPE_AGENT); }
                    dead = true; break; }
                __builtin_amdgcn_s_sleep(2);
            }
            __builtin_amdgcn_fence(__ATOMIC_ACQUIRE, "agent");
            if (lane == 0) flag[0] = dead ? 1u : 0u;
        }
        asm volatile("s_waitcnt vmcnt(0) lgkmcnt(0)" ::: "memory"); __builtin_amdgcn_s_barrier(); asm volatile("" ::: "memory");
        const bool bad = flag[0] != 0u;
        if (lane < 32) {
            const unsigned long long* slot = (const unsigned long long*)xbuf + (size_t)(u.pm * BM + row) * 4; float mt[4], m2[4]; float ms = 0.f;
#pragma unroll
            for (int t = 0; t < 4; ++t) { if (t < ntn) { const unsigned long long w = __hip_atomic_load(slot + t, __ATOMIC_RELAXED, __HIP_MEMORY_SCOPE_AGENT); mt[t] = __uint_as_float((unsigned)w); m2[t] = __uint_as_float((unsigned)(w >> 32)); } else { mt[t] = 0.f; m2[t] = 0.f; } ms += mt[t]; }
            const float mean = ms / (float)ntn; float q = 0.f;
#pragma unroll
            for (int t = 0; t < 4; ++t) if (t < ntn) { const float dm = mt[t] - mean; q += m2[t] + 256.0f * dm * dm; }
            S[row] = (f32x2v){mean, 1.0f / sqrtf(q / (256.0f * (float)ntn) + eps)};
        }
        asm volatile("s_waitcnt lgkmcnt(0)" ::: "memory"); __builtin_amdgcn_s_barrier(); asm volatile("" ::: "memory");
        return bad;
    }
};
struct EpiLnRes {
    static constexpr bool PERM = false, AFTER_DRAIN = true;
    const float* base; float* out; int ldc; const float* bias; PanelStats st; unsigned poison;
    __device__ __forceinline__ void fused(f32x4 (&acc)[2][2][4][2], const Unit& u, int wr, int wc, int fr, int fq, PG8_LAS unsigned char* lds, int wid, int lane) const {
        typedef float f32x2v __attribute__((ext_vector_type(2)));
        const PG8_LAS f32x2v* S = (const PG8_LAS f32x2v*)(lds + 8192);
        const int col0 = u.pn * BM + wc * 32 + 4 * fq;
#pragma unroll
        for (int bj = 0; bj < 2; ++bj)
#pragma unroll
            for (int n = 0; n < 2; ++n) { const f32x4 bv = bias ? *(const f32x4*)(bias + col0 + bj * HALF + n * 16) : (f32x4){0.f, 0.f, 0.f, 0.f};
#pragma unroll
                for (int ai = 0; ai < 2; ++ai)
#pragma unroll
                    for (int m = 0; m < 4; ++m) acc[ai][bj][m][n] += bv; }
        f32x4 pre[4][2][2];
#pragma unroll
        for (int m = 0; m < 4; ++m) { const size_t off = (size_t)(u.pm * BM + wr * 64 + m * 16 + fr) * ldc + col0;
#pragma unroll
            for (int bj = 0; bj < 2; ++bj)
#pragma unroll
                for (int n = 0; n < 2; ++n) pre[m][bj][n] = *(const f32x4*)(base + off + bj * HALF + n * 16); }
        const bool bad = st.run(acc, u, wr, wc, fr, fq, lds, wid, lane) || poison != 0u;
        const float qnan = __builtin_nanf("");
#pragma unroll
        for (int ai = 0; ai < 2; ++ai)
#pragma unroll
            for (int m = 0; m < 4; ++m) { const int r = ai * HALF + wr * 64 + m * 16 + fr; const f32x2v sr = S[r]; const size_t off = (size_t)(u.pm * BM + r) * ldc + col0;
#pragma unroll
                for (int bj = 0; bj < 2; ++bj)
#pragma unroll
                    for (int n = 0; n < 2; ++n) { const f32x4 bs = ai == 0 ? pre[m][bj][n] : *(const f32x4*)(base + off + bj * HALF + n * 16); f32x4 o = bs + (acc[ai][bj][m][n] - sr.x) * sr.y;
                        if (bad) o = (f32x4){qnan, qnan, qnan, qnan}; *(f32x4*)(out + off + bj * HALF + n * 16) = o; }
                if (m & 1) asm volatile("" ::: "memory"); }
    }
};
struct EpiLnResLn {
    static constexpr bool PERM = false, AFTER_DRAIN = true;
    const float* base; float* out; bf16_t* xn; int ldc; const float* bias; PanelStats st1, st2; unsigned poison;
    __device__ __forceinline__ void fused(f32x4 (&acc)[2][2][4][2], const Unit& u, int wr, int wc, int fr, int fq, PG8_LAS unsigned char* lds, int wid, int lane) const {
        typedef float f32x2v __attribute__((ext_vector_type(2))); typedef unsigned u32x2v __attribute__((ext_vector_type(2)));
        const PG8_LAS f32x2v* S = (const PG8_LAS f32x2v*)(lds + 8192);
        const int col0 = u.pn * BM + wc * 32 + 4 * fq;
#pragma unroll
        for (int bj = 0; bj < 2; ++bj)
#pragma unroll
            for (int n = 0; n < 2; ++n) { const f32x4 bv = bias ? *(const f32x4*)(bias + col0 + bj * HALF + n * 16) : (f32x4){0.f, 0.f, 0.f, 0.f};
#pragma unroll
                for (int ai = 0; ai < 2; ++ai)
#pragma unroll
                    for (int m = 0; m < 4; ++m) acc[ai][bj][m][n] += bv; }
        bool bad = st1.run(acc, u, wr, wc, fr, fq, lds, wid, lane) || poison != 0u;
        const float qnan = __builtin_nanf("");
#pragma unroll
        for (int ai = 0; ai < 2; ++ai)
#pragma unroll
            for (int m = 0; m < 4; ++m) { const int r = ai * HALF + wr * 64 + m * 16 + fr; const f32x2v sr = S[r]; const size_t off = (size_t)(u.pm * BM + r) * ldc + col0;
#pragma unroll
                for (int bj = 0; bj < 2; ++bj)
#pragma unroll
                    for (int n = 0; n < 2; ++n) { const f32x4 bs = *(const f32x4*)(base + off + bj * HALF + n * 16); acc[ai][bj][m][n] = bs + (acc[ai][bj][m][n] - sr.x) * sr.y; }
                asm volatile("" : "+v"(acc[ai][0][m][0]), "+v"(acc[ai][0][m][1]), "+v"(acc[ai][1][m][0]), "+v"(acc[ai][1][m][1]));
                if (m & 1) asm volatile("" ::: "memory"); }
        const bool bad1 = bad;
        bad = st2.run(acc, u, wr, wc, fr, fq, lds, wid, lane) || bad;
#pragma unroll
        for (int ai = 0; ai < 2; ++ai)
#pragma unroll
            for (int m = 0; m < 4; ++m) { const int r = ai * HALF + wr * 64 + m * 16 + fr; const f32x2v sr = S[r]; const size_t off = (size_t)(u.pm * BM + r) * ldc + col0;
#pragma unroll
                for (int bj = 0; bj < 2; ++bj)
#pragma unroll
                    for (int n = 0; n < 2; ++n) { const f32x4 x1 = acc[ai][bj][m][n]; *(f32x4*)(out + off + bj * HALF + n * 16) = bad1 ? (f32x4){qnan, qnan, qnan, qnan} : x1;
                        const f32x4 o = (x1 - sr.x) * sr.y; u32x2v w; w.x = cvt_pk_bf16(o[0], o[1]); w.y = cvt_pk_bf16(o[2], o[3]);
                        if (bad) { w.x = 0x7fc07fc0u; w.y = 0x7fc07fc0u; } *(u32x2v*)(xn + off + bj * HALF + n * 16) = w; }
                asm volatile("" ::: "memory"); }
    }
};

template <class Epi, class Sched, bool ALIGN_EPI = false, bool SP2 = false, bool AMAP = false, bool XPRE = false>
__device__ __forceinline__ void gemm_phase(PG8_LAS unsigned char* lds, const Gemm g, const Sched& S, const Epi& E) {
    int tid_o = threadIdx.x; asm volatile("" : "+v"(tid_o)); const int tid = tid_o, wid = __builtin_amdgcn_readfirstlane(tid >> 6), lane = tid & 63, wr = wid >> 2, wc = wid & 3, fr = lane & 15, fq = lane >> 4;
    const int K = g.K, nt = K / BK;
    unsigned voffA[2], voffB[2];
#pragma unroll
    for (int i = 0; i < 2; ++i) { int R, C; stage_rc(tid * 16 + i * 8192, R, C); const int Rb = Epi::PERM ? ((R & ~31) + perm32(R & 31)) : R;
        const int Ra = AMAP ? ((R >> 6) * 126 + 8 * (R & 15) + ((R >> 4) & 3)) : R;
        voffA[i] = (unsigned)(Ra * K + C) * 2u; voffB[i] = (unsigned)(Rb * K + C) * 2u; }
    const size_t kstep = (size_t)(BK * 2);
    const size_t hstep = (size_t)HALF * K * 2;
    const size_t tstep = 2 * hstep;
    const size_t hstepA = AMAP ? (size_t)4 * K * 2 : hstep;
#define PG8_AROW(pm) (AMAP ? ((long)((pm) / 33) * 8192 + (long)((pm) % 33) * 252 - 2) : (long)(pm) * 256)
    const unsigned ldsw = (unsigned)wid * 1024u;
    const int aoff = lds_byte(wr * 64 + fr, fq * 8), boff = lds_byte(wc * 32 + fr, fq * 8);
#define PG8_SA(b, h) (((b) * 2 + (h)) * HTB)
#define PG8_SB(b, h) ((4 + (b) * 2 + (h)) * HTB)
#define PG8_STAGE(bufoff, gbase, voff) do { _Pragma("unroll") for (int _i = 0; _i < 2; ++_i) \
        __builtin_amdgcn_global_load_lds((const unsigned*)((const char*)(gbase) + (voff)[_i]), (PG8_LAS unsigned*)(lds + (bufoff) + ldsw + _i * 8192), 16, 0, 0); } while (0)
#define PG8_LDA(dst, b, h) do { _Pragma("unroll") for (int m = 0; m < 4; ++m) _Pragma("unroll") for (int k = 0; k < 2; ++k) dst[m][k] = *(const PG8_LAS bf16x8*)(lds + PG8_SA(b, h) + aoff + m * 2048 + k * 1024); } while (0)
#define PG8_LDB(dst, b, h) do { _Pragma("unroll") for (int n = 0; n < 2; ++n) _Pragma("unroll") for (int k = 0; k < 2; ++k) dst[n][k] = *(const PG8_LAS bf16x8*)(lds + PG8_SB(b, h) + boff + n * 2048 + k * 1024); } while (0)
#define PG8_MMA(ai, bj, At, Bt) do { __builtin_amdgcn_s_setprio(1); _Pragma("unroll") for (int m = 0; m < 4; ++m) _Pragma("unroll") for (int n = 0; n < 2; ++n) _Pragma("unroll") for (int k = 0; k < 2; ++k) \
        acc[ai][bj][m][n] = __builtin_amdgcn_mfma_f32_16x16x32_bf16(Bt[n][k], At[m][k], acc[ai][bj][m][n], 0, 0, 0); __builtin_amdgcn_s_setprio(0); } while (0)
#define PG8_WAIT_V(n) asm volatile("s_waitcnt vmcnt(" #n ")" ::: "memory")
#define PG8_WAIT_L(n) asm volatile("s_waitcnt lgkmcnt(" #n ")" ::: "memory")
#define PG8_BAR __builtin_amdgcn_s_barrier()
#define PG8_SCHED __builtin_amdgcn_sched_barrier(0)
    Unit cur, nxt; int ui = 0;
    if (!S.next(0, cur)) return;
    f32x4 acc[2][2][4][2];
#pragma unroll
    for (int a = 0; a < 2; ++a)
#pragma unroll
        for (int b = 0; b < 2; ++b)
#pragma unroll
            for (int m = 0; m < 4; ++m)
#pragma unroll
                for (int n = 0; n < 2; ++n) acc[a][b][m][n] = (f32x4){0.f, 0.f, 0.f, 0.f};
    bf16x8 At[4][2], B0[2][2], B1[2][2];
    const char* cA = (const char*)g.A + PG8_AROW(cur.pm) * (long)K * 2; const char* cB = (const char*)g.Bt + (size_t)cur.pn * tstep;
    S.a_ready(cur);
    if constexpr (SP2) {
        PG8_STAGE(PG8_SB(0, 0), cB, voffB); PG8_STAGE(PG8_SB(0, 1), cB + hstep, voffB); PG8_STAGE(PG8_SA(0, 0), cA, voffA); PG8_STAGE(PG8_SA(0, 1), cA + hstepA, voffA);
        if (wr == 1) PG8_BAR;
        PG8_WAIT_V(2); PG8_BAR;
        PG8_STAGE(PG8_SB(1, 0), cB + kstep, voffB); PG8_STAGE(PG8_SA(1, 0), cA + kstep, voffA); PG8_STAGE(PG8_SB(1, 1), cB + hstep + kstep, voffB);
        PG8_WAIT_V(6); PG8_BAR;
    } else {
        PG8_STAGE(PG8_SB(0, 0), cB, voffB); PG8_STAGE(PG8_SA(0, 0), cA, voffA); PG8_STAGE(PG8_SB(0, 1), cB + hstep, voffB); PG8_STAGE(PG8_SA(0, 1), cA + hstepA, voffA);
        if (wr == 1) PG8_BAR;
        PG8_WAIT_V(4); PG8_BAR;
        PG8_STAGE(PG8_SB(1, 0), cB + kstep, voffB); PG8_STAGE(PG8_SA(1, 0), cA + kstep, voffA); PG8_STAGE(PG8_SB(1, 1), cB + hstep + kstep, voffB);
        PG8_WAIT_V(6); PG8_BAR;
    }
    for (;;) {
        const bool has_next = S.next(ui + 1, nxt);
        const char* nA = has_next ? (const char*)g.A + PG8_AROW(nxt.pm) * (long)K * 2 : cA; const char* nB = has_next ? (const char*)g.Bt + (size_t)nxt.pn * tstep : cB;
        for (int t = 0; t < nt; t += 2) {
            const bool last = (t == nt - 2);
            const bool xl = XPRE && last && !has_next;
            unsigned vx0 = 0u, vx1 = 0u; const char* xb = nullptr;
            if constexpr (XPRE) { if (xl) { int t_ = threadIdx.x; asm volatile("" : "+v"(t_)); int R_, C_; stage_rc(t_ * 16, R_, C_); vx0 = (unsigned)(R_ * 1024 + C_) * 2u; stage_rc(t_ * 16 + 8192, R_, C_); vx1 = (unsigned)(R_ * 1024 + C_) * 2u;
                xb = (const char*)E.X + ((size_t)cur.pm * 256 * 1024 + (size_t)cur.pn * 256) * 2; } }
#define PG8_STAGE_X(bufoff, q) do { const char* _g = xb + ((size_t)((q) & 1) * 128 * 1024 + (size_t)((q) >> 1) * 64) * 2; \
        __builtin_amdgcn_global_load_lds((const unsigned*)(_g + vx0), (PG8_LAS unsigned*)(lds + (bufoff) + ldsw), 16, 0, 0); \
        __builtin_amdgcn_global_load_lds((const unsigned*)(_g + vx1), (PG8_LAS unsigned*)(lds + (bufoff) + ldsw + 8192), 16, 0, 0); } while (0)
            const char* a1 = cA + (size_t)(t + 1) * kstep;
            const char* a2 = last ? nA : cA + (size_t)(t + 2) * kstep; const char* b2 = last ? nB : cB + (size_t)(t + 2) * kstep;
            const char* a3 = a2 + kstep; const char* b3 = b2 + kstep;
            if (last && has_next) S.a_ready(nxt);
            if constexpr (SP2) {
            PG8_LDB(B0, 0, 0); PG8_LDB(B1, 0, 1); PG8_SCHED; PG8_LDA(At, 0, 0); PG8_STAGE(PG8_SA(1, 1), a1 + hstepA, voffA);
            PG8_WAIT_V(8); PG8_WAIT_L(0); PG8_BAR; PG8_MMA(0, 0, At, B0); PG8_MMA(0, 1, At, B1); PG8_BAR; PG8_SCHED;
            PG8_LDA(At, 0, 1); if (xl) { PG8_STAGE_X(PG8_SB(0, 0), 0); PG8_STAGE_X(PG8_SB(0, 1), 1); PG8_STAGE_X(PG8_SA(0, 0), 2); } else { PG8_STAGE(PG8_SB(0, 0), b2, voffB); PG8_STAGE(PG8_SB(0, 1), b2 + hstep, voffB); PG8_STAGE(PG8_SA(0, 0), a2, voffA); }
            PG8_WAIT_V(8); PG8_WAIT_L(0); PG8_BAR; PG8_MMA(1, 0, At, B0); PG8_MMA(1, 1, At, B1); PG8_BAR; PG8_SCHED;
            PG8_LDB(B0, 1, 0); PG8_LDB(B1, 1, 1); PG8_SCHED; PG8_LDA(At, 1, 0); if (xl) { PG8_STAGE_X(PG8_SA(0, 1), 3); } else { PG8_STAGE(PG8_SA(0, 1), a2 + hstepA, voffA); }
            PG8_WAIT_V(8); PG8_WAIT_L(0); PG8_BAR; PG8_MMA(0, 0, At, B0); PG8_MMA(0, 1, At, B1); PG8_BAR; PG8_SCHED;
            PG8_LDA(At, 1, 1); if (xl) { PG8_STAGE_X(PG8_SB(1, 0), 4); PG8_STAGE_X(PG8_SB(1, 1), 5); PG8_STAGE_X(PG8_SA(1, 0), 6); } else { PG8_STAGE(PG8_SB(1, 0), b3, voffB); PG8_STAGE(PG8_SB(1, 1), b3 + hstep, voffB); PG8_STAGE(PG8_SA(1, 0), a3, voffA); }
            PG8_WAIT_V(8); PG8_WAIT_L(0); PG8_BAR; PG8_MMA(1, 0, At, B0); PG8_MMA(1, 1, At, B1); PG8_BAR; PG8_SCHED;
            } else {
            PG8_LDB(B0, 0, 0); PG8_SCHED; PG8_LDA(At, 0, 0); PG8_STAGE(PG8_SA(1, 1), a1 + hstepA, voffA);
            PG8_WAIT_L(8); PG8_BAR; PG8_WAIT_L(0); PG8_MMA(0, 0, At, B0); PG8_BAR; PG8_SCHED;
            PG8_LDB(B1, 0, 1); PG8_STAGE(PG8_SB(0, 0), b2, voffB);
            PG8_BAR; PG8_WAIT_L(0); PG8_MMA(0, 1, At, B1); PG8_BAR;
            PG8_LDA(At, 0, 1); PG8_STAGE(PG8_SA(0, 0), a2, voffA);
            PG8_BAR; PG8_WAIT_L(0); PG8_MMA(1, 0, At, B0); PG8_BAR; PG8_SCHED;
            PG8_STAGE(PG8_SB(0, 1), b2 + hstep, voffB);
            PG8_WAIT_V(6); PG8_BAR; PG8_MMA(1, 1, At, B1); PG8_BAR;
            PG8_LDB(B0, 1, 0); PG8_SCHED; PG8_LDA(At, 1, 0); PG8_STAGE(PG8_SA(0, 1), a2 + hstepA, voffA);
            PG8_WAIT_L(8); PG8_BAR; PG8_WAIT_L(0); PG8_MMA(0, 0, At, B0); PG8_BAR; PG8_SCHED;
            PG8_LDB(B1, 1, 1); PG8_STAGE(PG8_SB(1, 0), b3, voffB);
            PG8_BAR; PG8_WAIT_L(0); PG8_MMA(0, 1, At, B1); PG8_BAR;
            PG8_LDA(At, 1, 1); PG8_STAGE(PG8_SA(1, 0), a3, voffA);
            PG8_BAR; PG8_WAIT_L(0); PG8_MMA(1, 0, At, B0); PG8_BAR; PG8_SCHED;
            PG8_STAGE(PG8_SB(1, 1), b3 + hstep, voffB);
            PG8_WAIT_V(6); PG8_BAR; PG8_MMA(1, 1, At, B1); PG8_BAR;
            }
        }
        if constexpr (ALIGN_EPI) { if (wr == 0) PG8_BAR; }
        if constexpr (!Epi::AFTER_DRAIN) { E(acc, cur, wr, wc, fr, fq); S.done(cur); }
        if (!has_next) break;
#pragma unroll
        for (int a = 0; a < 2; ++a)
#pragma unroll
            for (int b = 0; b < 2; ++b)
#pragma unroll
                for (int m = 0; m < 4; ++m)
#pragma unroll
                    for (int n = 0; n < 2; ++n) acc[a][b][m][n] = (f32x4){0.f, 0.f, 0.f, 0.f};
        cur = nxt; cA = nA; cB = nB; ++ui;
        if constexpr (ALIGN_EPI) { if (wr == 1) PG8_BAR; }
    }
    PG8_WAIT_V(0);
    if constexpr (!ALIGN_EPI) { if (wr == 0) PG8_BAR; }
    PG8_BAR;
    if constexpr (Epi::AFTER_DRAIN) { E.fused(acc, cur, wr, wc, fr, fq, lds, wid, lane); S.done(cur); }
#undef PG8_AROW
#undef PG8_STAGE_X
#undef PG8_SA
#undef PG8_SB
#undef PG8_STAGE
#undef PG8_LDA
#undef PG8_LDB
#undef PG8_MMA
#undef PG8_WAIT_V
#undef PG8_WAIT_L
#undef PG8_BAR
#undef PG8_SCHED
}
}

#define GAS __attribute__((address_space(1)))
#define LAS __attribute__((address_space(3)))
typedef unsigned short bf16;
typedef float f32x4 __attribute__((ext_vector_type(4)));
typedef float f32x2 __attribute__((ext_vector_type(2)));
typedef float f32x16 __attribute__((ext_vector_type(16)));
typedef short bf16x8 __attribute__((ext_vector_type(8)));
typedef unsigned u32x4 __attribute__((ext_vector_type(4)));
typedef unsigned u32x2 __attribute__((ext_vector_type(2)));

constexpr int DM = 1024, SEQ = 8192, NBATCH = 2, MP = NBATCH * SEQ, NS = 128, DEPTH = 4;
constexpr int DIN = 2048, DFF = 2816, DUP = 5632, DLRU = 256;
constexpr float EPS = 1e-6f;
constexpr int NWAVES = 8, NTHREADS = 512;
constexpr int LDS_BYTES = 147456;
constexpr int ZQ = 0, ZK = 512, ZV = 640, ZLX = 768, ZLG = 1024, ZSB = 1280, ZSC = 1536, ZSU = 1792;
constexpr size_t O_Y = 0, O_YS = 16777216, O_CKP = 16908288, O_CVP = 17039360, O_RGP = 17170432, O_LCP = 17172480, O_SCP = 17178624,
                 O_FFP = 17182720, O_CKS = 17272832, O_CVS = 25661440, O_RGS = 34050048, O_LCS = 34181120, O_SCS = 34574336, O_FFS = 34836480;
constexpr size_t MiB = 1u << 20;
constexpr size_t WS_LWT = 1 * MiB;
constexpr size_t WS_W = 2 * MiB, W_LAYER = 23592960;
constexpr size_t W_IN = 0, W_OUT = 4 * MiB, W_UP = 6 * MiB, W_DOWN = 17 * MiB;
constexpr size_t WS_XS = 92 * MiB;
constexpr size_t WS_ZS = WS_XS + 512 * 1024;
constexpr size_t WS_MGS = WS_ZS + 512 * 1024;
constexpr size_t WS_ACTS = WS_MGS + 256 * 1024;
constexpr size_t WS_XSB = WS_ACTS + 768 * 1024;
constexpr size_t WS_AGGA = 95 * MiB, WS_AGGB = 95 * MiB + 512 * 1024;
constexpr size_t WS_Z = 96 * MiB;
constexpr size_t WS_MG = 160 * MiB;
constexpr size_t WS_HLOC = 192 * MiB, WS_CUMA = 208 * MiB;
constexpr size_t WS_XN = 192 * MiB;
constexpr size_t WS_ACT = 226 * MiB;
constexpr size_t WS_SSQA = 94 * MiB + 256 * 1024 + 4096, WS_SSQB = 94 * MiB + 640 * 1024 + 4096;
constexpr size_t WS_X = 316 * MiB + 64 * 1024;
constexpr size_t WS_END = 349 * MiB;

__device__ __forceinline__ float bf2f(unsigned v) { return __uint_as_float(v << 16); }
__device__ __forceinline__ unsigned f2bf(float f) { unsigned u = __float_as_uint(f); return (u + 0x7fffu + ((u >> 16) & 1u)) >> 16; }
__device__ __forceinline__ unsigned pk2(float lo, float hi) { unsigned r; asm volatile("v_cvt_pk_bf16_f32 %0, %1, %2" : "=v"(r) : "v"(lo), "v"(hi)); return r; }
__device__ __forceinline__ float wave_sum(float v) {
#pragma unroll
    for (int o = 1; o < 64; o <<= 1) v += __shfl_xor(v, o);
    return v;
}
__device__ __forceinline__ float wave_max(float v) {
#pragma unroll
    for (int o = 1; o < 64; o <<= 1) v = fmaxf(v, __shfl_xor(v, o));
    return v;
}
__device__ __forceinline__ float sigmoidf_(float x) { return __builtin_amdgcn_rcpf(1.0f + __builtin_amdgcn_exp2f(-1.4426950408889634f * x)); }
__device__ __forceinline__ float gelu_tanh(float x) { const float u = 0.7978845608028654f * (x + 0.044715f * x * x * x); return x * __builtin_amdgcn_rcpf(1.0f + __builtin_amdgcn_exp2f(-2.8853900817779268f * u)); }
__device__ __forceinline__ f32x4 ld_bf4(const bf16* p) { const u32x2 w = *(const u32x2*)p; return (f32x4){bf2f(w.x & 0xffffu), bf2f(w.x >> 16), bf2f(w.y & 0xffffu), bf2f(w.y >> 16)}; }
__device__ __forceinline__ void st_bf4(bf16* p, f32x4 v) { u32x2 w; w.x = pk2(v.x, v.y); w.y = pk2(v.z, v.w); *(u32x2*)p = w; }

struct Args { const float* in[26]; float* out; unsigned char* ws; };

struct EpiZ {
    static constexpr bool PERM = true, AFTER_DRAIN = false;
    bf16* O; const float* ssq;
    __device__ __forceinline__ void operator()(const pg8::f32x4 (&acc)[2][2][4][2], const pg8::Unit& u, int wr, int wc, int fr, int fq) const {
        const int row0 = u.pm * 256 + wr * 64 + fr, col0 = u.pn * 256 + wc * 32 + 8 * fq;
#pragma unroll
        for (int ai = 0; ai < 2; ++ai)
#pragma unroll
            for (int m = 0; m < 4; ++m) {
                const int row = row0 + ai * 128 + m * 16;
                const f32x4 sq = *(const f32x4*)(ssq + 4 * (size_t)row);
                const float rs = __builtin_amdgcn_rsqf(((sq.x + sq.y) + (sq.z + sq.w)) * (1.0f / DM) + EPS);
                bf16* rowp = O + (size_t)row * DIN + col0;
#pragma unroll
                for (int bj = 0; bj < 2; ++bj) {
                    const f32x4 v0 = acc[ai][bj][m][0] * rs, v1 = acc[ai][bj][m][1] * rs;
                    u32x4 w; w.x = pk2(v0[0], v0[1]); w.y = pk2(v0[2], v0[3]); w.z = pk2(v1[0], v1[1]); w.w = pk2(v1[2], v1[3]);
                    *(u32x4*)(rowp + bj * 128) = w;
                }
            }
    }
};
struct EpiRes {
    static constexpr bool PERM = true, AFTER_DRAIN = false;
    bf16* X; float* ssq_out; LAS float* P;
    LAS unsigned char* ring; bool xpre;
    __device__ __forceinline__ void operator()(const pg8::f32x4 (&acc)[2][2][4][2], const pg8::Unit& u, int wr, int wc, int fr, int fq) const {
        const int row0 = u.pm * 256 + wr * 64 + fr, col0 = u.pn * 256 + wc * 32 + 8 * fq;
        if (xpre) { asm volatile("s_waitcnt vmcnt(0)" ::: "memory"); __builtin_amdgcn_s_barrier(); asm volatile("" ::: "memory"); }
#pragma unroll
        for (int ai = 0; ai < 2; ++ai) {
            u32x4 xin[4][2];
#pragma unroll
            for (int m = 0; m < 4; ++m)
#pragma unroll
                for (int bj = 0; bj < 2; ++bj) {
                    const int q = 2 * (2 * bj + (wc >> 1)) + ai;
                    if (xpre && q < 7) {
                        const int boff = (q == 0 ? 4 : q == 1 ? 5 : q == 2 ? 0 : q == 3 ? 1 : q == 4 ? 6 : q == 5 ? 7 : 2) * 16384;
                        xin[m][bj] = *(const LAS u32x4*)(ring + boff + pg8::lds_byte(wr * 64 + m * 16 + fr, (wc & 1) * 32 + 8 * fq));
                    } else xin[m][bj] = *(const u32x4*)(X + (size_t)(row0 + ai * 128 + m * 16) * DM + col0 + bj * 128);
                }
#pragma unroll
            for (int m = 0; m < 4; ++m) {
                const int row = row0 + ai * 128 + m * 16;
                float q = 0.f;
#pragma unroll
                for (int bj = 0; bj < 2; ++bj) {
                    const u32x4 xi = xin[m][bj];
                    const f32x4 a0 = acc[ai][bj][m][0], a1 = acc[ai][bj][m][1];
                    const float y0 = bf2f(xi.x & 0xffffu) + a0[0], y1 = bf2f(xi.x >> 16) + a0[1], y2 = bf2f(xi.y & 0xffffu) + a0[2], y3 = bf2f(xi.y >> 16) + a0[3];
                    const float y4 = bf2f(xi.z & 0xffffu) + a1[0], y5 = bf2f(xi.z >> 16) + a1[1], y6 = bf2f(xi.w & 0xffffu) + a1[2], y7 = bf2f(xi.w >> 16) + a1[3];
                    q += (y0 * y0 + y1 * y1) + (y2 * y2 + y3 * y3) + (y4 * y4 + y5 * y5) + (y6 * y6 + y7 * y7);
                    u32x4 w; w.x = pk2(y0, y1); w.y = pk2(y2, y3); w.z = pk2(y4, y5); w.w = pk2(y6, y7);
                    *(u32x4*)(X + (size_t)row * DM + col0 + bj * 128) = w;
                }
                q += __shfl_xor(q, 16); q += __shfl_xor(q, 32);
                if (fq == 0) P[(ai * 128 + wr * 64 + m * 16 + fr) * 4 + wc] = q;
            }
        }
        asm volatile("s_waitcnt lgkmcnt(0)" ::: "memory"); __builtin_amdgcn_s_barrier(); asm volatile("" ::: "memory");
        const int t = (wr * 4 + wc) * 64 + fq * 16 + fr;
        if (t < 256) { const f32x4 v = *(const LAS f32x4*)(P + 4 * t); ssq_out[(size_t)(u.pm * 256 + t) * 4 + u.pn] = (v.x + v.y) + (v.z + v.w); }
    }
};
struct EpiFfn {
    static constexpr bool PERM = true, AFTER_DRAIN = false;
    bf16* act; const float* cw; float* st_out; const float* ssq;
    __device__ __forceinline__ void operator()(const pg8::f32x4 (&acc)[2][2][4][2], const pg8::Unit& u, int wr, int wc, int fr, int fq) const {
        const int bb = u.pm / 33, tt = u.pm % 33;
        const int t0 = tt * 252 + wr * 126 - 2 + 8 * fr;
        float rs[8];
#pragma unroll
        for (int j = 0; j < 8; ++j) { const f32x4 sq = *(const f32x4*)(ssq + 4 * (long)(bb * SEQ + t0 + j)); rs[j] = __builtin_amdgcn_rsqf(((sq.x + sq.y) + (sq.z + sq.w)) * (1.0f / DM) + EPS); }
#define DPP_SHR1(x) __builtin_bit_cast(float, __builtin_amdgcn_update_dpp(0, __builtin_bit_cast(int, (float)(x)), 0x111, 0xf, 0xf, true))
        const float rs6p = DPP_SHR1(rs[6]), rs7p = DPP_SHR1(rs[7]);
        const bool kill = (tt == 0) && (wr == 0) && (fr == 0);
        const int cu = u.pn * 128 + wc * 32 + 8 * fq;
        u32x4 outw[8];
#pragma unroll
        for (int n = 0; n < 2; ++n) {
            const int cn = cu + 4 * n;
            const f32x4 w0u = *(const f32x4*)(cw + cn), w1u = *(const f32x4*)(cw + DUP + cn), w2u = *(const f32x4*)(cw + 2 * DUP + cn);
            const f32x4 w0g = *(const f32x4*)(cw + DFF + cn), w1g = *(const f32x4*)(cw + DUP + DFF + cn), w2g = *(const f32x4*)(cw + 2 * DUP + DFF + cn);
            f32x4 pu6, pu7, pg6, pg7;
#pragma unroll
            for (int e = 0; e < 4; ++e) {
                pu6[e] = DPP_SHR1(acc[1][0][2][n][e]) * rs6p; pu7[e] = DPP_SHR1(acc[1][0][3][n][e]) * rs7p;
                pg6[e] = DPP_SHR1(acc[1][1][2][n][e]) * rs6p; pg7[e] = DPP_SHR1(acc[1][1][3][n][e]) * rs7p;
            }
            typedef float f2 __attribute__((ext_vector_type(2)));
            const f2 w0ua = w0u.xy, w0ub = w0u.zw, w1ua = w1u.xy, w1ub = w1u.zw, w2ua = w2u.xy, w2ub = w2u.zw;
            const f2 w0ga = w0g.xy, w0gb = w0g.zw, w1ga = w1g.xy, w1gb = w1g.zw, w2ga = w2g.xy, w2gb = w2g.zw;
            f2 um2a = pu6.xy, um2b = pu6.zw, um1a = pu7.xy, um1b = pu7.zw, gm2a = pg6.xy, gm2b = pg6.zw, gm1a = pg7.xy, gm1b = pg7.zw;
#pragma unroll
            for (int j = 0; j < 8; ++j) {
                const f32x4 au = acc[j >> 2][0][j & 3][n], ag = acc[j >> 2][1][j & 3][n];
                const f2 rsv = (f2){rs[j], rs[j]};
                f2 Ua = au.xy * rsv, Ub = au.zw * rsv, Ga = ag.xy * rsv, Gb = ag.zw * rsv;
                const int t = t0 + j;
                if (j < 2) { const f2 z = (f2){0.f, 0.f}; Ua = kill ? z : Ua; Ub = kill ? z : Ub; Ga = kill ? z : Ga; Gb = kill ? z : Gb; }
                const f2 uca = __builtin_elementwise_fma(w0ua, um2a, __builtin_elementwise_fma(w1ua, um1a, w2ua * Ua));
                const f2 ucb = __builtin_elementwise_fma(w0ub, um2b, __builtin_elementwise_fma(w1ub, um1b, w2ub * Ub));
                const f2 gca = __builtin_elementwise_fma(w0ga, gm2a, __builtin_elementwise_fma(w1ga, gm1a, w2ga * Ga));
                const f2 gcb = __builtin_elementwise_fma(w0gb, gm2b, __builtin_elementwise_fma(w1gb, gm1b, w2gb * Gb));
                const f2 nl = (f2){-1.4426950408889634f, -1.4426950408889634f}, one = (f2){1.f, 1.f};
                const f2 xa = gca * nl, xb = gcb * nl;
                f2 ea, eb; ea.x = __builtin_amdgcn_exp2f(xa.x); ea.y = __builtin_amdgcn_exp2f(xa.y); eb.x = __builtin_amdgcn_exp2f(xb.x); eb.y = __builtin_amdgcn_exp2f(xb.y);
                const f2 da = ea + one, db = eb + one;
                f2 ra, rb; ra.x = __builtin_amdgcn_rcpf(da.x); ra.y = __builtin_amdgcn_rcpf(da.y); rb.x = __builtin_amdgcn_rcpf(db.x); rb.y = __builtin_amdgcn_rcpf(db.y);
                const f2 oa = (uca * gca) * ra, ob = (ucb * gcb) * rb;
                if (n == 0) { outw[j].x = pk2(oa.x, oa.y); outw[j].y = pk2(ob.x, ob.y); } else { outw[j].z = pk2(oa.x, oa.y); outw[j].w = pk2(ob.x, ob.y); }
                if (t >= SEQ - 2 && t < SEQ && (8 * fr + j >= 2)) {
                    float* so = st_out + (size_t)(bb * 2 + (t - (SEQ - 2))) * DUP + cn;
                    *(f32x4*)so = (f32x4){Ua.x, Ua.y, Ub.x, Ub.y}; *(f32x4*)(so + DFF) = (f32x4){Ga.x, Ga.y, Gb.x, Gb.y};
                }
                um2a = um1a; um2b = um1b; um1a = Ua; um1b = Ub; gm2a = gm1a; gm2b = gm1b; gm1a = Ga; gm1b = Gb;
            }
        }
#pragma unroll
        for (int j = 0; j < 8; ++j) {
            const int t = t0 + j;
            if ((8 * fr + j >= 2) && (t < SEQ)) *(u32x4*)(act + (size_t)(bb * SEQ + t) * DFF + cu) = outw[j];
        }
    }
};

constexpr int SG_PITCH = 2832;
template <int MODE>
__device__ __forceinline__ void small_gemm_unit(LAS unsigned char* lds, int j, const bf16* Ap, const bf16* Bt, int K,
                                                bf16* obf, int ldo, const float* base, float* outf,
                                                const float* cw, const float* fbuf, float* fst) {
    int tid_o = threadIdx.x; asm volatile("" : "+v"(tid_o)); const int tid = tid_o, w = tid >> 6, lane = tid & 63, fr = lane & 15, fq = lane >> 4;
    const int row = 16 * w + fr;
    int bn0, bn1;
    if (MODE == 2) { bn0 = 256 * ((16 * j) / 128) + ((16 * j) % 128); bn1 = bn0 + 128; } else { bn0 = 32 * j; bn1 = bn0 + 16; }
    pg8::f32x4 acc0 = {0.f, 0.f, 0.f, 0.f}, acc1 = {0.f, 0.f, 0.f, 0.f};
    float ssq = 0.f;
    const bf16* ap = Ap + (size_t)row * K + 8 * fq;
    const int KC = (K > 1024) ? 1408 : 1024;
    for (int kc = 0; kc < K; kc += KC) {
        const int kl = (K - kc) < KC ? (K - kc) : KC, parts = kl >> 3;
        u32x4 af[16];
#pragma unroll
        for (int i = 0; i < 16; ++i) af[i] = *(const u32x4*)(ap + kc + 32 * i);
        __syncthreads();
        {
            u32x4 sg[11];
#pragma unroll
            for (int i = 0; i < 11; ++i) {
                const int c = tid + NTHREADS * i;
                if (c < 32 * parts) { const int r = c / parts, p = c - r * parts; sg[i] = *(const u32x4*)(Bt + (size_t)((r < 16 ? bn0 + r : bn1 + r - 16)) * K + kc + 8 * p); }
            }
#pragma unroll
            for (int i = 0; i < 11; ++i) {
                const int c = tid + NTHREADS * i;
                if (c < 32 * parts) { const int r = c / parts, p = c - r * parts; *(LAS u32x4*)(lds + r * SG_PITCH + 16 * p) = sg[i]; }
            }
        }
        __syncthreads();
        const LAS unsigned char* b0p = lds + fr * SG_PITCH + 16 * fq;
        const LAS unsigned char* b1p = lds + (16 + fr) * SG_PITCH + 16 * fq;
        for (int g0 = 0; g0 < kl; g0 += 512) {
            const int nst = (kl - g0) < 512 ? ((kl - g0) >> 5) : 16;
            if (g0 > 0) {
#pragma unroll
                for (int i = 0; i < 16; ++i) if (i < nst) af[i] = *(const u32x4*)(ap + kc + g0 + 32 * i);
            }
#pragma unroll
            for (int i = 0; i < 16; ++i) {
                if (i < nst) {
                    const u32x4 au = af[i];
                    if (MODE != 1) {
                        const float x0 = bf2f(au.x & 0xffffu), x1 = bf2f(au.x >> 16), x2 = bf2f(au.y & 0xffffu), x3 = bf2f(au.y >> 16);
                        const float x4 = bf2f(au.z & 0xffffu), x5 = bf2f(au.z >> 16), x6 = bf2f(au.w & 0xffffu), x7 = bf2f(au.w >> 16);
                        ssq += (x0 * x0 + x1 * x1) + (x2 * x2 + x3 * x3) + (x4 * x4 + x5 * x5) + (x6 * x6 + x7 * x7);
                    }
                    const bf16x8 a = __builtin_bit_cast(bf16x8, au);
                    const int k0 = g0 + 32 * i;
                    const bf16x8 b0 = *(const LAS bf16x8*)(b0p + 2 * k0), b1 = *(const LAS bf16x8*)(b1p + 2 * k0);
                    acc0 = __builtin_amdgcn_mfma_f32_16x16x32_bf16(b0, a, acc0, 0, 0, 0);
                    acc1 = __builtin_amdgcn_mfma_f32_16x16x32_bf16(b1, a, acc1, 0, 0, 0);
                }
            }
        }
    }
    if (MODE != 1) { ssq += __shfl_xor(ssq, 16); ssq += __shfl_xor(ssq, 32); }
    if (MODE == 0) {
        const float rs = rsqrtf(ssq * (1.0f / DM) + EPS);
        bf16* o = obf + (size_t)row * ldo + 32 * j + 4 * fq;
        st_bf4(o, acc0 * rs); st_bf4(o + 16, acc1 * rs);
    } else if (MODE == 1) {
        const size_t off = (size_t)row * DM + 32 * j + 4 * fq;
        const f32x4 r0 = *(const f32x4*)(base + off) + acc0, r1 = *(const f32x4*)(base + off + 16) + acc1;
        *(f32x4*)(outf + off) = r0; *(f32x4*)(outf + off + 16) = r1;
        st_bf4(obf + off, r0); st_bf4(obf + off + 16, r1);
    } else {
        const float rs = rsqrtf(ssq * (1.0f / DM) + EPS);
        const int cu = 16 * j + 4 * fq;
        const f32x4 U = acc0 * rs, G = acc1 * rs;
        const float* b0r = fbuf + (size_t)(row * 2 + 0) * DUP + cu; const float* b1r = fbuf + (size_t)(row * 2 + 1) * DUP + cu;
        const f32x4 u0 = *(const f32x4*)b0r, u1 = *(const f32x4*)b1r, g0 = *(const f32x4*)(b0r + DFF), g1 = *(const f32x4*)(b1r + DFF);
        const f32x4 uc = *(const f32x4*)(cw + cu) * u0 + *(const f32x4*)(cw + DUP + cu) * u1 + *(const f32x4*)(cw + 2 * DUP + cu) * U;
        const f32x4 gc = *(const f32x4*)(cw + DFF + cu) * g0 + *(const f32x4*)(cw + DUP + DFF + cu) * g1 + *(const f32x4*)(cw + 2 * DUP + DFF + cu) * G;
        f32x4 a;
#pragma unroll
        for (int e = 0; e < 4; ++e) a[e] = uc[e] * gc[e] / (1.0f + __expf(-gc[e]));
        st_bf4(obf + (size_t)row * DFF + cu, a);
        float* s0 = fst + (size_t)(row * 2 + 0) * DUP + cu; float* s1 = fst + (size_t)(row * 2 + 1) * DUP + cu;
        *(f32x4*)s0 = u1; *(f32x4*)(s0 + DFF) = g1; *(f32x4*)s1 = U; *(f32x4*)(s1 + DFF) = G;
    }
    __syncthreads();
}

constexpr int SF_PITCH = 1040;
__device__ __forceinline__ void small_ffn_unit(LAS unsigned char* lds, int j3, const bf16* __restrict__ Ap, const bf16* __restrict__ Bt, bf16* __restrict__ obf,
                                               const float* __restrict__ cw, const float* __restrict__ fbuf, float* __restrict__ fst) {
    int tid_o = threadIdx.x; asm volatile("" : "+v"(tid_o)); const int tid = tid_o, w = tid >> 6, lane = tid & 63, fr = lane & 15, fq = lane >> 4;
    const int row = 16 * w + fr, bl0 = 3 * j3, nb = (176 - bl0) < 3 ? (176 - bl0) : 3, K = DM;
    pg8::f32x4 acc[3][2];
#pragma unroll
    for (int b = 0; b < 3; ++b) { acc[b][0] = (pg8::f32x4){0.f, 0.f, 0.f, 0.f}; acc[b][1] = acc[b][0]; }
    float ssq = 0.f;
    const bf16* ap = Ap + (size_t)row * K + 8 * fq;
    for (int kc = 0; kc < K; kc += 512) {
        u32x4 af[16];
#pragma unroll
        for (int i = 0; i < 16; ++i) af[i] = *(const u32x4*)(ap + kc + 32 * i);
        __syncthreads();
        {
            u32x4 sg[12];
#pragma unroll
            for (int i = 0; i < 12; ++i) {
                const int c = tid + NTHREADS * i, r = c >> 6, p = c & 63, b = r >> 5, rr = r & 31;
                if (b < nb) { const int bl = bl0 + b, bn0 = 256 * ((16 * bl) / 128) + ((16 * bl) % 128); sg[i] = *(const u32x4*)(Bt + (size_t)(rr < 16 ? bn0 + rr : bn0 + 128 + rr - 16) * K + kc + 8 * p); }
            }
#pragma unroll
            for (int i = 0; i < 12; ++i) {
                const int c = tid + NTHREADS * i, r = c >> 6, p = c & 63, b = r >> 5;
                if (b < nb) *(LAS u32x4*)(lds + r * SF_PITCH + 16 * p) = sg[i];
            }
        }
        __syncthreads();
#pragma unroll
        for (int i = 0; i < 16; ++i) {
            const u32x4 au = af[i];
            const float x0 = bf2f(au.x & 0xffffu), x1 = bf2f(au.x >> 16), x2 = bf2f(au.y & 0xffffu), x3 = bf2f(au.y >> 16);
            const float x4 = bf2f(au.z & 0xffffu), x5 = bf2f(au.z >> 16), x6 = bf2f(au.w & 0xffffu), x7 = bf2f(au.w >> 16);
            ssq += (x0 * x0 + x1 * x1) + (x2 * x2 + x3 * x3) + (x4 * x4 + x5 * x5) + (x6 * x6 + x7 * x7);
            const bf16x8 a = __builtin_bit_cast(bf16x8, au);
#pragma unroll
            for (int b = 0; b < 3; ++b) {
                if (b < nb) {
                    const bf16x8 b0 = *(const LAS bf16x8*)(lds + (32 * b + fr) * SF_PITCH + 16 * fq + 64 * i), b1 = *(const LAS bf16x8*)(lds + (32 * b + 16 + fr) * SF_PITCH + 16 * fq + 64 * i);
                    acc[b][0] = __builtin_amdgcn_mfma_f32_16x16x32_bf16(b0, a, acc[b][0], 0, 0, 0);
                    acc[b][1] = __builtin_amdgcn_mfma_f32_16x16x32_bf16(b1, a, acc[b][1], 0, 0, 0);
                }
            }
        }
    }
    ssq += __shfl_xor(ssq, 16); ssq += __shfl_xor(ssq, 32);
    const float rs = rsqrtf(ssq * (1.0f / DM) + EPS);
#pragma unroll
    for (int b = 0; b < 3; ++b) {
        if (b < nb) {
            const int cu = 16 * (bl0 + b) + 4 * fq;
            const f32x4 U = acc[b][0] * rs, G = acc[b][1] * rs;
            const float* b0r = fbuf + (size_t)(row * 2 + 0) * DUP + cu; const float* b1r = fbuf + (size_t)(row * 2 + 1) * DUP + cu;
            const f32x4 u0 = *(const f32x4*)b0r, u1 = *(const f32x4*)b1r, g0 = *(const f32x4*)(b0r + DFF), g1 = *(const f32x4*)(b1r + DFF);
            const f32x4 uc = *(const f32x4*)(cw + cu) * u0 + *(const f32x4*)(cw + DUP + cu) * u1 + *(const f32x4*)(cw + 2 * DUP + cu) * U;
            const f32x4 gc = *(const f32x4*)(cw + DFF + cu) * g0 + *(const f32x4*)(cw + DUP + DFF + cu) * g1 + *(const f32x4*)(cw + 2 * DUP + DFF + cu) * G;
            f32x4 a;
#pragma unroll
            for (int e = 0; e < 4; ++e) a[e] = uc[e] * gc[e] * __builtin_amdgcn_rcpf(1.0f + __builtin_amdgcn_exp2f(-1.4426950408889634f * gc[e]));
            st_bf4(obf + (size_t)row * DFF + cu, a);
            float* s0 = fst + (size_t)(row * 2 + 0) * DUP + cu; float* s1 = fst + (size_t)(row * 2 + 1) * DUP + cu;
            *(f32x4*)s0 = u1; *(f32x4*)(s0 + DFF) = g1; *(f32x4*)s1 = U; *(f32x4*)(s1 + DFF) = G;
        }
    }
    __syncthreads();
}

__device__ __forceinline__ void transpose_item(const float* __restrict__ W, int K, int N, bf16* __restrict__ WT, int upmap, LAS float* scr, int item, int lane, const float* __restrict__ gain) {
    const int nblk = N / 64, kb = item / nblk, nb = item % nblk, k0 = 64 * kb, n0 = 64 * nb;
    float v[64];
#pragma unroll
    for (int i = 0; i < 64; ++i) v[i] = W[(size_t)(k0 + i) * N + n0 + lane];
    if (gain) {
#pragma unroll
        for (int i = 0; i < 64; ++i) v[i] *= gain[k0 + i];
    }
#pragma unroll
    for (int i = 0; i < 64; ++i) scr[i * 65 + lane] = v[i];
    asm volatile("s_waitcnt lgkmcnt(0)" ::: "memory");
    int r0 = n0;
    if (upmap) { r0 = (n0 < DFF) ? (256 * (n0 / 128) + (n0 % 128)) : (256 * ((n0 - DFF) / 128) + 128 + ((n0 - DFF) % 128)); }
    const int c = lane & 7;
#pragma unroll
    for (int j = 0; j < 8; ++j) { const int n = (lane >> 3) + 8 * j; const LAS float* s = scr + (8 * c) * 65 + n;
        u32x4 o; o.x = pk2(s[0 * 65], s[1 * 65]); o.y = pk2(s[2 * 65], s[3 * 65]); o.z = pk2(s[4 * 65], s[5 * 65]); o.w = pk2(s[6 * 65], s[7 * 65]);
        *(u32x4*)(WT + (size_t)(r0 + n) * K + k0 + 8 * c) = o; }
    asm volatile("s_waitcnt lgkmcnt(0)" ::: "memory");
}
__device__ __forceinline__ void rms_row_bf16(const float* xrow, bf16* orow, int lane) {
    f32x4 v[4]; float s = 0.f;
#pragma unroll
    for (int j = 0; j < 4; ++j) { v[j] = *(const f32x4*)(xrow + 4 * lane + 256 * j); s += (v[j].x * v[j].x + v[j].y * v[j].y) + (v[j].z * v[j].z + v[j].w * v[j].w); }
    const float rs = rsqrtf(wave_sum(s) * (1.0f / DM) + EPS);
#pragma unroll
    for (int j = 0; j < 4; ++j) st_bf4(orow + 4 * lane + 256 * j, v[j] * rs);
}
__device__ __forceinline__ void init_row(const float* xrow, bf16* orow, float* ssq, int lane) {
    f32x4 v[4]; float s = 0.f;
#pragma unroll
    for (int j = 0; j < 4; ++j) { v[j] = *(const f32x4*)(xrow + 4 * lane + 256 * j); s += (v[j].x * v[j].x + v[j].y * v[j].y) + (v[j].z * v[j].z + v[j].w * v[j].w); }
    s = wave_sum(s);
#pragma unroll
    for (int j = 0; j < 4; ++j) st_bf4(orow + 4 * lane + 256 * j, v[j]);
    if (lane == 0) *(f32x4*)ssq = (f32x4){s, 0.f, 0.f, 0.f};
}
__device__ __forceinline__ void final_row(const bf16* xrow, float ssq, const float* g, float* orow, int lane) {
    const float rs = rsqrtf(ssq * (1.0f / DM) + EPS);
#pragma unroll
    for (int j = 0; j < 4; ++j) { const f32x4 v = ld_bf4(xrow + 4 * lane + 256 * j); const f32x4 gg = *(const f32x4*)(g + 4 * lane + 256 * j); *(f32x4*)(orow + 4 * lane + 256 * j) = v * gg * rs; }
}
__device__ __forceinline__ void rms_row_f32(const float* xrow, const float* g, float* orow, int lane) {
    f32x4 v[4]; float s = 0.f;
#pragma unroll
    for (int j = 0; j < 4; ++j) { v[j] = *(const f32x4*)(xrow + 4 * lane + 256 * j); s += (v[j].x * v[j].x + v[j].y * v[j].y) + (v[j].z * v[j].z + v[j].w * v[j].w); }
    const float rs = rsqrtf(wave_sum(s) * (1.0f / DM) + EPS);
#pragma unroll
    for (int j = 0; j < 4; ++j) { const f32x4 gg = *(const f32x4*)(g + 4 * lane + 256 * j); *(f32x4*)(orow + 4 * lane + 256 * j) = v[j] * gg * rs; }
}

__device__ __forceinline__ void attn_prompt_unit(LAS unsigned char* lds, int b, int t0, const bf16* Z, bf16* MG, const float* sinks, const float* gout,
                                                 float* ck_out, float* cv_out) {
    int tid_o = threadIdx.x; asm volatile("" : "+v"(tid_o)); const int tid = tid_o, h = __builtin_amdgcn_readfirstlane(tid >> 6), lane = tid & 63, qi = lane & 31, hi = lane >> 5, g = h >> 2;
    LAS bf16* Ks = (LAS bf16*)lds;
    LAS bf16* Vt = (LAS bf16*)(lds + 55296);
    LAS float* SS = (LAS float*)(lds + 55296 + 51200);
    const bool wr_cache = (t0 >= SEQ - 128);
    bf16x8 qf[2][4];
#pragma unroll
    for (int sub = 0; sub < 2; ++sub) {
        const bf16* qp = Z + (size_t)(b * SEQ + t0 + 32 * sub + qi) * DIN + ZQ + 64 * h + 8 * hi;
#pragma unroll
        for (int st = 0; st < 4; ++st) qf[sub][st] = *(const bf16x8*)(qp + 16 * st);
    }
    {
        u32x4 kvr[6], vvr[6];
#pragma unroll
        for (int i = 0; i < 6; ++i) {
            const int c = tid + NTHREADS * i, row = c >> 4, part = c & 15, gg = part >> 3, d8 = part & 7, tok = t0 - 128 + row;
            kvr[i] = (u32x4){0u, 0u, 0u, 0u}; vvr[i] = (u32x4){0u, 0u, 0u, 0u};
            if (tok >= 0) { const bf16* zr = Z + (size_t)(b * SEQ + tok) * DIN + gg * 64 + d8 * 8; kvr[i] = *(const u32x4*)(zr + ZK); vvr[i] = *(const u32x4*)(zr + ZV); }
        }
#pragma unroll
        for (int i = 0; i < 6; ++i) {
            const int c = tid + NTHREADS * i, row = c >> 4, part = c & 15, gg = part >> 3, d8 = part & 7, tok = t0 - 128 + row;
            const u32x4 kv = kvr[i], vv = vvr[i];
            *(LAS u32x4*)(Ks + (gg * 192 + row) * 72 + d8 * 8) = kv;
            LAS bf16* vt = Vt + (gg * 64 + d8 * 8) * 200 + (row ^ (4 * d8));
            vt[0 * 200] = (bf16)(vv.x & 0xffffu); vt[1 * 200] = (bf16)(vv.x >> 16); vt[2 * 200] = (bf16)(vv.y & 0xffffu); vt[3 * 200] = (bf16)(vv.y >> 16);
            vt[4 * 200] = (bf16)(vv.z & 0xffffu); vt[5 * 200] = (bf16)(vv.z >> 16); vt[6 * 200] = (bf16)(vv.w & 0xffffu); vt[7 * 200] = (bf16)(vv.w >> 16);
            if (wr_cache && row >= 128) {
                const size_t o = ((size_t)(tok - (SEQ - 128)) * 2 + gg) * 64 + d8 * 8;
                *(f32x4*)(ck_out + o) = (f32x4){bf2f(kv.x & 0xffffu), bf2f(kv.x >> 16), bf2f(kv.y & 0xffffu), bf2f(kv.y >> 16)};
                *(f32x4*)(ck_out + o + 4) = (f32x4){bf2f(kv.z & 0xffffu), bf2f(kv.z >> 16), bf2f(kv.w & 0xffffu), bf2f(kv.w >> 16)};
                *(f32x4*)(cv_out + o) = (f32x4){bf2f(vv.x & 0xffffu), bf2f(vv.x >> 16), bf2f(vv.y & 0xffffu), bf2f(vv.y >> 16)};
                *(f32x4*)(cv_out + o + 4) = (f32x4){bf2f(vv.z & 0xffffu), bf2f(vv.z >> 16), bf2f(vv.w & 0xffffu), bf2f(vv.w >> 16)};
            }
        }
    }
    __syncthreads();
    const float L2E = 1.4426950408889634f;
    const float sc = 0.125f * L2E, sinkl = sinks[h] * L2E;
    f32x16 O[2][2];
#pragma unroll
    for (int sub = 0; sub < 2; ++sub) {
        f32x16 S[5];
#pragma unroll
        for (int kt = 0; kt < 5; ++kt) {
#pragma unroll
            for (int r = 0; r < 16; ++r) S[kt][r] = 0.f;
            const LAS bf16* kp = Ks + (g * 192 + 32 * sub + 32 * kt + qi) * 72 + 8 * hi;
#pragma unroll
            for (int st = 0; st < 4; ++st) { const bf16x8 kf = *(const LAS bf16x8*)(kp + 16 * st); S[kt] = __builtin_amdgcn_mfma_f32_32x32x16_bf16(kf, qf[sub][st], S[kt], 0, 0, 0); }
        }
        float m = sinkl;
#pragma unroll
        for (int kt = 0; kt < 5; ++kt)
#pragma unroll
            for (int r = 0; r < 16; ++r) {
                const int keyrow = 8 * (r >> 2) + 4 * hi + (r & 3);
                bool valid = true;
                if (kt == 0) valid = keyrow >= qi;
                if (kt == 4) valid = keyrow <= qi;
                if (t0 - 128 + 32 * sub + 32 * kt + keyrow < 0) valid = false;
                const float s = valid ? S[kt][r] * sc : -INFINITY;
                S[kt][r] = s; m = fmaxf(m, s);
            }
        m = fmaxf(m, __shfl_xor(m, 32));
        float sum = 0.f;
#pragma unroll
        for (int kt = 0; kt < 5; ++kt)
#pragma unroll
            for (int r = 0; r < 16; ++r) { const float p = __builtin_amdgcn_exp2f(S[kt][r] - m); S[kt][r] = p; sum += p; }
        sum += __shfl_xor(sum, 32);
        sum += exp2f(sinkl - m);
        const float inv = 1.0f / sum;
        f32x16 o0, o1;
#pragma unroll
        for (int r = 0; r < 16; ++r) { o0[r] = 0.f; o1[r] = 0.f; }
#pragma unroll
        for (int kt = 0; kt < 5; ++kt)
#pragma unroll
            for (int hf = 0; hf < 2; ++hf) {
                u32x4 pw; pw.x = pk2(S[kt][8 * hf + 0], S[kt][8 * hf + 1]); pw.y = pk2(S[kt][8 * hf + 2], S[kt][8 * hf + 3]);
                pw.z = pk2(S[kt][8 * hf + 4], S[kt][8 * hf + 5]); pw.w = pk2(S[kt][8 * hf + 6], S[kt][8 * hf + 7]);
                const bf16x8 pb = __builtin_bit_cast(bf16x8, pw);
                const int kb = 32 * sub + 32 * kt + 16 * hf + 4 * hi;
                const int f0 = 4 * (qi >> 3), f1 = 4 * (4 + (qi >> 3));
                const LAS bf16* v0 = Vt + (g * 64 + qi) * 200;
                const LAS bf16* v1 = Vt + (g * 64 + 32 + qi) * 200;
                u32x4 a0, a1; const u32x2 x0 = *(const LAS u32x2*)(v0 + (kb ^ f0)), x1 = *(const LAS u32x2*)(v0 + ((kb + 8) ^ f0)), y0 = *(const LAS u32x2*)(v1 + (kb ^ f1)), y1 = *(const LAS u32x2*)(v1 + ((kb + 8) ^ f1));
                a0.x = x0.x; a0.y = x0.y; a0.z = x1.x; a0.w = x1.y; a1.x = y0.x; a1.y = y0.y; a1.z = y1.x; a1.w = y1.y;
                o0 = __builtin_amdgcn_mfma_f32_32x32x16_bf16(__builtin_bit_cast(bf16x8, a0), pb, o0, 0, 0, 0);
                o1 = __builtin_amdgcn_mfma_f32_32x32x16_bf16(__builtin_bit_cast(bf16x8, a1), pb, o1, 0, 0, 0);
            }
        float q2 = 0.f;
#pragma unroll
        for (int r = 0; r < 16; ++r) { o0[r] *= inv; o1[r] *= inv; q2 += o0[r] * o0[r] + o1[r] * o1[r]; }
        q2 += __shfl_xor(q2, 32);
        if (hi == 0) SS[(sub * 8 + h) * 32 + qi] = q2;
        O[sub][0] = o0; O[sub][1] = o1;
    }
    __syncthreads();
    {
        LAS bf16* OT = (LAS bf16*)lds + h * (64 * 72);
#pragma unroll
        for (int sub = 0; sub < 2; ++sub) {
            float tot = 0.f;
#pragma unroll
            for (int hh = 0; hh < 8; ++hh) tot += SS[(sub * 8 + hh) * 32 + qi];
            const float rs = rsqrtf(tot * (1.0f / 512.0f) + EPS);
#pragma unroll
            for (int dt = 0; dt < 2; ++dt)
#pragma unroll
                for (int rq = 0; rq < 4; ++rq) {
                    const int d = 32 * dt + 8 * rq + 4 * hi;
                    const f32x4 gg = *(const f32x4*)(gout + 64 * h + d);
                    f32x4 v; v.x = O[sub][dt][4 * rq + 0]; v.y = O[sub][dt][4 * rq + 1]; v.z = O[sub][dt][4 * rq + 2]; v.w = O[sub][dt][4 * rq + 3];
                    v = v * gg * rs;
                    u32x2 w2; w2.x = pk2(v.x, v.y); w2.y = pk2(v.z, v.w);
                    *(LAS u32x2*)(OT + (32 * sub + qi) * 72 + d) = w2;
                }
        }
        asm volatile("s_waitcnt lgkmcnt(0)" ::: "memory");
#pragma unroll
        for (int i = 0; i < 8; ++i) {
            const int q = 8 * i + (lane >> 3), ch = lane & 7;
            const u32x4 w4 = *(const LAS u32x4*)(OT + q * 72 + 8 * ch);
            *(u32x4*)(MG + (size_t)(b * SEQ + t0 + q) * DM + 64 * h + 8 * ch) = w4;
        }
    }
    __syncthreads();
}

__device__ __forceinline__ void attn_sample_unit(LAS unsigned char* lds, int s, const bf16* __restrict__ ZS, bf16* __restrict__ MGS, const float* __restrict__ sinks, const float* __restrict__ gout,
                                                 const float* __restrict__ ck, const float* __restrict__ cv, float* __restrict__ cko, float* __restrict__ cvo) {
    int tid_o = threadIdx.x; asm volatile("" : "+v"(tid_o)); const int tid = tid_o, w = tid >> 6, lane = tid & 63;
    LAS float* KS = (LAS float*)lds;
    LAS float* VS = (LAS float*)(lds + 68112);
    LAS float* QS = (LAS float*)(lds + 68112 + 66048);
    LAS float* SC = QS + 512;
    LAS float* RED = SC + 8 * 132;
    const bf16* zr = ZS + (size_t)s * DIN;
    const float* ckb = ck + (size_t)s * 16384; float* ckob = cko + (size_t)s * 16384;
    const float* cvb = cv + (size_t)s * 16384; float* cvob = cvo + (size_t)s * 16384;
    {
        f32x4 kr[8], vr[8];
#pragma unroll
        for (int i = 0; i < 8; ++i) { const int e = (tid + NTHREADS * i) * 4; kr[i] = *(const f32x4*)(ckb + e); vr[i] = *(const f32x4*)(cvb + e); }
#pragma unroll
        for (int i = 0; i < 8; ++i) {
            const int e = (tid + NTHREADS * i) * 4, row = e >> 7, col = e & 127;
            *(LAS f32x4*)(KS + row * 132 + col) = kr[i]; *(LAS f32x4*)(VS + row * 128 + col) = vr[i];
            if (row >= 1) { *(f32x4*)(ckob + e - 128) = kr[i]; *(f32x4*)(cvob + e - 128) = vr[i]; }
        }
        QS[tid] = bf2f(zr[ZQ + tid]);
        if (tid < 128) {
            const float kn = bf2f(zr[ZK + tid]), vn = bf2f(zr[ZV + tid]);
            KS[128 * 132 + tid] = kn; VS[128 * 128 + tid] = vn;
            ckob[127 * 128 + tid] = kn; cvob[127 * 128 + tid] = vn;
        }
    }
    __syncthreads();
    {
        const int part = tid >> 7, g = part >> 1, h0 = 4 * g + 2 * (part & 1);
        for (int pass = 0; pass < 2; ++pass) {
            const int j = pass ? 128 : (tid & 127);
            if (pass && (tid & 127) != 0) break;
            const LAS float* kp = KS + j * 132 + 64 * g; const LAS float* q0 = QS + h0 * 64; const LAS float* q1 = q0 + 64;
            float a0 = 0.f, a1 = 0.f;
#pragma unroll
            for (int d = 0; d < 64; d += 4) { const f32x4 kv = *(const LAS f32x4*)(kp + d), x0 = *(const LAS f32x4*)(q0 + d), x1 = *(const LAS f32x4*)(q1 + d);
                a0 += (kv.x * x0.x + kv.y * x0.y) + (kv.z * x0.z + kv.w * x0.w); a1 += (kv.x * x1.x + kv.y * x1.y) + (kv.z * x1.z + kv.w * x1.w); }
            SC[h0 * 132 + j] = a0 * 0.125f; SC[(h0 + 1) * 132 + j] = a1 * 0.125f;
        }
    }
    __syncthreads();
    {
        const float sink = sinks[w];
        const float s0 = SC[w * 132 + lane], s1 = SC[w * 132 + 64 + lane], s2 = (lane == 0) ? SC[w * 132 + 128] : -INFINITY;
        const float m = fmaxf(wave_max(fmaxf(fmaxf(s0, s1), s2)), sink);
        const float p0 = __expf(s0 - m), p1 = __expf(s1 - m), p2 = (lane == 0) ? __expf(s2 - m) : 0.f;
        const float inv = 1.0f / (wave_sum(p0 + p1 + p2) + __expf(sink - m));
        SC[w * 132 + lane] = p0 * inv; SC[w * 132 + 64 + lane] = p1 * inv; if (lane == 0) SC[w * 132 + 128] = p2 * inv;
    }
    __syncthreads();
    float o = 0.f;
    {
        const LAS float* pp = SC + w * 132; const LAS float* vp = VS + 64 * (w >> 2) + lane;
#pragma unroll 8
        for (int jj = 0; jj < 128; jj += 4) { const f32x4 p4 = *(const LAS f32x4*)(pp + jj);
            o += p4.x * vp[(jj + 0) * 128] + p4.y * vp[(jj + 1) * 128] + p4.z * vp[(jj + 2) * 128] + p4.w * vp[(jj + 3) * 128]; }
        o += pp[128] * vp[128 * 128];
    }
    const float q2 = wave_sum(o * o);
    if (lane == 0) RED[w] = q2;
    __syncthreads();
    float tot = 0.f;
#pragma unroll
    for (int ww = 0; ww < 8; ++ww) tot += RED[ww];
    const float rs = rsqrtf(tot * (1.0f / 512.0f) + EPS);
    MGS[(size_t)s * DM + tid] = (bf16)f2bf(o * rs * gout[tid]);
    __syncthreads();
}

template <int NTW>
__device__ __forceinline__ void sconv_unit(bool sample, int b, int t0, const bf16* __restrict__ Zp, bf16* __restrict__ MGp, const float* __restrict__ cw, const float* __restrict__ gout,
                                           const float* __restrict__ sbuf, float* __restrict__ st_out) {
    int tid_o = threadIdx.x; asm volatile("" : "+v"(tid_o)); const int tid = tid_o, w = tid >> 6, lane = tid & 63, c = 4 * lane;
    const f32x4 w0 = *(const f32x4*)(cw + c), w1 = *(const f32x4*)(cw + 256 + c), w2 = *(const f32x4*)(cw + 512 + c), gg = *(const f32x4*)(gout + 768 + c);
    const f32x4 zero = (f32x4){0.f, 0.f, 0.f, 0.f};
    f32x4 co[NTW];
    if (!sample) {
        const int tb = t0 + NTW * w;
        const bf16* zb = Zp + ((size_t)b * SEQ + tb) * DIN;
        u32x2 rc[NTW + 2], ru[NTW + 2], rb[NTW];
#pragma unroll
        for (int i = 0; i < NTW + 2; ++i) {
            rc[i] = (u32x2){0u, 0u}; ru[i] = (u32x2){0u, 0u};
            if (tb + i - 2 >= 0) { rc[i] = *(const u32x2*)(zb + (long)(i - 2) * DIN + ZSC + c); ru[i] = *(const u32x2*)(zb + (long)(i - 2) * DIN + ZSU + c); }
        }
#pragma unroll
        for (int k = 0; k < NTW; ++k) rb[k] = *(const u32x2*)(zb + (size_t)k * DIN + ZSB + c);
        f32x4 v[NTW + 2];
#pragma unroll
        for (int i = 0; i < NTW + 2; ++i) {
            const f32x4 cc = (f32x4){bf2f(rc[i].x & 0xffffu), bf2f(rc[i].x >> 16), bf2f(rc[i].y & 0xffffu), bf2f(rc[i].y >> 16)};
            const f32x4 uu = (f32x4){bf2f(ru[i].x & 0xffffu), bf2f(ru[i].x >> 16), bf2f(ru[i].y & 0xffffu), bf2f(ru[i].y >> 16)};
            v[i] = cc * uu;
        }
#pragma unroll
        for (int k = 0; k < NTW; ++k) {
            const f32x4 bb = (f32x4){bf2f(rb[k].x & 0xffffu), bf2f(rb[k].x >> 16), bf2f(rb[k].y & 0xffffu), bf2f(rb[k].y >> 16)};
            co[k] = bb * (w0 * v[k] + w1 * v[k + 1] + w2 * v[k + 2]);
            const int t = tb + k;
            if (t >= SEQ - 2) *(f32x4*)(st_out + (size_t)(b * 2 + (t - (SEQ - 2))) * 256 + c) = v[k + 2];
        }
    } else if constexpr (NTW == 8) {
        const size_t sb = t0 + 8 * w;
        u32x2 rc[8], ru[8], rb[8]; f32x4 p0[8], p1[8];
#pragma unroll
        for (int k = 0; k < 8; ++k) {
            const bf16* zr = Zp + (sb + k) * DIN;
            rc[k] = *(const u32x2*)(zr + ZSC + c); ru[k] = *(const u32x2*)(zr + ZSU + c); rb[k] = *(const u32x2*)(zr + ZSB + c);
            p0[k] = *(const f32x4*)(sbuf + ((sb + k) * 2 + 0) * 256 + c); p1[k] = *(const f32x4*)(sbuf + ((sb + k) * 2 + 1) * 256 + c);
        }
#pragma unroll
        for (int k = 0; k < 8; ++k) {
            const f32x4 cc = (f32x4){bf2f(rc[k].x & 0xffffu), bf2f(rc[k].x >> 16), bf2f(rc[k].y & 0xffffu), bf2f(rc[k].y >> 16)};
            const f32x4 uu = (f32x4){bf2f(ru[k].x & 0xffffu), bf2f(ru[k].x >> 16), bf2f(ru[k].y & 0xffffu), bf2f(ru[k].y >> 16)};
            const f32x4 bb = (f32x4){bf2f(rb[k].x & 0xffffu), bf2f(rb[k].x >> 16), bf2f(rb[k].y & 0xffffu), bf2f(rb[k].y >> 16)};
            const f32x4 vcur = cc * uu;
            co[k] = bb * (w0 * p0[k] + w1 * p1[k] + w2 * vcur);
            *(f32x4*)(st_out + ((sb + k) * 2 + 0) * 256 + c) = p1[k]; *(f32x4*)(st_out + ((sb + k) * 2 + 1) * 256 + c) = vcur;
        }
    }
    (void)zero;
    float q[NTW];
#pragma unroll
    for (int k = 0; k < NTW; ++k) q[k] = (co[k].x * co[k].x + co[k].y * co[k].y) + (co[k].z * co[k].z + co[k].w * co[k].w);
#pragma unroll
    for (int o = 1; o < 64; o <<= 1)
#pragma unroll
        for (int k = 0; k < NTW; ++k) q[k] += __shfl_xor(q[k], o);
#pragma unroll
    for (int k = 0; k < NTW; ++k) {
        const size_t row = sample ? (size_t)(t0 + NTW * w + k) : ((size_t)b * SEQ + t0 + NTW * w + k);
        st_bf4(MGp + row * DM + 768 + c, co[k] * gg * rsqrtf(q[k] * (1.0f / 256.0f) + EPS));
    }
}

struct LruW { const float *cw, *cb, *ba, *bi, *lam, *gout; const bf16* lwt; };
__device__ __forceinline__ void lru_unit(LAS unsigned char* lds, bool sample, int b, int t0, const bf16* __restrict__ Zp, bf16* __restrict__ MGp, const LruW W,
                                         bf16* __restrict__ hloc, bf16* __restrict__ cuma, float* __restrict__ agga, float* __restrict__ aggb,
                                         const float* __restrict__ lbuf, const float* __restrict__ h0, float* __restrict__ lc_out, float* __restrict__ rg_out) {
    int tid_o = threadIdx.x; asm volatile("" : "+v"(tid_o)); const int tid = tid_o, w = __builtin_amdgcn_readfirstlane(tid >> 6), lane = tid & 63;
    LAS float* XC = (LAS float*)lds;
    constexpr int LP = 260;
    LAS bf16* XB = (LAS bf16*)(lds + 66560);
    LAS float* AA = (LAS float*)(lds + 66560);
    {
        const int cp = tid & 127, tg = tid >> 7, c = 2 * cp;
        const f32x2 k0 = *(const f32x2*)(W.cw + c), k1 = *(const f32x2*)(W.cw + 256 + c), k2 = *(const f32x2*)(W.cw + 512 + c), k3 = *(const f32x2*)(W.cw + 768 + c), bb = *(const f32x2*)(W.cb + c);
        if (!sample) {
            const int tb = t0 + 16 * tg;
            const bf16* zc = Zp + ((size_t)b * SEQ + tb) * DIN + ZLX + c;
            unsigned xr[19];
#pragma unroll
            for (int i = 0; i < 19; ++i) { xr[i] = 0u; if (tb + i - 3 >= 0) xr[i] = *(const unsigned*)(zc + (long)(i - 3) * DIN); }
#pragma unroll
            for (int i = 0; i < 16; ++i) {
                const f32x2 xm3 = (f32x2){bf2f(xr[i] & 0xffffu), bf2f(xr[i] >> 16)}, xm2 = (f32x2){bf2f(xr[i + 1] & 0xffffu), bf2f(xr[i + 1] >> 16)};
                const f32x2 xm1 = (f32x2){bf2f(xr[i + 2] & 0xffffu), bf2f(xr[i + 2] >> 16)}, x = (f32x2){bf2f(xr[i + 3] & 0xffffu), bf2f(xr[i + 3] >> 16)};
                const f32x2 xc = k0 * xm3 + k1 * xm2 + k2 * xm1 + k3 * x + bb;
                const int tok = 16 * tg + i;
                *(LAS f32x2*)(XC + tok * LP + c) = xc; *(LAS unsigned*)(XB + tok * 264 + c) = pk2(xc.x, xc.y);
                if (tb + i >= SEQ - 3) *(f32x2*)(lc_out + (size_t)(b * 3 + (tb + i - (SEQ - 3))) * 256 + c) = x;
            }
        } else {
#pragma unroll
            for (int i = 0; i < 16; ++i) {
                const int tok = 16 * tg + i; const size_t s = t0 + tok;
                const unsigned u = *(const unsigned*)(Zp + s * DIN + ZLX + c); const f32x2 x = (f32x2){bf2f(u & 0xffffu), bf2f(u >> 16)};
                const f32x2 xm3 = *(const f32x2*)(lbuf + (s * 3 + 0) * 256 + c), xm2 = *(const f32x2*)(lbuf + (s * 3 + 1) * 256 + c), xm1 = *(const f32x2*)(lbuf + (s * 3 + 2) * 256 + c);
                const f32x2 xc = k0 * xm3 + k1 * xm2 + k2 * xm1 + k3 * x + bb;
                *(LAS f32x2*)(XC + tok * LP + c) = xc; *(LAS unsigned*)(XB + tok * 264 + c) = pk2(xc.x, xc.y);
                *(f32x2*)(lc_out + (s * 3 + 0) * 256 + c) = xm2; *(f32x2*)(lc_out + (s * 3 + 1) * 256 + c) = xm1; *(f32x2*)(lc_out + (s * 3 + 2) * 256 + c) = x;
            }
        }
    }
    __syncthreads();
    const int blk = w & 3, dh = w >> 2, qi = lane & 31, hi = lane >> 5, ch = 64 * blk + 32 * dh + qi;
    f32x16 ar[2], ai[2];
    {
        bf16x8 bw[2][4];
#pragma unroll
        for (int gt = 0; gt < 2; ++gt)
#pragma unroll
            for (int st = 0; st < 4; ++st) bw[gt][st] = *(const bf16x8*)(W.lwt + ((size_t)(gt * 4 + blk) * 64 + 32 * dh + qi) * 64 + 16 * st + 8 * hi);
#pragma unroll
        for (int tt = 0; tt < 2; ++tt) {
#pragma unroll
            for (int r = 0; r < 16; ++r) { ar[tt][r] = 0.f; ai[tt][r] = 0.f; }
#pragma unroll
            for (int st = 0; st < 4; ++st) {
                const bf16x8 af = *(const LAS bf16x8*)(XB + (32 * tt + qi) * 264 + 64 * blk + 16 * st + 8 * hi);
                ar[tt] = __builtin_amdgcn_mfma_f32_32x32x16_bf16(af, bw[0][st], ar[tt], 0, 0, 0);
                ai[tt] = __builtin_amdgcn_mfma_f32_32x32x16_bf16(af, bw[1][st], ai[tt], 0, 0, 0);
            }
        }
    }
    __syncthreads();
    {
        const float ba = W.ba[ch], bi = W.bi[ch], lam = W.lam[ch];
        const float c8 = -8.0f * log1pf(__expf(-lam));
#pragma unroll
        for (int tt = 0; tt < 2; ++tt)
#pragma unroll
            for (int r = 0; r < 16; ++r) {
                const int tok = 32 * tt + 8 * (r >> 2) + 4 * hi + (r & 3);
                const float xc = XC[tok * LP + ch];
                const float rg = sigmoidf_(ar[tt][r] + ba), ig = sigmoidf_(ai[tt][r] + bi);
                const float la = c8 * rg, a = __builtin_amdgcn_exp2f(1.4426950408889634f * la), x2 = 2.0f * la, mult = __builtin_amdgcn_sqrtf(fmaxf(-x2 * (1.0f + x2 * (0.5f + x2 * (0.16666667f + x2 * (0.041666668f + x2 * (0.0083333338f + x2 * 0.0013888889f))))), 0.f));
                AA[tok * LP + ch] = a; XC[tok * LP + ch] = mult * ig * xc;
            }
    }
    __syncthreads();
    if (!sample) {
        const int half = tid >> 8, ch = tid & 255;
        float hl[32], cl[32];
        {
            float hh = 0.f, cum = 1.f;
#pragma unroll
            for (int i = 0; i < 32; ++i) { const int tok = 32 * half + i; const float a = AA[tok * LP + ch]; hh = a * hh + XC[tok * LP + ch]; cum *= a; hl[i] = hh; cl[i] = cum; }
        }
        __syncthreads();
        if (!half) { XC[ch] = hl[31]; XC[256 + ch] = cl[31]; }
        __syncthreads();
        if (half) {
            const float h1 = XC[ch], c1 = XC[256 + ch];
#pragma unroll
            for (int i = 0; i < 32; ++i) { hl[i] += cl[i] * h1; cl[i] *= c1; }
            const int chunk = t0 >> 6;
            agga[(size_t)(b * 128 + chunk) * 256 + ch] = cl[31]; aggb[(size_t)(b * 128 + chunk) * 256 + ch] = hl[31];
        }
        const size_t rb = ((size_t)b * SEQ + t0 + 32 * half) * 256 + ch;
#pragma unroll
        for (int i = 0; i < 32; ++i) { hloc[rb + (size_t)i * 256] = (bf16)f2bf(hl[i]); cuma[rb + (size_t)i * 256] = (bf16)f2bf(cl[i]); }
    } else {
        const int c = tid & 255, tk0 = (tid >> 8) * 32;
        float h0r[32]; unsigned short gr[32];
#pragma unroll
        for (int i = 0; i < 32; ++i) { const size_t s = t0 + tk0 + i; h0r[i] = h0[s * 256 + c]; gr[i] = Zp[s * DIN + ZLG + c]; }
#pragma unroll
        for (int i = 0; i < 32; ++i) {
            const int tok = tk0 + i; const size_t s = t0 + tok;
            const float hh = AA[tok * LP + c] * h0r[i] + XC[tok * LP + c];
            rg_out[s * 256 + c] = hh;
            XC[tok * LP + c] = hh * gelu_tanh(bf2f(gr[i]));
        }
        __syncthreads();
        for (int it = 0; it < 8; ++it) {
            const int tok = it * 8 + w; const size_t s = t0 + tok;
            const f32x4 v = *(const LAS f32x4*)(XC + tok * LP + 4 * lane);
            const float rs = rsqrtf(wave_sum((v.x * v.x + v.y * v.y) + (v.z * v.z + v.w * v.w)) * (1.0f / 256.0f) + EPS);
            st_bf4(MGp + s * DM + 512 + 4 * lane, v * *(const f32x4*)(W.gout + 512 + 4 * lane) * rs);
        }
    }
    __syncthreads();
}

__device__ __forceinline__ void lru_fix_unit(LAS unsigned char* lds, int b, int chunk, const bf16* __restrict__ Z, bf16* __restrict__ MG, const float* __restrict__ gout,
                                             const bf16* __restrict__ hloc, const bf16* __restrict__ cuma, const float* __restrict__ agga, const float* __restrict__ aggb, float* __restrict__ rg_out) {
    int tid_o = threadIdx.x; asm volatile("" : "+v"(tid_o)); const int tid = tid_o, w = tid >> 6, lane = tid & 63;
    LAS float* CR = (LAS float*)lds;
    const size_t row0 = (size_t)b * SEQ + chunk * 64 + 8 * w;
    u32x2 hlr[8], car[8]; u32x2 gr[8];
#pragma unroll
    for (int k = 0; k < 8; ++k) { hlr[k] = *(const u32x2*)(hloc + (row0 + k) * 256 + 4 * lane); car[k] = *(const u32x2*)(cuma + (row0 + k) * 256 + 4 * lane); gr[k] = *(const u32x2*)(Z + (row0 + k) * DIN + ZLG + 4 * lane); }
    {
        const int half = tid >> 8, ch = tid & 255, n1 = chunk >> 1, j0 = half ? n1 : 0, j1 = half ? chunk : n1;
        const float* pa = agga + (size_t)b * 128 * 256 + ch; const float* pb = aggb + (size_t)b * 128 * 256 + ch;
        float A = 1.f, B = 0.f;
#pragma unroll 32
        for (int j = j0; j < j1; ++j) { const float a = pa[(size_t)j * 256], bb = pb[(size_t)j * 256]; B = a * B + bb; A *= a; }
        if (half) { CR[ch] = A; CR[256 + ch] = B; }
        __syncthreads();
        if (!half) CR[512 + ch] = CR[ch] * B + CR[256 + ch];
        __syncthreads();
    }
    const f32x4 cr = *(const LAS f32x4*)(CR + 512 + 4 * lane), gg = *(const f32x4*)(gout + 512 + 4 * lane);
    f32x4 bo[8]; float q[8];
#pragma unroll
    for (int k = 0; k < 8; ++k) {
        const f32x4 hlk = (f32x4){bf2f(hlr[k].x & 0xffffu), bf2f(hlr[k].x >> 16), bf2f(hlr[k].y & 0xffffu), bf2f(hlr[k].y >> 16)};
        const f32x4 cak = (f32x4){bf2f(car[k].x & 0xffffu), bf2f(car[k].x >> 16), bf2f(car[k].y & 0xffffu), bf2f(car[k].y >> 16)};
        const f32x4 hh = hlk + cak * cr;
        const f32x4 gt = (f32x4){bf2f(gr[k].x & 0xffffu), bf2f(gr[k].x >> 16), bf2f(gr[k].y & 0xffffu), bf2f(gr[k].y >> 16)};
        bo[k].x = hh.x * gelu_tanh(gt.x); bo[k].y = hh.y * gelu_tanh(gt.y); bo[k].z = hh.z * gelu_tanh(gt.z); bo[k].w = hh.w * gelu_tanh(gt.w);
        q[k] = (bo[k].x * bo[k].x + bo[k].y * bo[k].y) + (bo[k].z * bo[k].z + bo[k].w * bo[k].w);
        if (chunk * 64 + 8 * w + k == SEQ - 1) *(f32x4*)(rg_out + (size_t)b * 256 + 4 * lane) = hh;
    }
#pragma unroll
    for (int o = 1; o < 64; o <<= 1)
#pragma unroll
        for (int k = 0; k < 8; ++k) q[k] += __shfl_xor(q[k], o);
#pragma unroll
    for (int k = 0; k < 8; ++k) st_bf4(MG + (row0 + k) * DM + 512 + 4 * lane, bo[k] * gg * rsqrtf(q[k] * (1.0f / 256.0f) + EPS));
    __syncthreads();
}

#define XB_TMO      128
#define XB_XCNT(j)  (256  + 64 * (j))
#define XB_XSUB(j)  (1280 + 64 * (j))
#define XB_XGEN(j)  (2304 + 64 * (j))
#define XB_TOP      3328
#define XB_TOPGEN   3392
#define XCD_BAR_WORDS 3456
#define XB_SPIN_CAP (1u << 18)

__device__ __forceinline__ unsigned xb_ld(unsigned* p)              { return __hip_atomic_load(p, __ATOMIC_RELAXED, __HIP_MEMORY_SCOPE_AGENT); }
__device__ __forceinline__ unsigned xb_add(unsigned* p, unsigned v) { return __hip_atomic_fetch_add(p, v, __ATOMIC_RELAXED, __HIP_MEMORY_SCOPE_AGENT); }
__device__ __forceinline__ unsigned xb_xcc_id() { return (unsigned)__builtin_amdgcn_s_getreg((3 << 11) | 20) & 0xFu; }
#define XB_SPIN(cond, bar) do { unsigned _sp = 0; while (cond) { __builtin_amdgcn_s_sleep(1); \
    if ((++_sp & 255u) == 0u) { if (xb_ld(&(bar)[XB_TMO])) break; if (_sp > XB_SPIN_CAP) { atomicAdd(&(bar)[XB_TMO], 1u); break; } } } } while (0)

struct XcdBarrier {
    unsigned* bar; unsigned x;
    volatile LAS unsigned* st;
};

__device__ __forceinline__ XcdBarrier xcd_barrier_post(unsigned* bar, volatile LAS unsigned* st) {
    XcdBarrier b; b.bar = bar; b.x = xb_xcc_id(); b.st = st;
    if (threadIdx.x == 0) (void)xb_add(&bar[XB_XCNT(b.x)], 1u);
    return b;
}
__device__ __forceinline__ void xcd_barrier_complete(unsigned* bar, unsigned x, unsigned& nloc, unsigned& nx) {
    const unsigned G = gridDim.x * gridDim.y * gridDim.z;
    unsigned sum, cnt, mine, sp = 0u;
    for (;;) {
        sum = 0u; cnt = 0u; mine = 0u;
#pragma unroll
        for (unsigned j = 0; j < 16; ++j) { const unsigned c = xb_ld(&bar[XB_XCNT(j)]); sum += c; cnt += (c > 0u) ? 1u : 0u; mine = (j == x) ? c : mine; }
        if (sum == G) break;
        __builtin_amdgcn_s_sleep(1);
        if ((++sp & 255u) == 0u) { if (xb_ld(&bar[XB_TMO])) break; if (sp > XB_SPIN_CAP) { atomicAdd(&bar[XB_TMO], 1u); break; } }
    }
    nloc = mine > 0u ? mine : 1u; nx = cnt > 0u ? cnt : 1u;
}

__device__ __forceinline__ void xcd_barrier(const XcdBarrier& b) {
    asm volatile("s_waitcnt vmcnt(0)" ::: "memory");
    __syncthreads();
    if (threadIdx.x == 0) {
        unsigned* bar = b.bar;
        __builtin_amdgcn_s_waitcnt(0);
        unsigned nloc = b.st[0], nx = b.st[1];
        if (nloc == 0u) { xcd_barrier_complete(bar, b.x, nloc, nx); b.st[0] = nloc; b.st[1] = nx; }
        const unsigned old = xb_add(&bar[XB_XSUB(b.x)], 1u);
        const unsigned gen = old / nloc;
        if (old + 1u == (gen + 1u) * nloc) {
            __builtin_amdgcn_fence(__ATOMIC_RELEASE, "agent");
            asm volatile("s_waitcnt vmcnt(0)" ::: "memory");
            const unsigned og = xb_add(&bar[XB_TOP], 1u);
            const unsigned tg = og / nx;
            if (og + 1u == (tg + 1u) * nx) xb_add(&bar[XB_TOPGEN], 1u);
            else XB_SPIN(xb_ld(&bar[XB_TOPGEN]) == tg, bar);
            __builtin_amdgcn_fence(__ATOMIC_ACQUIRE, "agent");
            xb_add(&bar[XB_XGEN(b.x)], 1u);
            asm volatile("s_waitcnt vmcnt(0)" ::: "memory");
        } else {
            XB_SPIN(xb_ld(&bar[XB_XGEN(b.x)]) == gen, bar);
            __builtin_amdgcn_fence(__ATOMIC_ACQUIRE, "agent");
            asm volatile("s_waitcnt vmcnt(0)" ::: "memory");
        }
    }
    __syncthreads();
}

typedef const Args __attribute__((address_space(4))) * KArgsP;
__device__ __forceinline__ KArgsP kargs() { KArgsP p = (KArgsP)__builtin_amdgcn_kernarg_segment_ptr(); asm volatile("" : "+s"(p)); return p; }
#define IN(i) (ka->in[i])
#define WSP(T, off) ((T*)(ka->ws + (off)))
#define OUTP(off) (ka->out + (off))
#define PHASE_VARS KArgsP ka = kargs(); int tid_o = threadIdx.x; asm volatile("" : "+v"(tid_o)); const int tid = tid_o, lane = tid & 63, wave = __builtin_amdgcn_readfirstlane(tid >> 6); \
    const int G = gridDim.x, cu = blockIdx.x, gw = cu * NWAVES + wave, NGW = G * NWAVES; (void)lane; (void)gw; (void)NGW; (void)ka;

#ifndef REP_AT
#define REP_AT 1
#endif
#ifndef REP_LR
#define REP_LR 1
#endif
#ifndef REP_SC
#define REP_SC 1
#endif
#ifndef REP_LF
#define REP_LF 1
#endif
#ifndef REP_AS
#define REP_AS 1
#endif
#ifndef REP_SG
#define REP_SG 1
#endif
#ifndef REP_LS
#define REP_LS 1
#endif
#ifndef REP_P1
#define REP_P1 1
#endif
#ifndef REP_P2
#define REP_P2 1
#endif
#ifndef REP_P3
#define REP_P3 1
#endif
#ifndef REP_P5
#define REP_P5 1
#endif
#ifndef REP_P0
#define REP_P0 1
#endif
__global__ void __launch_bounds__(NTHREADS, 2) fwd_megakernel(Args args) {
    extern __shared__ __attribute__((aligned(16))) unsigned char lds_raw[];
    LAS unsigned char* lds = (LAS unsigned char*)lds_raw;
    cg::grid_group grid = cg::this_grid();
    volatile LAS unsigned* MISC = (volatile LAS unsigned*)(lds + 147392);
    if (threadIdx.x < 16) MISC[threadIdx.x] = 0u;
    __syncthreads();
    const XcdBarrier bar = xcd_barrier_post((unsigned*)(args.ws + 16384), MISC + 8);

    for (int rep_ = 0; rep_ < REP_P0; ++rep_)
    {
        PHASE_VARS
        LAS float* scr = (LAS float*)(lds + wave * 16640);
        constexpr int I_IN = 16 * 32, I_OUT = 16 * 16, I_UP = 16 * 88, I_DN = 44 * 16, I_L = I_IN + I_OUT + I_UP + I_DN;
        for (int it = gw; it < DEPTH * I_L; it += NGW) {
            const int l = it / I_L; int r = it % I_L;
            unsigned char* wl = ka->ws + WS_W + (size_t)l * W_LAYER;
            if (r < I_IN) { transpose_item(IN(9) + (size_t)l * DM * DIN, DM, DIN, (bf16*)(wl + W_IN), 0, scr, r, lane, IN(8) + (size_t)l * DM); continue; } r -= I_IN;
            if (r < I_OUT) { transpose_item(IN(20) + (size_t)l * DM * DM, DM, DM, (bf16*)(wl + W_OUT), 0, scr, r, lane, nullptr); continue; } r -= I_OUT;
            if (r < I_UP) { transpose_item(IN(22) + (size_t)l * DM * DUP, DM, DUP, (bf16*)(wl + W_UP), 1, scr, r, lane, IN(21) + (size_t)l * DM); continue; } r -= I_UP;
            transpose_item(IN(24) + (size_t)l * DFF * DM, DFF, DM, (bf16*)(wl + W_DOWN), 0, scr, r, lane, nullptr);
        }
        bf16* LWT = WSP(bf16, WS_LWT);
        for (int e = cu * NTHREADS + tid; e < DEPTH * 2 * 4 * 4096; e += G * NTHREADS) {
            const int c = e & 63, d = (e >> 6) & 63, blk = (e >> 12) & 3, gt = (e >> 14) & 1, l = e >> 15;
            const float* src = gt ? IN(15) : IN(13);
            LWT[e] = (bf16)f2bf(src[((size_t)(l * 4 + blk) * 64 + c) * 64 + d]);
        }
        const float* xp = IN(0); bf16* X = WSP(bf16, WS_X); float* SSQB = WSP(float, WS_SSQB); float* SSQA = WSP(float, WS_SSQA);
        for (int m0 = gw; m0 < MP; m0 += 4 * NGW) {
            f32x4 v[4][4];
#pragma unroll
            for (int r = 0; r < 4; ++r) { const int m = m0 + r * NGW; if (m < MP) {
#pragma unroll
                for (int j = 0; j < 4; ++j) v[r][j] = *(const f32x4*)(xp + (size_t)m * DM + 4 * lane + 256 * j); } }
#pragma unroll
            for (int r = 0; r < 4; ++r) { const int m = m0 + r * NGW; if (m < MP) {
                float q = 0.f;
#pragma unroll
                for (int j = 0; j < 4; ++j) { q += (v[r][j].x * v[r][j].x + v[r][j].y * v[r][j].y) + (v[r][j].z * v[r][j].z + v[r][j].w * v[r][j].w); st_bf4(X + (size_t)m * DM + 4 * lane + 256 * j, v[r][j]); }
                q = wave_sum(q);
                if (lane == 0) *(f32x4*)(SSQB + 4 * (size_t)m) = (f32x4){q, 0.f, 0.f, 0.f}; } }
        }
        (void)SSQA;
        { const float* xs0 = IN(1); bf16* XSB = WSP(bf16, WS_XSB);
          for (int e = (cu * NTHREADS + tid) * 4; e < NS * DM; e += G * NTHREADS * 4) st_bf4(XSB + e, *(const f32x4*)(xs0 + e)); }
    }
    xcd_barrier(bar);
    if (gridDim.x == 0x7fffffffu) grid.sync();

#pragma nounroll
    for (int l = 0; l < DEPTH; ++l) {
        for (int rep_ = 0; rep_ < REP_P1; ++rep_)
        {
            PHASE_VARS
            const bf16* Win_t = (const bf16*)(ka->ws + WS_W + (size_t)l * W_LAYER + W_IN);
            pg8::Gemm g{WSP(bf16, WS_X), Win_t, MP, DIN, DM}; pg8::StaticOrder S; S.init(MP, DIN, G, cu);
            EpiZ E{WSP(bf16, WS_Z), WSP(float, WS_SSQB)};
            pg8::gemm_phase<EpiZ, pg8::StaticOrder, true, true, false>(lds, g, S, E);
        }
        xcd_barrier(bar);

        for (int rep_ = 0; rep_ < REP_P2; ++rep_)
        {
            PHASE_VARS
            const float* gout = IN(19) + (size_t)l * DM;
            const float* sinks = IN(10) + l * 8;
            LruW LW{IN(11) + (size_t)l * 4 * 256, IN(12) + (size_t)l * 256, IN(14) + (size_t)l * 256, IN(16) + (size_t)l * 256,
                    IN(17) + (size_t)l * 256, gout, WSP(bf16, WS_LWT) + (size_t)l * 2 * 4 * 4096};
            if (G == 256) {
                const int vc = (cu & 7) * 32 + (cu >> 3);
                if (vc < 64)
                    for (int r2 = 0; r2 < REP_SG; ++r2) small_gemm_unit<0>(lds, vc, WSP(bf16, WS_XSB), (const bf16*)(ka->ws + WS_W + (size_t)l * W_LAYER + W_IN), DM, WSP(bf16, WS_ZS), DIN, nullptr, nullptr, nullptr, nullptr, nullptr);
                { const int b = vc >> 7, qb = vc & 127;
                  for (int r2 = 0; r2 < REP_AT; ++r2) attn_prompt_unit(lds, b, qb * 64, WSP(bf16, WS_Z), WSP(bf16, WS_MG), sinks, gout, OUTP(O_CKP) + (size_t)(l * 2 + b) * 16384, OUTP(O_CVP) + (size_t)(l * 2 + b) * 16384);
                  for (int r2 = 0; r2 < REP_LR; ++r2) lru_unit(lds, false, b, qb * 64, WSP(bf16, WS_Z), WSP(bf16, WS_MG), LW, WSP(bf16, WS_HLOC), WSP(bf16, WS_CUMA), WSP(float, WS_AGGA), WSP(float, WS_AGGB),
                             nullptr, nullptr, OUTP(O_LCP) + (size_t)l * 2 * 3 * 256, nullptr); }
                if (vc >= 64) {
                    const int b = vc >> 7, tb = vc & 127;
                    for (int r2 = 0; r2 < REP_SC; ++r2) sconv_unit<8>(false, b, tb * 64, WSP(bf16, WS_Z), WSP(bf16, WS_MG), IN(18) + (size_t)l * 3 * 256, gout, nullptr, OUTP(O_SCP) + (size_t)l * 2 * 2 * 256);
                    if (vc < 192) { const int u = (vc - 64) >> 1, hf = (vc - 64) & 1;
                        sconv_unit<4>(false, 0, u * 64 + 32 * hf, WSP(bf16, WS_Z), WSP(bf16, WS_MG), IN(18) + (size_t)l * 3 * 256, gout, nullptr, OUTP(O_SCP) + (size_t)l * 2 * 2 * 256); }
                }
            } else
            for (int idx0 = cu; idx0 < 64 + 768; idx0 += G) {
                if (idx0 < 64) {
                    for (int r2 = 0; r2 < REP_SG; ++r2) small_gemm_unit<0>(lds, idx0, WSP(bf16, WS_XSB), (const bf16*)(ka->ws + WS_W + (size_t)l * W_LAYER + W_IN), DM, WSP(bf16, WS_ZS), DIN, nullptr, nullptr, nullptr, nullptr, nullptr);
                    continue;
                }
                const int idx = idx0 - 64;
                if (idx < 256) {
                    const int b = idx >> 7, qb = idx & 127;
                    for (int r2 = 0; r2 < REP_AT; ++r2) attn_prompt_unit(lds, b, qb * 64, WSP(bf16, WS_Z), WSP(bf16, WS_MG), sinks, gout, OUTP(O_CKP) + (size_t)(l * 2 + b) * 16384, OUTP(O_CVP) + (size_t)(l * 2 + b) * 16384);
                } else if (idx < 512) {
                    LruW LW{IN(11) + (size_t)l * 4 * 256, IN(12) + (size_t)l * 256, IN(14) + (size_t)l * 256, IN(16) + (size_t)l * 256,
                            IN(17) + (size_t)l * 256, gout, WSP(bf16, WS_LWT) + (size_t)l * 2 * 4 * 4096};
                    const int u = idx - 256, b = u >> 7, chunk = u & 127;
                    for (int r2 = 0; r2 < REP_LR; ++r2) lru_unit(lds, false, b, chunk * 64, WSP(bf16, WS_Z), WSP(bf16, WS_MG), LW, WSP(bf16, WS_HLOC), WSP(bf16, WS_CUMA), WSP(float, WS_AGGA), WSP(float, WS_AGGB),
                             nullptr, nullptr, OUTP(O_LCP) + (size_t)l * 2 * 3 * 256, nullptr);
                } else {
                    const int u = idx - 512, b = u >> 7, tb = u & 127;
                    for (int r2 = 0; r2 < REP_SC; ++r2) sconv_unit<8>(false, b, tb * 64, WSP(bf16, WS_Z), WSP(bf16, WS_MG), IN(18) + (size_t)l * 3 * 256, gout, nullptr, OUTP(O_SCP) + (size_t)l * 2 * 2 * 256);
                }
            }
        }
        xcd_barrier(bar);

        for (int rep_ = 0; rep_ < REP_P3; ++rep_)
        {
            PHASE_VARS
            const float* gout = IN(19) + (size_t)l * DM;
            for (int k = 0; k < 2; ++k) {
                int idx = -1;
                if (G == 256) {
                    const int vc = (cu & 7) * 32 + (cu >> 3);
                    if (k == 0) idx = (vc >= 128 && vc < 132) ? 256 + vc : vc;
                    else idx = (vc < 128) ? 256 + vc : ((vc >= 132 && vc < 136) ? vc - 4 : -1);
                    if (idx >= 384) idx = idx;
                }
                for (int i2 = (G == 256 ? idx : cu + k * 100000); i2 >= 0 && i2 < 388; i2 += (G == 256 ? 100000 : G)) {
                    const int id = i2;
                    if (id < 256) {
                        for (int r2 = 0; r2 < REP_LF; ++r2) lru_fix_unit(lds, id >> 7, id & 127, WSP(bf16, WS_Z), WSP(bf16, WS_MG), gout, WSP(bf16, WS_HLOC), WSP(bf16, WS_CUMA),
                                     WSP(float, WS_AGGA), WSP(float, WS_AGGB), OUTP(O_RGP) + (size_t)l * 2 * 256);
                    } else if (id < 384) {
                        const int s = id - 256;
                        for (int r2 = 0; r2 < REP_AS; ++r2) attn_sample_unit(lds, s, WSP(bf16, WS_ZS), WSP(bf16, WS_MGS), IN(10) + l * 8, gout, IN(2) + (size_t)l * NS * 16384, IN(3) + (size_t)l * NS * 16384,
                                         OUTP(O_CKS) + (size_t)l * NS * 16384, OUTP(O_CVS) + (size_t)l * NS * 16384);
                    } else if (id < 386) {
                        LruW LW{IN(11) + (size_t)l * 4 * 256, IN(12) + (size_t)l * 256, IN(14) + (size_t)l * 256, IN(16) + (size_t)l * 256,
                                IN(17) + (size_t)l * 256, gout, WSP(bf16, WS_LWT) + (size_t)l * 2 * 4 * 4096};
                        for (int r2 = 0; r2 < REP_LS; ++r2) lru_unit(lds, true, 0, (id - 384) * 64, WSP(bf16, WS_ZS), WSP(bf16, WS_MGS), LW, nullptr, nullptr, nullptr, nullptr, IN(5) + (size_t)l * NS * 3 * 256, IN(4) + (size_t)l * NS * 256,
                                 OUTP(O_LCS) + (size_t)l * NS * 3 * 256, OUTP(O_RGS) + (size_t)l * NS * 256);
                    } else {
                        sconv_unit<8>(true, 0, (id - 386) * 64, WSP(bf16, WS_ZS), WSP(bf16, WS_MGS), IN(18) + (size_t)l * 3 * 256, gout, IN(6) + (size_t)l * NS * 2 * 256, OUTP(O_SCS) + (size_t)l * NS * 2 * 256);
                    }
                }
                if (G != 256) break;
            }
        }
        xcd_barrier(bar);

        {
            PHASE_VARS
            const bf16* Wout_t = (const bf16*)(ka->ws + WS_W + (size_t)l * W_LAYER + W_OUT);
            if (cu < 32) {
                const float* xs_in = (l == 0) ? IN(1) : WSP(float, WS_XS);
                small_gemm_unit<1>(lds, cu, WSP(bf16, WS_MGS), Wout_t, DM, WSP(bf16, WS_XSB), 0, xs_in, WSP(float, WS_XS), nullptr, nullptr, nullptr);
            }
            pg8::Gemm g{WSP(bf16, WS_MG), Wout_t, MP, DM, DM}; pg8::StaticOrder S; S.init(MP, DM, G, cu);
            EpiRes E{WSP(bf16, WS_X), WSP(float, WS_SSQA), (LAS float*)(lds + 131072), lds, G == 256};
            if (G == 256) pg8::gemm_phase<EpiRes, pg8::StaticOrder, true, true, false, true>(lds, g, S, E);
            else pg8::gemm_phase<EpiRes, pg8::StaticOrder, true, true, false>(lds, g, S, E);
        }
        xcd_barrier(bar);

        for (int rep_ = 0; rep_ < REP_P5; ++rep_)
        {
            PHASE_VARS
            const bf16* Wup_t = (const bf16*)(ka->ws + WS_W + (size_t)l * W_LAYER + W_UP);
            const float* fcw = IN(23) + (size_t)l * 3 * DUP;
            pg8::Gemm g{WSP(bf16, WS_X), Wup_t, 66 * 256, DUP, DM}; pg8::StaticOrder S; S.init(66 * 256, DUP, G, cu);
            EpiFfn E{WSP(bf16, WS_ACT), fcw, OUTP(O_FFP) + (size_t)l * 2 * 2 * DUP, WSP(float, WS_SSQA)};
            pg8::gemm_phase<EpiFfn, pg8::StaticOrder, true, true, true>(lds, g, S, E);
            const int nwg = 66 * 22, rem = nwg % G, n_idle = rem ? G - rem : G, first_idle = G - n_idle;
            if (cu >= first_idle)
                for (int j3 = cu - first_idle; j3 < 59; j3 += n_idle)
                    small_ffn_unit(lds, j3, WSP(bf16, WS_XSB), Wup_t, WSP(bf16, WS_ACTS), fcw, IN(7) + (size_t)l * NS * 2 * DUP, OUTP(O_FFS) + (size_t)l * NS * 2 * DUP);
        }
        xcd_barrier(bar);

        {
            PHASE_VARS
            const bf16* Wdown_t = (const bf16*)(ka->ws + WS_W + (size_t)l * W_LAYER + W_DOWN);
            if (cu < 32)
                small_gemm_unit<1>(lds, cu, WSP(bf16, WS_ACTS), Wdown_t, DFF, WSP(bf16, WS_XSB), 0, WSP(float, WS_XS), WSP(float, WS_XS), nullptr, nullptr, nullptr);
            pg8::Gemm g{WSP(bf16, WS_ACT), Wdown_t, MP, DM, DFF}; pg8::StaticOrder S; S.init(MP, DM, G, cu);
            EpiRes E{WSP(bf16, WS_X), WSP(float, WS_SSQB), (LAS float*)(lds + 131072), lds, G == 256};
            if (G == 256) pg8::gemm_phase<EpiRes, pg8::StaticOrder, true, true, false, true>(lds, g, S, E);
            else pg8::gemm_phase<EpiRes, pg8::StaticOrder, true, true, false>(lds, g, S, E);
        }
        xcd_barrier(bar);
    }
    {
        PHASE_VARS
        const float* gfin = IN(25); const float* XS = WSP(float, WS_XS); float* ys = OUTP(O_YS); float* Y = OUTP(O_Y);
        const bf16* X = WSP(bf16, WS_X); const float* SSQB = WSP(float, WS_SSQB);
        f32x4 gg[4];
#pragma unroll
        for (int j = 0; j < 4; ++j) gg[j] = *(const f32x4*)(gfin + 4 * lane + 256 * j);
        for (int m0 = gw; m0 < MP; m0 += 4 * NGW) {
            u32x2 xr[4][4]; f32x4 sq[4];
#pragma unroll
            for (int r = 0; r < 4; ++r) { const int m = m0 + r * NGW; if (m < MP) { sq[r] = *(const f32x4*)(SSQB + 4 * (size_t)m);
#pragma unroll
                for (int j = 0; j < 4; ++j) xr[r][j] = *(const u32x2*)(X + (size_t)m * DM + 4 * lane + 256 * j); } }
#pragma unroll
            for (int r = 0; r < 4; ++r) { const int m = m0 + r * NGW; if (m < MP) {
                const float rs = rsqrtf(((sq[r].x + sq[r].y) + (sq[r].z + sq[r].w)) * (1.0f / DM) + EPS);
#pragma unroll
                for (int j = 0; j < 4; ++j) { const f32x4 v = (f32x4){bf2f(xr[r][j].x & 0xffffu), bf2f(xr[r][j].x >> 16), bf2f(xr[r][j].y & 0xffffu), bf2f(xr[r][j].y >> 16)};
                    *(f32x4*)(Y + (size_t)m * DM + 4 * lane + 256 * j) = v * gg[j] * rs; } } }
        }
        for (int m = gw; m < NS; m += NGW) rms_row_f32(XS + (size_t)m * DM, gfin, ys + (size_t)m * DM, lane);
    }
}

extern "C" void kernel_launch(void* const* d_in, const int* in_sizes, int n_in, void* d_out, int out_size, void* d_ws, size_t ws_size, hipStream_t stream) {
    static int grid = 0;
    if (grid == 0) {
        if (n_in != 26 || ws_size < WS_END) { fprintf(stderr, "kernel_launch: unexpected n_in %d / ws_size %zu\n", n_in, ws_size); grid = -1; return; }
        int dev = 0, cus = 0, per_cu = 0;
        hipGetDevice(&dev);
        hipDeviceGetAttribute(&cus, hipDeviceAttributeMultiprocessorCount, dev);
        hipFuncSetAttribute((const void*)fwd_megakernel, hipFuncAttributeMaxDynamicSharedMemorySize, LDS_BYTES);
        hipOccupancyMaxActiveBlocksPerMultiprocessor(&per_cu, (const void*)fwd_megakernel, NTHREADS, LDS_BYTES);
        if (per_cu < 1) per_cu = 1;
        (void)hipGetLastError();
        grid = cus;
    }
    if (grid < 0) return;
    if (hipMemsetAsync(d_ws, 0, 65536, stream) != hipSuccess) { fprintf(stderr, "memset failed\n"); return; }
    Args a{};
    for (int i = 0; i < 26; ++i) a.in[i] = (const float*)d_in[i];
    a.out = (float*)d_out; a.ws = (unsigned char*)d_ws;
    void* kargs[] = {&a};
    hipError_t e = hipLaunchCooperativeKernel((const void*)fwd_megakernel, dim3(grid), dim3(NTHREADS), kargs, LDS_BYTES, stream);
    if (e != hipSuccess) fprintf(stderr, "cooperative launch failed: %s (grid %d)\n", hipGetErrorString(e), grid);
}
```

```cpp
#include <hip/hip_runtime.h>
#include <hip/hip_cooperative_groups.h>
#include <cstdio>
#include <cstdint>
namespace cg = cooperative_groups;
namespace pg8 {
#define PG8_LAS __attribute__((address_space(3)))
typedef unsigned short bf16_t;
typedef short bf16x8 __attribute__((ext_vector_type(8)));
typedef float f32x4 __attribute__((ext_vector_type(4)));
typedef unsigned u32x4 __attribute__((ext_vector_type(4)));
constexpr int BM = 256, BK = 64, HALF = 128, HTB = HALF * BK * 2  , STAGE_BYTES = 8 * HTB, NXCD = 8, WGM = 8;

__host__ __device__ __forceinline__ int lds_byte(int r, int c) { const int st = (r >> 4) * 2 + (c >> 5), rr = r & 15, cc = c & 31, ob = rr * 64 + cc * 2; return st * 1024 + (ob ^ (((ob >> 9) & 1) << 5)); }
__host__ __device__ __forceinline__ void stage_rc(int b, int& R, int& C) { const int st = b / 1024, sb = b % 1024, swz = sb ^ (((sb >> 9) & 1) << 5); R = (st >> 1) * 16 + swz / 64; C = (st & 1) * 32 + (swz % 64) / 2; }
__host__ __device__ __forceinline__ int perm32(int rho) { const int n = rho >> 4, i = rho & 15; return 8 * (i >> 2) + 4 * n + (i & 3); }

struct Unit { int pm, pn; };
struct Gemm { const bf16_t* A; const bf16_t* Bt; int M, N, K; };

struct StaticOrder {
    int nM, nN, nwg, G, c;
    __host__ __device__ void init(int M, int N, int G_, int c_) { nM = M / BM; nN = N / BM; nwg = nM * nN; G = G_; c = c_; }
    __host__ __device__ bool next(int i, Unit& u) const {
        const long L = (long)i * G + c; if (L >= nwg) return false;
        int wgid = (int)L; { const int q = nwg / NXCD, r = nwg % NXCD, xcd = wgid % NXCD, off = wgid / NXCD; wgid = (xcd < r ? xcd * (q + 1) : r * (q + 1) + (xcd - r) * q) + off; }
        const int nig = WGM * nN, gid = wgid / nig, fm = gid * WGM, gsz = (nM - fm) < WGM ? (nM - fm) : WGM;
        u.pm = fm + ((wgid % nig) % gsz); u.pn = (wgid % nig) / gsz; return true;
    }
    __device__ __forceinline__ void a_ready(const Unit&) const {}
    __device__ __forceinline__ void done(const Unit&) const {}
};

__device__ __forceinline__ unsigned cvt_pk_bf16(float lo, float hi) { unsigned r; asm volatile("v_cvt_pk_bf16_f32 %0, %1, %2" : "=v"(r) : "v"(lo), "v"(hi)); return r; }
typedef float f32x2 __attribute__((ext_vector_type(2)));
__device__ __forceinline__ f32x2 gelu_pk(f32x2 v) {
    const f32x2 av = __builtin_elementwise_abs(v), d = av * 0.2316418882f + 1.0f;
    f32x2 t; t.x = __builtin_amdgcn_rcpf(d.x); t.y = __builtin_amdgcn_rcpf(d.y);
    f32x2 q = t * 0.5307027145f + (-0.7265760135f); q = q * t + 0.7107068705f; q = q * t + (-0.142248368f); q = q * t + 0.127414796f; q = q * t;
    const f32x2 s = (v * v) * (-0.72134752044f);
    f32x2 e; e.x = __builtin_amdgcn_exp2f(s.x); e.y = __builtin_amdgcn_exp2f(s.y);
    const f32x2 m = v * (q * e), r = v - m;
    f32x2 o; o.x = v.x < 0.f ? m.x : r.x; o.y = v.y < 0.f ? m.y : r.y; return o;
}

template <int ACT  > struct EpiBf16 {
    static constexpr bool PERM = true, AFTER_DRAIN = false; static_assert(ACT == 0 || ACT == 1, "EpiBf16: ACT is 0 (none) or 1 (gelu_pk)");
    bf16_t* O; int ldc; const float* bias; int split_cols; size_t split_stride; float scale0;
    __device__ __forceinline__ void operator()(const f32x4 (&acc)[2][2][4][2], const Unit& u, int wr, int wc, int fr, int fq) const {
        const int row0 = u.pm * BM + wr * 64 + fr; int colt = u.pn * BM; bf16_t* base = O;
        float sc = 1.f; if (split_cols) { const int t = colt / split_cols; base += (size_t)t * split_stride; colt -= t * split_cols; if (t == 0) sc = scale0; }
        const int col0 = colt + wc * 32 + 8 * fq, bcol0 = u.pn * BM + wc * 32 + 8 * fq;
        f32x4 bv[2][2];
#pragma unroll
        for (int bj = 0; bj < 2; ++bj)
#pragma unroll
            for (int n = 0; n < 2; ++n) bv[bj][n] = bias ? *(const f32x4*)(bias + bcol0 + bj * HALF + 4 * n) : (f32x4){0.f, 0.f, 0.f, 0.f};
#pragma unroll
        for (int ai = 0; ai < 2; ++ai)
#pragma unroll
            for (int m = 0; m < 4; ++m) { bf16_t* rowp = base + (size_t)(row0 + ai * HALF + m * 16) * ldc + col0;
#pragma unroll
                for (int bj = 0; bj < 2; ++bj) { f32x4 v0 = acc[ai][bj][m][0] + bv[bj][0], v1 = acc[ai][bj][m][1] + bv[bj][1];
                    if (ACT == 1) { f32x2 a = gelu_pk((f32x2){v0[0], v0[1]}), b = gelu_pk((f32x2){v0[2], v0[3]}), c = gelu_pk((f32x2){v1[0], v1[1]}), d = gelu_pk((f32x2){v1[2], v1[3]});
                        v0 = (f32x4){a.x, a.y, b.x, b.y}; v1 = (f32x4){c.x, c.y, d.x, d.y}; }
                    v0 = v0 * sc; v1 = v1 * sc; u32x4 w; w.x = cvt_pk_bf16(v0[0], v0[1]); w.y = cvt_pk_bf16(v0[2], v0[3]); w.z = cvt_pk_bf16(v1[0], v1[1]); w.w = cvt_pk_bf16(v1[2], v1[3]);
                    *(u32x4*)(rowp + bj * HALF) = w; } }
    }
};

struct PanelStats {
    unsigned* xbuf;
    unsigned* cnt;
    unsigned* tmo;
    int ntn; float eps;
    unsigned code;
    __device__ __forceinline__ bool run(const f32x4 (&v)[2][2][4][2], const Unit& u, int wr, int wc, int fr, int fq, PG8_LAS unsigned char* lds, int wid, int lane) const {
        typedef float f32x2v __attribute__((ext_vector_type(2)));
        PG8_LAS f32x2v* P = (PG8_LAS f32x2v*)lds;
        PG8_LAS f32x2v* S = (PG8_LAS f32x2v*)(lds + 8192);
        PG8_LAS unsigned* flag = (PG8_LAS unsigned*)(lds + 8192 + 2048);
#pragma unroll
        for (int ai = 0; ai < 2; ++ai)
#pragma unroll
            for (int m = 0; m < 4; ++m) {
                float s = 0.f;
#pragma unroll
                for (int bj = 0; bj < 2; ++bj)
#pragma unroll
                    for (int n = 0; n < 2; ++n) { const f32x4 x = v[ai][bj][m][n]; s += (x[0] + x[1]) + (x[2] + x[3]); }
                s += __shfl_xor(s, 16); s += __shfl_xor(s, 32);
                const float mw = s * (1.0f / 64.0f); float q = 0.f;
#pragma unroll
                for (int bj = 0; bj < 2; ++bj)
#pragma unroll
                    for (int n = 0; n < 2; ++n) { const f32x4 d = v[ai][bj][m][n] - mw; q += (d[0] * d[0] + d[1] * d[1]) + (d[2] * d[2] + d[3] * d[3]); }
                q += __shfl_xor(q, 16); q += __shfl_xor(q, 32);
                if (fq == 0) P[(ai * HALF + wr * 64 + m * 16 + fr) * 4 + wc] = (f32x2v){mw, q};
            }
        asm volatile("s_waitcnt lgkmcnt(0)" ::: "memory"); __builtin_amdgcn_s_barrier(); asm volatile("" ::: "memory");
#if defined(BROKEN_EXCHANGE_NO_WAIT)
#warning BROKEN CONTROL BUILD: the row-statistics exchange does not wait; results are wrong by design
        if (blockIdx.x >= 64) { const long long t0_ = clock64(); while (clock64() - t0_ < 60000) __builtin_amdgcn_s_sleep(8); }
#endif
        const int row = wid * 32 + (lane & 31);
        if (lane < 32) {
            const f32x2v a = P[row * 4 + 0], b = P[row * 4 + 1], c = P[row * 4 + 2], d = P[row * 4 + 3];
            const float mt = (a.x + b.x + c.x + d.x) * 0.25f;
            const float da = a.x - mt, db = b.x - mt, dc = c.x - mt, dd = d.x - mt;
            const float m2 = (a.y + b.y) + (c.y + d.y) + 64.0f * ((da * da + db * db) + (dc * dc + dd * dd));
            unsigned long long* slot = (unsigned long long*)xbuf + ((size_t)(u.pm * BM + row) * 4 + u.pn);
            __hip_atomic_store(slot, ((unsigned long long)__float_as_uint(m2) << 32) | __float_as_uint(mt), __ATOMIC_RELAXED, __HIP_MEMORY_SCOPE_AGENT);
        }
        asm volatile("s_waitcnt vmcnt(0)" ::: "memory");
        if (lane == 0) __hip_atomic_fetch_add(cnt + 64 * u.pm, 1u, __ATOMIC_RELAXED, __HIP_MEMORY_SCOPE_AGENT);
        if (wid == 0) {
            bool dead = false; const unsigned long long t0 = __builtin_amdgcn_s_memrealtime(); const unsigned want = 8u * (unsigned)ntn;
            for (;;) {
#if defined(BROKEN_EXCHANGE_NO_WAIT)
                break;
#endif
                if ((unsigned)__builtin_amdgcn_readfirstlane(__hip_atomic_load(cnt + 64 * u.pm, __ATOMIC_RELAXED, __HIP_MEMORY_SCOPE_AGENT)) >= want) break;
                if (__builtin_amdgcn_s_memrealtime() - t0 > 2000000ull) {
                    if (lane == 0) { unsigned expect = 0u; __hip_atomic_compare_exchange_strong(tmo + 1, &expect, code | (unsigned)(u.pm & 0xff), __ATOMIC_RELAXED, __ATOMIC_RELAXED, __HIP_MEMORY_SCOPE_AGENT);
                                     __hip_atomic_store(tmo, 1u, __ATOMIC_RELAXED, __HIP_MEMORY_SCOPE_AGENT); }
                    dead = true; break; }
                __builtin_amdgcn_s_sleep(2);
            }
            __builtin_amdgcn_fence(__ATOMIC_ACQUIRE, "agent");
            if (lane == 0) flag[0] = dead ? 1u : 0u;
        }
        asm volatile("s_waitcnt vmcnt(0) lgkmcnt(0)" ::: "memory"); __builtin_amdgcn_s_barrier(); asm volatile("" ::: "memory");
        const bool bad = flag[0] != 0u;
        if (lane < 32) {
            const unsigned long long* slot = (const unsigned long long*)xbuf + (size_t)(u.pm * BM + row) * 4; float mt[4], m2[4]; float ms = 0.f;
#pragma unroll
            for (int t = 0; t < 4; ++t) { if (t < ntn) { const unsigned long long w = __hip_atomic_load(slot + t, __ATOMIC_RELAXED, __HIP_MEMORY_SCOPE_AGENT); mt[t] = __uint_as_float((unsigned)w); m2[t] = __uint_as_float((unsigned)(w >> 32)); } else { mt[t] = 0.f; m2[t] = 0.f; } ms += mt[t]; }
            const float mean = ms / (float)ntn; float q = 0.f;
#pragma unroll
            for (int t = 0; t < 4; ++t) if (t < ntn) { const float dm = mt[t] - mean; q += m2[t] + 256.0f * dm * dm; }
            S[row] = (f32x2v){mean, 1.0f / sqrtf(q / (256.0f * (float)ntn) + eps)};
        }
        asm volatile("s_waitcnt lgkmcnt(0)" ::: "memory"); __builtin_amdgcn_s_barrier(); asm volatile("" ::: "memory");
        return bad;
    }
};
struct EpiLnRes {
    static constexpr bool PERM = false, AFTER_DRAIN = true;
    const float* base; float* out; int ldc; const float* bias; PanelStats st; unsigned poison;
    __device__ __forceinline__ void fused(f32x4 (&acc)[2][2][4][2], const Unit& u, int wr, int wc, int fr, int fq, PG8_LAS unsigned char* lds, int wid, int lane) const {
        typedef float f32x2v __attribute__((ext_vector_type(2)));
        const PG8_LAS f32x2v* S = (const PG8_LAS f32x2v*)(lds + 8192);
        const int col0 = u.pn * BM + wc * 32 + 4 * fq;
#pragma unroll
        for (int bj = 0; bj < 2; ++bj)
#pragma unroll
            for (int n = 0; n < 2; ++n) { const f32x4 bv = bias ? *(const f32x4*)(bias + col0 + bj * HALF + n * 16) : (f32x4){0.f, 0.f, 0.f, 0.f};
#pragma unroll
                for (int ai = 0; ai < 2; ++ai)
#pragma unroll
                    for (int m = 0; m < 4; ++m) acc[ai][bj][m][n] += bv; }
        f32x4 pre[4][2][2];
#pragma unroll
        for (int m = 0; m < 4; ++m) { const size_t off = (size_t)(u.pm * BM + wr * 64 + m * 16 + fr) * ldc + col0;
#pragma unroll
            for (int bj = 0; bj < 2; ++bj)
#pragma unroll
                for (int n = 0; n < 2; ++n) pre[m][bj][n] = *(const f32x4*)(base + off + bj * HALF + n * 16); }
        const bool bad = st.run(acc, u, wr, wc, fr, fq, lds, wid, lane) || poison != 0u;
        const float qnan = __builtin_nanf("");
#pragma unroll
        for (int ai = 0; ai < 2; ++ai)
#pragma unroll
            for (int m = 0; m < 4; ++m) { const int r = ai * HALF + wr * 64 + m * 16 + fr; const f32x2v sr = S[r]; const size_t off = (size_t)(u.pm * BM + r) * ldc + col0;
#pragma unroll
                for (int bj = 0; bj < 2; ++bj)
#pragma unroll
                    for (int n = 0; n < 2; ++n) { const f32x4 bs = ai == 0 ? pre[m][bj][n] : *(const f32x4*)(base + off + bj * HALF + n * 16); f32x4 o = bs + (acc[ai][bj][m][n] - sr.x) * sr.y;
                        if (bad) o = (f32x4){qnan, qnan, qnan, qnan}; *(f32x4*)(out + off + bj * HALF + n * 16) = o; }
                if (m & 1) asm volatile("" ::: "memory"); }
    }
};
struct EpiLnResLn {
    static constexpr bool PERM = false, AFTER_DRAIN = true;
    const float* base; float* out; bf16_t* xn; int ldc; const float* bias; PanelStats st1, st2; unsigned poison;
    __device__ __forceinline__ void fused(f32x4 (&acc)[2][2][4][2], const Unit& u, int wr, int wc, int fr, int fq, PG8_LAS unsigned char* lds, int wid, int lane) const {
        typedef float f32x2v __attribute__((ext_vector_type(2))); typedef unsigned u32x2v __attribute__((ext_vector_type(2)));
        const PG8_LAS f32x2v* S = (const PG8_LAS f32x2v*)(lds + 8192);
        const int col0 = u.pn * BM + wc * 32 + 4 * fq;
#pragma unroll
        for (int bj = 0; bj < 2; ++bj)
#pragma unroll
            for (int n = 0; n < 2; ++n) { const f32x4 bv = bias ? *(const f32x4*)(bias + col0 + bj * HALF + n * 16) : (f32x4){0.f, 0.f, 0.f, 0.f};
#pragma unroll
                for (int ai = 0; ai < 2; ++ai)
#pragma unroll
                    for (int m = 0; m < 4; ++m) acc[ai][bj][m][n] += bv; }
        bool bad = st1.run(acc, u, wr, wc, fr, fq, lds, wid, lane) || poison != 0u;
        const float qnan = __builtin_nanf("");
#pragma unroll
        for (int ai = 0; ai < 2; ++ai)
#pragma unroll
            for (int m = 0; m < 4; ++m) { const int r = ai * HALF + wr * 64 + m * 16 + fr; const f32x2v sr = S[r]; const size_t off = (size_t)(u.pm * BM + r) * ldc + col0;
#pragma unroll
                for (int bj = 0; bj < 2; ++bj)
#pragma unroll
                    for (int n = 0; n < 2; ++n) { const f32x4 bs = *(const f32x4*)(base + off + bj * HALF + n * 16); acc[ai][bj][m][n] = bs + (acc[ai][bj][m][n] - sr.x) * sr.y; }
                asm volatile("" : "+v"(acc[ai][0][m][0]), "+v"(acc[ai][0][m][1]), "+v"(acc[ai][1][m][0]), "+v"(acc[ai][1][m][1]));
                if (m & 1) asm volatile("" ::: "memory"); }
        const bool bad1 = bad;
        bad = st2.run(acc, u, wr, wc, fr, fq, lds, wid, lane) || bad;
#pragma unroll
        for (int ai = 0; ai < 2; ++ai)
#pragma unroll
            for (int m = 0; m < 4; ++m) { const int r = ai * HALF + wr * 64 + m * 16 + fr; const f32x2v sr = S[r]; const size_t off = (size_t)(u.pm * BM + r) * ldc + col0;
#pragma unroll
                for (int bj = 0; bj < 2; ++bj)
#pragma unroll
                    for (int n = 0; n < 2; ++n) { const f32x4 x1 = acc[ai][bj][m][n]; *(f32x4*)(out + off + bj * HALF + n * 16) = bad1 ? (f32x4){qnan, qnan, qnan, qnan} : x1;
                        const f32x4 o = (x1 - sr.x) * sr.y; u32x2v w; w.x = cvt_pk_bf16(o[0], o[1]); w.y = cvt_pk_bf16(o[2], o[3]);
                        if (bad) { w.x = 0x7fc07fc0u; w.y = 0x7fc07fc0u; } *(u32x2v*)(xn + off + bj * HALF + n * 16) = w; }
                asm volatile("" ::: "memory"); }
    }
};

template <class Epi, class Sched, bool ALIGN_EPI = false, bool SP2 = false, bool AMAP = false, bool XPRE = false>
__device__ __forceinline__ void gemm_phase(PG8_LAS unsigned char* lds, const Gemm g, const Sched& S, const Epi& E) {
    int tid_o = threadIdx.x; asm volatile("" : "+v"(tid_o)); const int tid = tid_o, wid = __builtin_amdgcn_readfirstlane(tid >> 6), lane = tid & 63, wr = wid >> 2, wc = wid & 3, fr = lane & 15, fq = lane >> 4;
    const int K = g.K, nt = K / BK;
    unsigned voffA[2], voffB[2];
#pragma unroll
    for (int i = 0; i < 2; ++i) { int R, C; stage_rc(tid * 16 + i * 8192, R, C); const int Rb = Epi::PERM ? ((R & ~31) + perm32(R & 31)) : R;
        const int Ra = AMAP ? ((R >> 6) * 126 + 8 * (R & 15) + ((R >> 4) & 3)) : R;
        voffA[i] = (unsigned)(Ra * K + C) * 2u; voffB[i] = (unsigned)(Rb * K + C) * 2u; }
    const size_t kstep = (size_t)(BK * 2);
    const size_t hstep = (size_t)HALF * K * 2;
    const size_t tstep = 2 * hstep;
    const size_t hstepA = AMAP ? (size_t)4 * K * 2 : hstep;
#define PG8_AROW(pm) (AMAP ? ((long)((pm) / 33) * 8192 + (long)((pm) % 33) * 252 - 2) : (long)(pm) * 256)
    const unsigned ldsw = (unsigned)wid * 1024u;
    const int aoff = lds_byte(wr * 64 + fr, fq * 8), boff = lds_byte(wc * 32 + fr, fq * 8);
#define PG8_SA(b, h) (((b) * 2 + (h)) * HTB)
#define PG8_SB(b, h) ((4 + (b) * 2 + (h)) * HTB)
#define PG8_STAGE(bufoff, gbase, voff) do { _Pragma("unroll") for (int _i = 0; _i < 2; ++_i) \
        __builtin_amdgcn_global_load_lds((const unsigned*)((const char*)(gbase) + (voff)[_i]), (PG8_LAS unsigned*)(lds + (bufoff) + ldsw + _i * 8192), 16, 0, 0); } while (0)
#define PG8_LDA(dst, b, h) do { _Pragma("unroll") for (int m = 0; m < 4; ++m) _Pragma("unroll") for (int k = 0; k < 2; ++k) dst[m][k] = *(const PG8_LAS bf16x8*)(lds + PG8_SA(b, h) + aoff + m * 2048 + k * 1024); } while (0)
#define PG8_LDB(dst, b, h) do { _Pragma("unroll") for (int n = 0; n < 2; ++n) _Pragma("unroll") for (int k = 0; k < 2; ++k) dst[n][k] = *(const PG8_LAS bf16x8*)(lds + PG8_SB(b, h) + boff + n * 2048 + k * 1024); } while (0)
#define PG8_MMA(ai, bj, At, Bt) do { __builtin_amdgcn_s_setprio(1); _Pragma("unroll") for (int m = 0; m < 4; ++m) _Pragma("unroll") for (int n = 0; n < 2; ++n) _Pragma("unroll") for (int k = 0; k < 2; ++k) \
        acc[ai][bj][m][n] = __builtin_amdgcn_mfma_f32_16x16x32_bf16(Bt[n][k], At[m][k], acc[ai][bj][m][n], 0, 0, 0); __builtin_amdgcn_s_setprio(0); } while (0)
#define PG8_WAIT_V(n) asm volatile("s_waitcnt vmcnt(" #n ")" ::: "memory")
#define PG8_WAIT_L(n) asm volatile("s_waitcnt lgkmcnt(" #n ")" ::: "memory")
#define PG8_BAR __builtin_amdgcn_s_barrier()
#define PG8_SCHED __builtin_amdgcn_sched_barrier(0)
    Unit cur, nxt; int ui = 0;
    if (!S.next(0, cur)) return;
    f32x4 acc[2][2][4][2];
#pragma unroll
    for (int a = 0; a < 2; ++a)
#pragma unroll
        for (int b = 0; b < 2; ++b)
#pragma unroll
            for (int m = 0; m < 4; ++m)
#pragma unroll
                for (int n = 0; n < 2; ++n) acc[a][b][m][n] = (f32x4){0.f, 0.f, 0.f, 0.f};
    bf16x8 At[4][2], B0[2][2], B1[2][2];
    const char* cA = (const char*)g.A + PG8_AROW(cur.pm) * (long)K * 2; const char* cB = (const char*)g.Bt + (size_t)cur.pn * tstep;
    S.a_ready(cur);
    if constexpr (SP2) {
        PG8_STAGE(PG8_SB(0, 0), cB, voffB); PG8_STAGE(PG8_SB(0, 1), cB + hstep, voffB); PG8_STAGE(PG8_SA(0, 0), cA, voffA); PG8_STAGE(PG8_SA(0, 1), cA + hstepA, voffA);
        if (wr == 1) PG8_BAR;
        PG8_WAIT_V(2); PG8_BAR;
        PG8_STAGE(PG8_SB(1, 0), cB + kstep, voffB); PG8_STAGE(PG8_SA(1, 0), cA + kstep, voffA); PG8_STAGE(PG8_SB(1, 1), cB + hstep + kstep, voffB);
        PG8_WAIT_V(6); PG8_BAR;
    } else {
        PG8_STAGE(PG8_SB(0, 0), cB, voffB); PG8_STAGE(PG8_SA(0, 0), cA, voffA); PG8_STAGE(PG8_SB(0, 1), cB + hstep, voffB); PG8_STAGE(PG8_SA(0, 1), cA + hstepA, voffA);
        if (wr == 1) PG8_BAR;
        PG8_WAIT_V(4); PG8_BAR;
        PG8_STAGE(PG8_SB(1, 0), cB + kstep, voffB); PG8_STAGE(PG8_SA(1, 0), cA + kstep, voffA); PG8_STAGE(PG8_SB(1, 1), cB + hstep + kstep, voffB);
        PG8_WAIT_V(6); PG8_BAR;
    }
    for (;;) {
        const bool has_next = S.next(ui + 1, nxt);
        const char* nA = has_next ? (const char*)g.A + PG8_AROW(nxt.pm) * (long)K * 2 : cA; const char* nB = has_next ? (const char*)g.Bt + (size_t)nxt.pn * tstep : cB;
        for (int t = 0; t < nt; t += 2) {
            const bool last = (t == nt - 2);
            const bool xl = XPRE && last && !has_next;
            unsigned vx0 = 0u, vx1 = 0u; const char* xb = nullptr;
            if constexpr (XPRE) { if (xl) { int t_ = threadIdx.x; asm volatile("" : "+v"(t_)); int R_, C_; stage_rc(t_ * 16, R_, C_); vx0 = (unsigned)(R_ * 1024 + C_) * 2u; stage_rc(t_ * 16 + 8192, R_, C_); vx1 = (unsigned)(R_ * 1024 + C_) * 2u;
                xb = (const char*)E.X + ((size_t)cur.pm * 256 * 1024 + (size_t)cur.pn * 256) * 2; } }
#define PG8_STAGE_X(bufoff, q) do { const char* _g = xb + ((size_t)((q) & 1) * 128 * 1024 + (size_t)((q) >> 1) * 64) * 2; \
        __builtin_amdgcn_global_load_lds((const unsigned*)(_g + vx0), (PG8_LAS unsigned*)(lds + (bufoff) + ldsw), 16, 0, 0); \
        __builtin_amdgcn_global_load_lds((const unsigned*)(_g + vx1), (PG8_LAS unsigned*)(lds + (bufoff) + ldsw + 8192), 16, 0, 0); } while (0)
            const char* a1 = cA + (size_t)(t + 1) * kstep;
            const char* a2 = last ? nA : cA + (size_t)(t + 2) * kstep; const char* b2 = last ? nB : cB + (size_t)(t + 2) * kstep;
            const char* a3 = a2 + kstep; const char* b3 = b2 + kstep;
            if (last && has_next) S.a_ready(nxt);
            if constexpr (SP2) {
            PG8_LDB(B0, 0, 0); PG8_LDB(B1, 0, 1); PG8_SCHED; PG8_LDA(At, 0, 0); PG8_STAGE(PG8_SA(1, 1), a1 + hstepA, voffA);
            PG8_WAIT_V(8); PG8_WAIT_L(0); PG8_BAR; PG8_MMA(0, 0, At, B0); PG8_MMA(0, 1, At, B1); PG8_BAR; PG8_SCHED;
            PG8_LDA(At, 0, 1); if (xl) { PG8_STAGE_X(PG8_SB(0, 0), 0); PG8_STAGE_X(PG8_SB(0, 1), 1); PG8_STAGE_X(PG8_SA(0, 0), 2); } else { PG8_STAGE(PG8_SB(0, 0), b2, voffB); PG8_STAGE(PG8_SB(0, 1), b2 + hstep, voffB); PG8_STAGE(PG8_SA(0, 0), a2, voffA); }
            PG8_WAIT_V(8); PG8_WAIT_L(0); PG8_BAR; PG8_MMA(1, 0, At, B0); PG8_MMA(1, 1, At, B1); PG8_BAR; PG8_SCHED;
            PG8_LDB(B0, 1, 0); PG8_LDB(B1, 1, 1); PG8_SCHED; PG8_LDA(At, 1, 0); if (xl) { PG8_STAGE_X(PG8_SA(0, 1), 3); } else { PG8_STAGE(PG8_SA(0, 1), a2 + hstepA, voffA); }
            PG8_WAIT_V(8); PG8_WAIT_L(0); PG8_BAR; PG8_MMA(0, 0, At, B0); PG8_MMA(0, 1, At, B1); PG8_BAR; PG8_SCHED;
            PG8_LDA(At, 1, 1); if (xl) { PG8_STAGE_X(PG8_SB(1, 0), 4); PG8_STAGE_X(PG8_SB(1, 1), 5); PG8_STAGE_X(PG8_SA(1, 0), 6); } else { PG8_STAGE(PG8_SB(1, 0), b3, voffB); PG8_STAGE(PG8_SB(1, 1), b3 + hstep, voffB); PG8_STAGE(PG8_SA(1, 0), a3, voffA); }
            PG8_WAIT_V(8); PG8_WAIT_L(0); PG8_BAR; PG8_MMA(1, 0, At, B0); PG8_MMA(1, 1, At, B1); PG8_BAR; PG8_SCHED;
            } else {
            PG8_LDB(B0, 0, 0); PG8_SCHED; PG8_LDA(At, 0, 0); PG8_STAGE(PG8_SA(1, 1), a1 + hstepA, voffA);
            PG8_WAIT_L(8); PG8_BAR; PG8_WAIT_L(0); PG8_MMA(0, 0, At, B0); PG8_BAR; PG8_SCHED;
            PG8_LDB(B1, 0, 1); PG8_STAGE(PG8_SB(0, 0), b2, voffB);
            PG8_BAR; PG8_WAIT_L(0); PG8_MMA(0, 1, At, B1); PG8_BAR;
            PG8_LDA(At, 0, 1); PG8_STAGE(PG8_SA(0, 0), a2, voffA);
            PG8_BAR; PG8_WAIT_L(0); PG8_MMA(1, 0, At, B0); PG8_BAR; PG8_SCHED;
            PG8_STAGE(PG8_SB(0, 1), b2 + hstep, voffB);
            PG8_WAIT_V(6); PG8_BAR; PG8_MMA(1, 1, At, B1); PG8_BAR;
            PG8_LDB(B0, 1, 0); PG8_SCHED; PG8_LDA(At, 1, 0); PG8_STAGE(PG8_SA(0, 1), a2 + hstepA, voffA);
            PG8_WAIT_L(8); PG8_BAR; PG8_WAIT_L(0); PG8_MMA(0, 0, At, B0); PG8_BAR; PG8_SCHED;
            PG8_LDB(B1, 1, 1); PG8_STAGE(PG8_SB(1, 0), b3, voffB);
            PG8_BAR; PG8_WAIT_L(0); PG8_MMA(0, 1, At, B1); PG8_BAR;
            PG8_LDA(At, 1, 1); PG8_STAGE(PG8_SA(1, 0), a3, voffA);
            PG8_BAR; PG8_WAIT_L(0); PG8_MMA(1, 0, At, B0); PG8_BAR; PG8_SCHED;
            PG8_STAGE(PG8_SB(1, 1), b3 + hstep, voffB);
            PG8_WAIT_V(6); PG8_BAR; PG8_MMA(1, 1, At, B1); PG8_BAR;
            }
        }
        if constexpr (ALIGN_EPI) { if (wr == 0) PG8_BAR; }
        if constexpr (!Epi::AFTER_DRAIN) { E(acc, cur, wr, wc, fr, fq); S.done(cur); }
        if (!has_next) break;
#pragma unroll
        for (int a = 0; a < 2; ++a)
#pragma unroll
            for (int b = 0; b < 2; ++b)
#pragma unroll
                for (int m = 0; m < 4; ++m)
#pragma unroll
                    for (int n = 0; n < 2; ++n) acc[a][b][m][n] = (f32x4){0.f, 0.f, 0.f, 0.f};
        cur = nxt; cA = nA; cB = nB; ++ui;
        if constexpr (ALIGN_EPI) { if (wr == 1) PG8_BAR; }
    }
    PG8_WAIT_V(0);
    if constexpr (!ALIGN_EPI) { if (wr == 0) PG8_BAR; }
    PG8_BAR;
    if constexpr (Epi::AFTER_DRAIN) { E.fused(acc, cur, wr, wc, fr, fq, lds, wid, lane); S.done(cur); }
#undef PG8_AROW
#undef PG8_STAGE_X
#undef PG8_SA
#undef PG8_SB
#undef PG8_STAGE
#undef PG8_LDA
#undef PG8_LDB
#undef PG8_MMA
#undef PG8_WAIT_V
#undef PG8_WAIT_L
#undef PG8_BAR
#undef PG8_SCHED
}
}

#define GAS __attribute__((address_space(1)))
#define LAS __attribute__((address_space(3)))
typedef unsigned short bf16;
typedef float f32x4 __attribute__((ext_vector_type(4)));
typedef float f32x2 __attribute__((ext_vector_type(2)));
typedef float f32x16 __attribute__((ext_vector_type(16)));
typedef short bf16x8 __attribute__((ext_vector_type(8)));
typedef unsigned u32x4 __attribute__((ext_vector_type(4)));
typedef unsigned u32x2 __attribute__((ext_vector_type(2)));

constexpr int DM = 1024, SEQ = 8192, NBATCH = 2, MP = NBATCH * SEQ, NS = 128, DEPTH = 4;
constexpr int DIN = 2048, DFF = 2816, DUP = 5632, DLRU = 256;
constexpr float EPS = 1e-6f;
constexpr int NWAVES = 8, NTHREADS = 512;
constexpr int LDS_BYTES = 147456;
constexpr int ZQ = 0, ZK = 512, ZV = 640, ZLX = 768, ZLG = 1024, ZSB = 1280, ZSC = 1536, ZSU = 1792;
constexpr size_t O_Y = 0, O_YS = 16777216, O_CKP = 16908288, O_CVP = 17039360, O_RGP = 17170432, O_LCP = 17172480, O_SCP = 17178624,
                 O_FFP = 17182720, O_CKS = 17272832, O_CVS = 25661440, O_RGS = 34050048, O_LCS = 34181120, O_SCS = 34574336, O_FFS = 34836480;
constexpr size_t MiB = 1u << 20;
constexpr size_t WS_LWT = 1 * MiB;
constexpr size_t WS_W = 2 * MiB, W_LAYER = 23592960;
constexpr size_t W_IN = 0, W_OUT = 4 * MiB, W_UP = 6 * MiB, W_DOWN = 17 * MiB;
constexpr size_t WS_XS = 92 * MiB;
constexpr size_t WS_ZS = WS_XS + 512 * 1024;
constexpr size_t WS_MGS = WS_ZS + 512 * 1024;
constexpr size_t WS_ACTS = WS_MGS + 256 * 1024;
constexpr size_t WS_XSB = WS_ACTS + 768 * 1024;
constexpr size_t WS_AGGA = 95 * MiB, WS_AGGB = 95 * MiB + 512 * 1024;
constexpr size_t WS_Z = 96 * MiB;
constexpr size_t WS_MG = 160 * MiB;
constexpr size_t WS_HLOC = 192 * MiB, WS_CUMA = 208 * MiB;
constexpr size_t WS_XN = 192 * MiB;
constexpr size_t WS_ACT = 226 * MiB;
constexpr size_t WS_SSQA = 94 * MiB + 256 * 1024 + 4096, WS_SSQB = 94 * MiB + 640 * 1024 + 4096;
constexpr size_t WS_X = 316 * MiB + 64 * 1024;
constexpr size_t WS_END = 349 * MiB;

__device__ __forceinline__ float bf2f(unsigned v) { return __uint_as_float(v << 16); }
__device__ __forceinline__ unsigned f2bf(float f) { unsigned u = __float_as_uint(f); return (u + 0x7fffu + ((u >> 16) & 1u)) >> 16; }
__device__ __forceinline__ unsigned pk2(float lo, float hi) { unsigned r; asm volatile("v_cvt_pk_bf16_f32 %0, %1, %2" : "=v"(r) : "v"(lo), "v"(hi)); return r; }
__device__ __forceinline__ float wave_sum(float v) {
#pragma unroll
    for (int o = 1; o < 64; o <<= 1) v += __shfl_xor(v, o);
    return v;
}
__device__ __forceinline__ float wave_max(float v) {
#pragma unroll
    for (int o = 1; o < 64; o <<= 1) v = fmaxf(v, __shfl_xor(v, o));
    return v;
}
__device__ __forceinline__ float sigmoidf_(float x) { return __builtin_amdgcn_rcpf(1.0f + __builtin_amdgcn_exp2f(-1.4426950408889634f * x)); }
__device__ __forceinline__ float gelu_tanh(float x) { const float u = 0.7978845608028654f * (x + 0.044715f * x * x * x); return x * __builtin_amdgcn_rcpf(1.0f + __builtin_amdgcn_exp2f(-2.8853900817779268f * u)); }
__device__ __forceinline__ f32x4 ld_bf4(const bf16* p) { const u32x2 w = *(const u32x2*)p; return (f32x4){bf2f(w.x & 0xffffu), bf2f(w.x >> 16), bf2f(w.y & 0xffffu), bf2f(w.y >> 16)}; }
__device__ __forceinline__ void st_bf4(bf16* p, f32x4 v) { u32x2 w; w.x = pk2(v.x, v.y); w.y = pk2(v.z, v.w); *(u32x2*)p = w; }

struct Args { const float* in[26]; float* out; unsigned char* ws; };

struct EpiZ {
    static constexpr bool PERM = true, AFTER_DRAIN = false;
    bf16* O; const float* ssq;
    __device__ __forceinline__ void operator()(const pg8::f32x4 (&acc)[2][2][4][2], const pg8::Unit& u, int wr, int wc, int fr, int fq) const {
        const int row0 = u.pm * 256 + wr * 64 + fr, col0 = u.pn * 256 + wc * 32 + 8 * fq;
#pragma unroll
        for (int ai = 0; ai < 2; ++ai)
#pragma unroll
            for (int m = 0; m < 4; ++m) {
                const int row = row0 + ai * 128 + m * 16;
                const f32x4 sq = *(const f32x4*)(ssq + 4 * (size_t)row);
                const float rs = __builtin_amdgcn_rsqf(((sq.x + sq.y) + (sq.z + sq.w)) * (1.0f / DM) + EPS);
                bf16* rowp = O + (size_t)row * DIN + col0;
#pragma unroll
                for (int bj = 0; bj < 2; ++bj) {
                    const f32x4 v0 = acc[ai][bj][m][0] * rs, v1 = acc[ai][bj][m][1] * rs;
                    u32x4 w; w.x = pk2(v0[0], v0[1]); w.y = pk2(v0[2], v0[3]); w.z = pk2(v1[0], v1[1]); w.w = pk2(v1[2], v1[3]);
                    *(u32x4*)(rowp + bj * 128) = w;
                }
            }
    }
};
struct EpiRes {
    static constexpr bool PERM = true, AFTER_DRAIN = false;
    bf16* X; float* ssq_out; LAS float* P;
    LAS unsigned char* ring; bool xpre;
    __device__ __forceinline__ void operator()(const pg8::f32x4 (&acc)[2][2][4][2], const pg8::Unit& u, int wr, int wc, int fr, int fq) const {
        const int row0 = u.pm * 256 + wr * 64 + fr, col0 = u.pn * 256 + wc * 32 + 8 * fq;
        if (xpre) { asm volatile("s_waitcnt vmcnt(0)" ::: "memory"); __builtin_amdgcn_s_barrier(); asm volatile("" ::: "memory"); }
#pragma unroll
        for (int ai = 0; ai < 2; ++ai) {
            u32x4 xin[4][2];
#pragma unroll
            for (int m = 0; m < 4; ++m)
#pragma unroll
                for (int bj = 0; bj < 2; ++bj) {
                    const int q = 2 * (2 * bj + (wc >> 1)) + ai;
                    if (xpre && q < 7) {
                        const int boff = (q == 0 ? 4 : q == 1 ? 5 : q == 2 ? 0 : q == 3 ? 1 : q == 4 ? 6 : q == 5 ? 7 : 2) * 16384;
                        xin[m][bj] = *(const LAS u32x4*)(ring + boff + pg8::lds_byte(wr * 64 + m * 16 + fr, (wc & 1) * 32 + 8 * fq));
                    } else xin[m][bj] = *(const u32x4*)(X + (size_t)(row0 + ai * 128 + m * 16) * DM + col0 + bj * 128);
                }
#pragma unroll
            for (int m = 0; m < 4; ++m) {
                const int row = row0 + ai * 128 + m * 16;
                float q = 0.f;
#pragma unroll
                for (int bj = 0; bj < 2; ++bj) {
                    const u32x4 xi = xin[m][bj];
                    const f32x4 a0 = acc[ai][bj][m][0], a1 = acc[ai][bj][m][1];
                    const float y0 = bf2f(xi.x & 0xffffu) + a0[0], y1 = bf2f(xi.x >> 16) + a0[1], y2 = bf2f(xi.y & 0xffffu) + a0[2], y3 = bf2f(xi.y >> 16) + a0[3];
                    const float y4 = bf2f(xi.z & 0xffffu) + a1[0], y5 = bf2f(xi.z >> 16) + a1[1], y6 = bf2f(xi.w & 0xffffu) + a1[2], y7 = bf2f(xi.w >> 16) + a1[3];
                    q += (y0 * y0 + y1 * y1) + (y2 * y2 + y3 * y3) + (y4 * y4 + y5 * y5) + (y6 * y6 + y7 * y7);
                    u32x4 w; w.x = pk2(y0, y1); w.y = pk2(y2, y3); w.z = pk2(y4, y5); w.w = pk2(y6, y7);
                    *(u32x4*)(X + (size_t)row * DM + col0 + bj * 128) = w;
                }
                q += __shfl_xor(q, 16); q += __shfl_xor(q, 32);
                if (fq == 0) P[(ai * 128 + wr * 64 + m * 16 + fr) * 4 + wc] = q;
            }
        }
        asm volatile("s_waitcnt lgkmcnt(0)" ::: "memory"); __builtin_amdgcn_s_barrier(); asm volatile("" ::: "memory");
        const int t = (wr * 4 + wc) * 64 + fq * 16 + fr;
        if (t < 256) { const f32x4 v = *(const LAS f32x4*)(P + 4 * t); ssq_out[(size_t)(u.pm * 256 + t) * 4 + u.pn] = (v.x + v.y) + (v.z + v.w); }
    }
};
struct EpiFfn {
    static constexpr bool PERM = true, AFTER_DRAIN = false;
    bf16* act; const float* cw; float* st_out; const float* ssq;
    __device__ __forceinline__ void operator()(const pg8::f32x4 (&acc)[2][2][4][2], const pg8::Unit& u, int wr, int wc, int fr, int fq) const {
        const int bb = u.pm / 33, tt = u.pm % 33;
        const int t0 = tt * 252 + wr * 126 - 2 + 8 * fr;
        float rs[8];
#pragma unroll
        for (int j = 0; j < 8; ++j) { const f32x4 sq = *(const f32x4*)(ssq + 4 * (long)(bb * SEQ + t0 + j)); rs[j] = __builtin_amdgcn_rsqf(((sq.x + sq.y) + (sq.z + sq.w)) * (1.0f / DM) + EPS); }
#define DPP_SHR1(x) __builtin_bit_cast(float, __builtin_amdgcn_update_dpp(0, __builtin_bit_cast(int, (float)(x)), 0x111, 0xf, 0xf, true))
        const float rs6p = DPP_SHR1(rs[6]), rs7p = DPP_SHR1(rs[7]);
        const bool kill = (tt == 0) && (wr == 0) && (fr == 0);
        const int cu = u.pn * 128 + wc * 32 + 8 * fq;
        u32x4 outw[8];
#pragma unroll
        for (int n = 0; n < 2; ++n) {
            const int cn = cu + 4 * n;
            const f32x4 w0u = *(const f32x4*)(cw + cn), w1u = *(const f32x4*)(cw + DUP + cn), w2u = *(const f32x4*)(cw + 2 * DUP + cn);
            const f32x4 w0g = *(const f32x4*)(cw + DFF + cn), w1g = *(const f32x4*)(cw + DUP + DFF + cn), w2g = *(const f32x4*)(cw + 2 * DUP + DFF + cn);
            f32x4 pu6, pu7, pg6, pg7;
#pragma unroll
            for (int e = 0; e < 4; ++e) {
                pu6[e] = DPP_SHR1(acc[1][0][2][n][e]) * rs6p; pu7[e] = DPP_SHR1(acc[1][0][3][n][e]) * rs7p;
                pg6[e] = DPP_SHR1(acc[1][1][2][n][e]) * rs6p; pg7[e] = DPP_SHR1(acc[1][1][3][n][e]) * rs7p;
            }
            typedef float f2 __attribute__((ext_vector_type(2)));
            const f2 w0ua = w0u.xy, w0ub = w0u.zw, w1ua = w1u.xy, w1ub = w1u.zw, w2ua = w2u.xy, w2ub = w2u.zw;
            const f2 w0ga = w0g.xy, w0gb = w0g.zw, w1ga = w1g.xy, w1gb = w1g.zw, w2ga = w2g.xy, w2gb = w2g.zw;
            f2 um2a = pu6.xy, um2b = pu6.zw, um1a = pu7.xy, um1b = pu7.zw, gm2a = pg6.xy, gm2b = pg6.zw, gm1a = pg7.xy, gm1b = pg7.zw;
#pragma unroll
            for (int j = 0; j < 8; ++j) {
                const f32x4 au = acc[j >> 2][0][j & 3][n], ag = acc[j >> 2][1][j & 3][n];
                const f2 rsv = (f2){rs[j], rs[j]};
                f2 Ua = au.xy * rsv, Ub = au.zw * rsv, Ga = ag.xy * rsv, Gb = ag.zw * rsv;
                const int t = t0 + j;
                if (j < 2) { const f2 z = (f2){0.f, 0.f}; Ua = kill ? z : Ua; Ub = kill ? z : Ub; Ga = kill ? z : Ga; Gb = kill ? z : Gb; }
                const f2 uca = __builtin_elementwise_fma(w0ua, um2a, __builtin_elementwise_fma(w1ua, um1a, w2ua * Ua));
                const f2 ucb = __builtin_elementwise_fma(w0ub, um2b, __builtin_elementwise_fma(w1ub, um1b, w2ub * Ub));
                const f2 gca = __builtin_elementwise_fma(w0ga, gm2a, __builtin_elementwise_fma(w1ga, gm1a, w2ga * Ga));
                const f2 gcb = __builtin_elementwise_fma(w0gb, gm2b, __builtin_elementwise_fma(w1gb, gm1b, w2gb * Gb));
                const f2 nl = (f2){-1.4426950408889634f, -1.4426950408889634f}, one = (f2){1.f, 1.f};
                const f2 xa = gca * nl, xb = gcb * nl;
                f2 ea, eb; ea.x = __builtin_amdgcn_exp2f(xa.x); ea.y = __builtin_amdgcn_exp2f(xa.y); eb.x = __builtin_amdgcn_exp2f(xb.x); eb.y = __builtin_amdgcn_exp2f(xb.y);
                const f2 da = ea + one, db = eb + one;
                f2 ra, rb; ra.x = __builtin_amdgcn_rcpf(da.x); ra.y = __builtin_amdgcn_rcpf(da.y); rb.x = __builtin_amdgcn_rcpf(db.x); rb.y = __builtin_amdgcn_rcpf(db.y);
                const f2 oa = (uca * gca) * ra, ob = (ucb * gcb) * rb;
                if (n == 0) { outw[j].x = pk2(oa.x, oa.y); outw[j].y = pk2(ob.x, ob.y); } else { outw[j].z = pk2(oa.x, oa.y); outw[j].w = pk2(ob.x, ob.y); }
                if (t >= SEQ - 2 && t < SEQ && (8 * fr + j >= 2)) {
                    float* so = st_out + (size_t)(bb * 2 + (t - (SEQ - 2))) * DUP + cn;
                    *(f32x4*)so = (f32x4){Ua.x, Ua.y, Ub.x, Ub.y}; *(f32x4*)(so + DFF) = (f32x4){Ga.x, Ga.y, Gb.x, Gb.y};
                }
                um2a = um1a; um2b = um1b; um1a = Ua; um1b = Ub; gm2a = gm1a; gm2b = gm1b; gm1a = Ga; gm1b = Gb;
            }
        }
#pragma unroll
        for (int j = 0; j < 8; ++j) {
            const int t = t0 + j;
            if ((8 * fr + j >= 2) && (t < SEQ)) *(u32x4*)(act + (size_t)(bb * SEQ + t) * DFF + cu) = outw[j];
        }
    }
};

constexpr int SG_PITCH = 2832;
template <int MODE>
__device__ __forceinline__ void small_gemm_unit(LAS unsigned char* lds, int j, const bf16* Ap, const bf16* Bt, int K,
                                                bf16* obf, int ldo, const float* base, float* outf,
                                                const float* cw, const float* fbuf, float* fst) {
    int tid_o = threadIdx.x; asm volatile("" : "+v"(tid_o)); const int tid = tid_o, w = tid >> 6, lane = tid & 63, fr = lane & 15, fq = lane >> 4;
    const int row = 16 * w + fr;
    int bn0, bn1;
    if (MODE == 2) { bn0 = 256 * ((16 * j) / 128) + ((16 * j) % 128); bn1 = bn0 + 128; } else { bn0 = 32 * j; bn1 = bn0 + 16; }
    pg8::f32x4 acc0 = {0.f, 0.f, 0.f, 0.f}, acc1 = {0.f, 0.f, 0.f, 0.f};
    float ssq = 0.f;
    const bf16* ap = Ap + (size_t)row * K + 8 * fq;
    const int KC = (K > 1024) ? 1408 : 1024;
    for (int kc = 0; kc < K; kc += KC) {
        const int kl = (K - kc) < KC ? (K - kc) : KC, parts = kl >> 3;
        u32x4 af[16];
#pragma unroll
        for (int i = 0; i < 16; ++i) af[i] = *(const u32x4*)(ap + kc + 32 * i);
        __syncthreads();
        {
            u32x4 sg[11];
#pragma unroll
            for (int i = 0; i < 11; ++i) {
                const int c = tid + NTHREADS * i;
                if (c < 32 * parts) { const int r = c / parts, p = c - r * parts; sg[i] = *(const u32x4*)(Bt + (size_t)((r < 16 ? bn0 + r : bn1 + r - 16)) * K + kc + 8 * p); }
            }
#pragma unroll
            for (int i = 0; i < 11; ++i) {
                const int c = tid + NTHREADS * i;
                if (c < 32 * parts) { const int r = c / parts, p = c - r * parts; *(LAS u32x4*)(lds + r * SG_PITCH + 16 * p) = sg[i]; }
            }
        }
        __syncthreads();
        const LAS unsigned char* b0p = lds + fr * SG_PITCH + 16 * fq;
        const LAS unsigned char* b1p = lds + (16 + fr) * SG_PITCH + 16 * fq;
        for (int g0 = 0; g0 < kl; g0 += 512) {
            const int nst = (kl - g0) < 512 ? ((kl - g0) >> 5) : 16;
            if (g0 > 0) {
#pragma unroll
                for (int i = 0; i < 16; ++i) if (i < nst) af[i] = *(const u32x4*)(ap + kc + g0 + 32 * i);
            }
#pragma unroll
            for (int i = 0; i < 16; ++i) {
                if (i < nst) {
                    const u32x4 au = af[i];
                    if (MODE != 1) {
                        const float x0 = bf2f(au.x & 0xffffu), x1 = bf2f(au.x >> 16), x2 = bf2f(au.y & 0xffffu), x3 = bf2f(au.y >> 16);
                        const float x4 = bf2f(au.z & 0xffffu), x5 = bf2f(au.z >> 16), x6 = bf2f(au.w & 0xffffu), x7 = bf2f(au.w >> 16);
                        ssq += (x0 * x0 + x1 * x1) + (x2 * x2 + x3 * x3) + (x4 * x4 + x5 * x5) + (x6 * x6 + x7 * x7);
                    }
                    const bf16x8 a = __builtin_bit_cast(bf16x8, au);
                    const int k0 = g0 + 32 * i;
                    const bf16x8 b0 = *(const LAS bf16x8*)(b0p + 2 * k0), b1 = *(const LAS bf16x8*)(b1p + 2 * k0);
                    acc0 = __builtin_amdgcn_mfma_f32_16x16x32_bf16(b0, a, acc0, 0, 0, 0);
                    acc1 = __builtin_amdgcn_mfma_f32_16x16x32_bf16(b1, a, acc1, 0, 0, 0);
                }
            }
        }
    }
    if (MODE != 1) { ssq += __shfl_xor(ssq, 16); ssq += __shfl_xor(ssq, 32); }
    if (MODE == 0) {
        const float rs = rsqrtf(ssq * (1.0f / DM) + EPS);
        bf16* o = obf + (size_t)row * ldo + 32 * j + 4 * fq;
        st_bf4(o, acc0 * rs); st_bf4(o + 16, acc1 * rs);
    } else if (MODE == 1) {
        const size_t off = (size_t)row * DM + 32 * j + 4 * fq;
        const f32x4 r0 = *(const f32x4*)(base + off) + acc0, r1 = *(const f32x4*)(base + off + 16) + acc1;
        *(f32x4*)(outf + off) = r0; *(f32x4*)(outf + off + 16) = r1;
        st_bf4(obf + off, r0); st_bf4(obf + off + 16, r1);
    } else {
        const float rs = rsqrtf(ssq * (1.0f / DM) + EPS);
        const int cu = 16 * j + 4 * fq;
        const f32x4 U = acc0 * rs, G = acc1 * rs;
        const float* b0r = fbuf + (size_t)(row * 2 + 0) * DUP + cu; const float* b1r = fbuf + (size_t)(row * 2 + 1) * DUP + cu;
        const f32x4 u0 = *(const f32x4*)b0r, u1 = *(const f32x4*)b1r, g0 = *(const f32x4*)(b0r + DFF), g1 = *(const f32x4*)(b1r + DFF);
        const f32x4 uc = *(const f32x4*)(cw + cu) * u0 + *(const f32x4*)(cw + DUP + cu) * u1 + *(const f32x4*)(cw + 2 * DUP + cu) * U;
        const f32x4 gc = *(const f32x4*)(cw + DFF + cu) * g0 + *(const f32x4*)(cw + DUP + DFF + cu) * g1 + *(const f32x4*)(cw + 2 * DUP + DFF + cu) * G;
        f32x4 a;
#pragma unroll
        for (int e = 0; e < 4; ++e) a[e] = uc[e] * gc[e] / (1.0f + __expf(-gc[e]));
        st_bf4(obf + (size_t)row * DFF + cu, a);
        float* s0 = fst + (size_t)(row * 2 + 0) * DUP + cu; float* s1 = fst + (size_t)(row * 2 + 1) * DUP + cu;
        *(f32x4*)s0 = u1; *(f32x4*)(s0 + DFF) = g1; *(f32x4*)s1 = U; *(f32x4*)(s1 + DFF) = G;
    }
    __syncthreads();
}

constexpr int SF_PITCH = 1040;
__device__ __forceinline__ void small_ffn_unit(LAS unsigned char* lds, int j3, const bf16* __restrict__ Ap, const bf16* __restrict__ Bt, bf16* __restrict__ obf,
                                               const float* __restrict__ cw, const float* __restrict__ fbuf, float* __restrict__ fst) {
    int tid_o = threadIdx.x; asm volatile("" : "+v"(tid_o)); const int tid = tid_o, w = tid >> 6, lane = tid & 63, fr = lane & 15, fq = lane >> 4;
    const int row = 16 * w + fr, bl0 = 3 * j3, nb = (176 - bl0) < 3 ? (176 - bl0) : 3, K = DM;
    pg8::f32x4 acc[3][2];
#pragma unroll
    for (int b = 0; b < 3; ++b) { acc[b][0] = (pg8::f32x4){0.f, 0.f, 0.f, 0.f}; acc[b][1] = acc[b][0]; }
    float ssq = 0.f;
    const bf16* ap = Ap + (size_t)row * K + 8 * fq;
    for (int kc = 0; kc < K; kc += 512) {
        u32x4 af[16];
#pragma unroll
        for (int i = 0; i < 16; ++i) af[i] = *(const u32x4*)(ap + kc + 32 * i);
        __syncthreads();
        {
            u32x4 sg[12];
#pragma unroll
            for (int i = 0; i < 12; ++i) {
                const int c = tid + NTHREADS * i, r = c >> 6, p = c & 63, b = r >> 5, rr = r & 31;
                if (b < nb) { const int bl = bl0 + b, bn0 = 256 * ((16 * bl) / 128) + ((16 * bl) % 128); sg[i] = *(const u32x4*)(Bt + (size_t)(rr < 16 ? bn0 + rr : bn0 + 128 + rr - 16) * K + kc + 8 * p); }
            }
#pragma unroll
            for (int i = 0; i < 12; ++i) {
                const int c = tid + NTHREADS * i, r = c >> 6, p = c & 63, b = r >> 5;
                if (b < nb) *(LAS u32x4*)(lds + r * SF_PITCH + 16 * p) = sg[i];
            }
        }
        __syncthreads();
#pragma unroll
        for (int i = 0; i < 16; ++i) {
            const u32x4 au = af[i];
            const float x0 = bf2f(au.x & 0xffffu), x1 = bf2f(au.x >> 16), x2 = bf2f(au.y & 0xffffu), x3 = bf2f(au.y >> 16);
            const float x4 = bf2f(au.z & 0xffffu), x5 = bf2f(au.z >> 16), x6 = bf2f(au.w & 0xffffu), x7 = bf2f(au.w >> 16);
            ssq += (x0 * x0 + x1 * x1) + (x2 * x2 + x3 * x3) + (x4 * x4 + x5 * x5) + (x6 * x6 + x7 * x7);
            const bf16x8 a = __builtin_bit_cast(bf16x8, au);
#pragma unroll
            for (int b = 0; b < 3; ++b) {
                if (b < nb) {
                    const bf16x8 b0 = *(const LAS bf16x8*)(lds + (32 * b + fr) * SF_PITCH + 16 * fq + 64 * i), b1 = *(const LAS bf16x8*)(lds + (32 * b + 16 + fr) * SF_PITCH + 16 * fq + 64 * i);
                    acc[b][0] = __builtin_amdgcn_mfma_f32_16x16x32_bf16(b0, a, acc[b][0], 0, 0, 0);
                    acc[b][1] = __builtin_amdgcn_mfma_f32_16x16x32_bf16(b1, a, acc[b][1], 0, 0, 0);
                }
            }
        }
    }
    ssq += __shfl_xor(ssq, 16); ssq += __shfl_xor(ssq, 32);
    const float rs = rsqrtf(ssq * (1.0f / DM) + EPS);
#pragma unroll
    for (int b = 0; b < 3; ++b) {
        if (b < nb) {
            const int cu = 16 * (bl0 + b) + 4 * fq;
            const f32x4 U = acc[b][0] * rs, G = acc[b][1] * rs;
            const float* b0r = fbuf + (size_t)(row * 2 + 0) * DUP + cu; const float* b1r = fbuf + (size_t)(row * 2 + 1) * DUP + cu;
            const f32x4 u0 = *(const f32x4*)b0r, u1 = *(const f32x4*)b1r, g0 = *(const f32x4*)(b0r + DFF), g1 = *(const f32x4*)(b1r + DFF);
            const f32x4 uc = *(const f32x4*)(cw + cu) * u0 + *(const f32x4*)(cw + DUP + cu) * u1 + *(const f32x4*)(cw + 2 * DUP + cu) * U;
            const f32x4 gc = *(const f32x4*)(cw + DFF + cu) * g0 + *(const f32x4*)(cw + DUP + DFF + cu) * g1 + *(const f32x4*)(cw + 2 * DUP + DFF + cu) * G;
            f32x4 a;
#pragma unroll
            for (int e = 0; e < 4; ++e) a[e] = uc[e] * gc[e] * __builtin_amdgcn_rcpf(1.0f + __builtin_amdgcn_exp2f(-1.4426950408889634f * gc[e]));
            st_bf4(obf + (size_t)row * DFF + cu, a);
            float* s0 = fst + (size_t)(row * 2 + 0) * DUP + cu; float* s1 = fst + (size_t)(row * 2 + 1) * DUP + cu;
            *(f32x4*)s0 = u1; *(f32x4*)(s0 + DFF) = g1; *(f32x4*)s1 = U; *(f32x4*)(s1 + DFF) = G;
        }
    }
    __syncthreads();
}

__device__ __forceinline__ void transpose_item(const float* __restrict__ W, int K, int N, bf16* __restrict__ WT, int upmap, LAS float* scr, int item, int lane, const float* __restrict__ gain) {
    const int nblk = N / 64, kb = item / nblk, nb = item % nblk, k0 = 64 * kb, n0 = 64 * nb;
    float v[64];
#pragma unroll
    for (int i = 0; i < 64; ++i) v[i] = __builtin_nontemporal_load(W + (size_t)(k0 + i) * N + n0 + lane);
    if (gain) {
#pragma unroll
        for (int i = 0; i < 64; ++i) v[i] *= gain[k0 + i];
    }
#pragma unroll
    for (int i = 0; i < 64; ++i) scr[i * 65 + lane] = v[i];
    asm volatile("s_waitcnt lgkmcnt(0)" ::: "memory");
    int r0 = n0;
    if (upmap) { r0 = (n0 < DFF) ? (256 * (n0 / 128) + (n0 % 128)) : (256 * ((n0 - DFF) / 128) + 128 + ((n0 - DFF) % 128)); }
    const int c = lane & 7;
#pragma unroll
    for (int j = 0; j < 8; ++j) { const int n = (lane >> 3) + 8 * j; const LAS float* s = scr + (8 * c) * 65 + n;
        u32x4 o; o.x = pk2(s[0 * 65], s[1 * 65]); o.y = pk2(s[2 * 65], s[3 * 65]); o.z = pk2(s[4 * 65], s[5 * 65]); o.w = pk2(s[6 * 65], s[7 * 65]);
        *(u32x4*)(WT + (size_t)(r0 + n) * K + k0 + 8 * c) = o; }
    asm volatile("s_waitcnt lgkmcnt(0)" ::: "memory");
}
__device__ __forceinline__ void rms_row_bf16(const float* xrow, bf16* orow, int lane) {
    f32x4 v[4]; float s = 0.f;
#pragma unroll
    for (int j = 0; j < 4; ++j) { v[j] = *(const f32x4*)(xrow + 4 * lane + 256 * j); s += (v[j].x * v[j].x + v[j].y * v[j].y) + (v[j].z * v[j].z + v[j].w * v[j].w); }
    const float rs = rsqrtf(wave_sum(s) * (1.0f / DM) + EPS);
#pragma unroll
    for (int j = 0; j < 4; ++j) st_bf4(orow + 4 * lane + 256 * j, v[j] * rs);
}
__device__ __forceinline__ void init_row(const float* xrow, bf16* orow, float* ssq, int lane) {
    f32x4 v[4]; float s = 0.f;
#pragma unroll
    for (int j = 0; j < 4; ++j) { v[j] = *(const f32x4*)(xrow + 4 * lane + 256 * j); s += (v[j].x * v[j].x + v[j].y * v[j].y) + (v[j].z * v[j].z + v[j].w * v[j].w); }
    s = wave_sum(s);
#pragma unroll
    for (int j = 0; j < 4; ++j) st_bf4(orow + 4 * lane + 256 * j, v[j]);
    if (lane == 0) *(f32x4*)ssq = (f32x4){s, 0.f, 0.f, 0.f};
}
__device__ __forceinline__ void final_row(const bf16* xrow, float ssq, const float* g, float* orow, int lane) {
    const float rs = rsqrtf(ssq * (1.0f / DM) + EPS);
#pragma unroll
    for (int j = 0; j < 4; ++j) { const f32x4 v = ld_bf4(xrow + 4 * lane + 256 * j); const f32x4 gg = *(const f32x4*)(g + 4 * lane + 256 * j); *(f32x4*)(orow + 4 * lane + 256 * j) = v * gg * rs; }
}
__device__ __forceinline__ void rms_row_f32(const float* xrow, const float* g, float* orow, int lane) {
    f32x4 v[4]; float s = 0.f;
#pragma unroll
    for (int j = 0; j < 4; ++j) { v[j] = *(const f32x4*)(xrow + 4 * lane + 256 * j); s += (v[j].x * v[j].x + v[j].y * v[j].y) + (v[j].z * v[j].z + v[j].w * v[j].w); }
    const float rs = rsqrtf(wave_sum(s) * (1.0f / DM) + EPS);
#pragma unroll
    for (int j = 0; j < 4; ++j) { const f32x4 gg = *(const f32x4*)(g + 4 * lane + 256 * j); *(f32x4*)(orow + 4 * lane + 256 * j) = v[j] * gg * rs; }
}

__device__ __forceinline__ void attn_prompt_unit(LAS unsigned char* lds, int b, int t0, const bf16* Z, bf16* MG, const float* sinks, const float* gout,
                                                 float* ck_out, float* cv_out) {
    int tid_o = threadIdx.x; asm volatile("" : "+v"(tid_o)); const int tid = tid_o, h = __builtin_amdgcn_readfirstlane(tid >> 6), lane = tid & 63, qi = lane & 31, hi = lane >> 5, g = h >> 2;
    LAS bf16* Ks = (LAS bf16*)lds;
    LAS bf16* Vt = (LAS bf16*)(lds + 55296);
    LAS float* SS = (LAS float*)(lds + 55296 + 51200);
    const bool wr_cache = (t0 >= SEQ - 128);
    bf16x8 qf[2][4];
#pragma unroll
    for (int sub = 0; sub < 2; ++sub) {
        const bf16* qp = Z + (size_t)(b * SEQ + t0 + 32 * sub + qi) * DIN + ZQ + 64 * h + 8 * hi;
#pragma unroll
        for (int st = 0; st < 4; ++st) qf[sub][st] = *(const bf16x8*)(qp + 16 * st);
    }
    {
        u32x4 kvr[6], vvr[6];
#pragma unroll
        for (int i = 0; i < 6; ++i) {
            const int c = tid + NTHREADS * i, row = c >> 4, part = c & 15, gg = part >> 3, d8 = part & 7, tok = t0 - 128 + row;
            kvr[i] = (u32x4){0u, 0u, 0u, 0u}; vvr[i] = (u32x4){0u, 0u, 0u, 0u};
            if (tok >= 0) { const bf16* zr = Z + (size_t)(b * SEQ + tok) * DIN + gg * 64 + d8 * 8; kvr[i] = *(const u32x4*)(zr + ZK); vvr[i] = *(const u32x4*)(zr + ZV); }
        }
#pragma unroll
        for (int i = 0; i < 6; ++i) {
            const int c = tid + NTHREADS * i, row = c >> 4, part = c & 15, gg = part >> 3, d8 = part & 7, tok = t0 - 128 + row;
            const u32x4 kv = kvr[i], vv = vvr[i];
            *(LAS u32x4*)(Ks + (gg * 192 + row) * 72 + d8 * 8) = kv;
            LAS bf16* vt = Vt + (gg * 64 + d8 * 8) * 200 + (row ^ (4 * d8));
            vt[0 * 200] = (bf16)(vv.x & 0xffffu); vt[1 * 200] = (bf16)(vv.x >> 16); vt[2 * 200] = (bf16)(vv.y & 0xffffu); vt[3 * 200] = (bf16)(vv.y >> 16);
            vt[4 * 200] = (bf16)(vv.z & 0xffffu); vt[5 * 200] = (bf16)(vv.z >> 16); vt[6 * 200] = (bf16)(vv.w & 0xffffu); vt[7 * 200] = (bf16)(vv.w >> 16);
            if (wr_cache && row >= 128) {
                const size_t o = ((size_t)(tok - (SEQ - 128)) * 2 + gg) * 64 + d8 * 8;
                *(f32x4*)(ck_out + o) = (f32x4){bf2f(kv.x & 0xffffu), bf2f(kv.x >> 16), bf2f(kv.y & 0xffffu), bf2f(kv.y >> 16)};
                *(f32x4*)(ck_out + o + 4) = (f32x4){bf2f(kv.z & 0xffffu), bf2f(kv.z >> 16), bf2f(kv.w & 0xffffu), bf2f(kv.w >> 16)};
                *(f32x4*)(cv_out + o) = (f32x4){bf2f(vv.x & 0xffffu), bf2f(vv.x >> 16), bf2f(vv.y & 0xffffu), bf2f(vv.y >> 16)};
                *(f32x4*)(cv_out + o + 4) = (f32x4){bf2f(vv.z & 0xffffu), bf2f(vv.z >> 16), bf2f(vv.w & 0xffffu), bf2f(vv.w >> 16)};
            }
        }
    }
    __syncthreads();
    const float L2E = 1.4426950408889634f;
    const float sc = 0.125f * L2E, sinkl = sinks[h] * L2E;
    f32x16 O[2][2];
#pragma unroll
    for (int sub = 0; sub < 2; ++sub) {
        f32x16 S[5];
#pragma unroll
        for (int kt = 0; kt < 5; ++kt) {
#pragma unroll
            for (int r = 0; r < 16; ++r) S[kt][r] = 0.f;
            const LAS bf16* kp = Ks + (g * 192 + 32 * sub + 32 * kt + qi) * 72 + 8 * hi;
#pragma unroll
            for (int st = 0; st < 4; ++st) { const bf16x8 kf = *(const LAS bf16x8*)(kp + 16 * st); S[kt] = __builtin_amdgcn_mfma_f32_32x32x16_bf16(kf, qf[sub][st], S[kt], 0, 0, 0); }
        }
        float m = sinkl;
#pragma unroll
        for (int kt = 0; kt < 5; ++kt)
#pragma unroll
            for (int r = 0; r < 16; ++r) {
                const int keyrow = 8 * (r >> 2) + 4 * hi + (r & 3);
                bool valid = true;
                if (kt == 0) valid = keyrow >= qi;
                if (kt == 4) valid = keyrow <= qi;
                if (t0 - 128 + 32 * sub + 32 * kt + keyrow < 0) valid = false;
                const float s = valid ? S[kt][r] * sc : -INFINITY;
                S[kt][r] = s; m = fmaxf(m, s);
            }
        m = fmaxf(m, __shfl_xor(m, 32));
        float sum = 0.f;
#pragma unroll
        for (int kt = 0; kt < 5; ++kt)
#pragma unroll
            for (int r = 0; r < 16; ++r) { const float p = __builtin_amdgcn_exp2f(S[kt][r] - m); S[kt][r] = p; sum += p; }
        sum += __shfl_xor(sum, 32);
        sum += exp2f(sinkl - m);
        const float inv = 1.0f / sum;
        f32x16 o0, o1;
#pragma unroll
        for (int r = 0; r < 16; ++r) { o0[r] = 0.f; o1[r] = 0.f; }
#pragma unroll
        for (int kt = 0; kt < 5; ++kt)
#pragma unroll
            for (int hf = 0; hf < 2; ++hf) {
                u32x4 pw; pw.x = pk2(S[kt][8 * hf + 0], S[kt][8 * hf + 1]); pw.y = pk2(S[kt][8 * hf + 2], S[kt][8 * hf + 3]);
                pw.z = pk2(S[kt][8 * hf + 4], S[kt][8 * hf + 5]); pw.w = pk2(S[kt][8 * hf + 6], S[kt][8 * hf + 7]);
                const bf16x8 pb = __builtin_bit_cast(bf16x8, pw);
                const int kb = 32 * sub + 32 * kt + 16 * hf + 4 * hi;
                const int f0 = 4 * (qi >> 3), f1 = 4 * (4 + (qi >> 3));
                const LAS bf16* v0 = Vt + (g * 64 + qi) * 200;
                const LAS bf16* v1 = Vt + (g * 64 + 32 + qi) * 200;
                u32x4 a0, a1; const u32x2 x0 = *(const LAS u32x2*)(v0 + (kb ^ f0)), x1 = *(const LAS u32x2*)(v0 + ((kb + 8) ^ f0)), y0 = *(const LAS u32x2*)(v1 + (kb ^ f1)), y1 = *(const LAS u32x2*)(v1 + ((kb + 8) ^ f1));
                a0.x = x0.x; a0.y = x0.y; a0.z = x1.x; a0.w = x1.y; a1.x = y0.x; a1.y = y0.y; a1.z = y1.x; a1.w = y1.y;
                o0 = __builtin_amdgcn_mfma_f32_32x32x16_bf16(__builtin_bit_cast(bf16x8, a0), pb, o0, 0, 0, 0);
                o1 = __builtin_amdgcn_mfma_f32_32x32x16_bf16(__builtin_bit_cast(bf16x8, a1), pb, o1, 0, 0, 0);
            }
        float q2 = 0.f;
#pragma unroll
        for (int r = 0; r < 16; ++r) { o0[r] *= inv; o1[r] *= inv; q2 += o0[r] * o0[r] + o1[r] * o1[r]; }
        q2 += __shfl_xor(q2, 32);
        if (hi == 0) SS[(sub * 8 + h) * 32 + qi] = q2;
        O[sub][0] = o0; O[sub][1] = o1;
    }
    __syncthreads();
    {
        LAS bf16* OT = (LAS bf16*)lds + h * (64 * 72);
#pragma unroll
        for (int sub = 0; sub < 2; ++sub) {
            float tot = 0.f;
#pragma unroll
            for (int hh = 0; hh < 8; ++hh) tot += SS[(sub * 8 + hh) * 32 + qi];
            const float rs = rsqrtf(tot * (1.0f / 512.0f) + EPS);
#pragma unroll
            for (int dt = 0; dt < 2; ++dt)
#pragma unroll
                for (int rq = 0; rq < 4; ++rq) {
                    const int d = 32 * dt + 8 * rq + 4 * hi;
                    const f32x4 gg = *(const f32x4*)(gout + 64 * h + d);
                    f32x4 v; v.x = O[sub][dt][4 * rq + 0]; v.y = O[sub][dt][4 * rq + 1]; v.z = O[sub][dt][4 * rq + 2]; v.w = O[sub][dt][4 * rq + 3];
                    v = v * gg * rs;
                    u32x2 w2; w2.x = pk2(v.x, v.y); w2.y = pk2(v.z, v.w);
                    *(LAS u32x2*)(OT + (32 * sub + qi) * 72 + d) = w2;
                }
        }
        asm volatile("s_waitcnt lgkmcnt(0)" ::: "memory");
#pragma unroll
        for (int i = 0; i < 8; ++i) {
            const int q = 8 * i + (lane >> 3), ch = lane & 7;
            const u32x4 w4 = *(const LAS u32x4*)(OT + q * 72 + 8 * ch);
            *(u32x4*)(MG + (size_t)(b * SEQ + t0 + q) * DM + 64 * h + 8 * ch) = w4;
        }
    }
    __syncthreads();
}

__device__ __forceinline__ void attn_sample_unit(LAS unsigned char* lds, int s, const bf16* __restrict__ ZS, bf16* __restrict__ MGS, const float* __restrict__ sinks, const float* __restrict__ gout,
                                                 const float* __restrict__ ck, const float* __restrict__ cv, float* __restrict__ cko, float* __restrict__ cvo) {
    int tid_o = threadIdx.x; asm volatile("" : "+v"(tid_o)); const int tid = tid_o, w = tid >> 6, lane = tid & 63;
    LAS float* KS = (LAS float*)lds;
    LAS float* VS = (LAS float*)(lds + 68112);
    LAS float* QS = (LAS float*)(lds + 68112 + 66048);
    LAS float* SC = QS + 512;
    LAS float* RED = SC + 8 * 132;
    const bf16* zr = ZS + (size_t)s * DIN;
    const float* ckb = ck + (size_t)s * 16384; float* ckob = cko + (size_t)s * 16384;
    const float* cvb = cv + (size_t)s * 16384; float* cvob = cvo + (size_t)s * 16384;
    {
        f32x4 kr[8], vr[8];
#pragma unroll
        for (int i = 0; i < 8; ++i) { const int e = (tid + NTHREADS * i) * 4; kr[i] = *(const f32x4*)(ckb + e); vr[i] = *(const f32x4*)(cvb + e); }
#pragma unroll
        for (int i = 0; i < 8; ++i) {
            const int e = (tid + NTHREADS * i) * 4, row = e >> 7, col = e & 127;
            *(LAS f32x4*)(KS + row * 132 + col) = kr[i]; *(LAS f32x4*)(VS + row * 128 + col) = vr[i];
            if (row >= 1) { *(f32x4*)(ckob + e - 128) = kr[i]; *(f32x4*)(cvob + e - 128) = vr[i]; }
        }
        QS[tid] = bf2f(zr[ZQ + tid]);
        if (tid < 128) {
            const float kn = bf2f(zr[ZK + tid]), vn = bf2f(zr[ZV + tid]);
            KS[128 * 132 + tid] = kn; VS[128 * 128 + tid] = vn;
            ckob[127 * 128 + tid] = kn; cvob[127 * 128 + tid] = vn;
        }
    }
    __syncthreads();
    {
        const int part = tid >> 7, g = part >> 1, h0 = 4 * g + 2 * (part & 1);
        for (int pass = 0; pass < 2; ++pass) {
            const int j = pass ? 128 : (tid & 127);
            if (pass && (tid & 127) != 0) break;
            const LAS float* kp = KS + j * 132 + 64 * g; const LAS float* q0 = QS + h0 * 64; const LAS float* q1 = q0 + 64;
            float a0 = 0.f, a1 = 0.f;
#pragma unroll
            for (int d = 0; d < 64; d += 4) { const f32x4 kv = *(const LAS f32x4*)(kp + d), x0 = *(const LAS f32x4*)(q0 + d), x1 = *(const LAS f32x4*)(q1 + d);
                a0 += (kv.x * x0.x + kv.y * x0.y) + (kv.z * x0.z + kv.w * x0.w); a1 += (kv.x * x1.x + kv.y * x1.y) + (kv.z * x1.z + kv.w * x1.w); }
            SC[h0 * 132 + j] = a0 * 0.125f; SC[(h0 + 1) * 132 + j] = a1 * 0.125f;
        }
    }
    __syncthreads();
    {
        const float sink = sinks[w];
        const float s0 = SC[w * 132 + lane], s1 = SC[w * 132 + 64 + lane], s2 = (lane == 0) ? SC[w * 132 + 128] : -INFINITY;
        const float m = fmaxf(wave_max(fmaxf(fmaxf(s0, s1), s2)), sink);
        const float p0 = __expf(s0 - m), p1 = __expf(s1 - m), p2 = (lane == 0) ? __expf(s2 - m) : 0.f;
        const float inv = 1.0f / (wave_sum(p0 + p1 + p2) + __expf(sink - m));
        SC[w * 132 + lane] = p0 * inv; SC[w * 132 + 64 + lane] = p1 * inv; if (lane == 0) SC[w * 132 + 128] = p2 * inv;
    }
    __syncthreads();
    float o = 0.f;
    {
        const LAS float* pp = SC + w * 132; const LAS float* vp = VS + 64 * (w >> 2) + lane;
#pragma unroll 8
        for (int jj = 0; jj < 128; jj += 4) { const f32x4 p4 = *(const LAS f32x4*)(pp + jj);
            o += p4.x * vp[(jj + 0) * 128] + p4.y * vp[(jj + 1) * 128] + p4.z * vp[(jj + 2) * 128] + p4.w * vp[(jj + 3) * 128]; }
        o += pp[128] * vp[128 * 128];
    }
    const float q2 = wave_sum(o * o);
    if (lane == 0) RED[w] = q2;
    __syncthreads();
    float tot = 0.f;
#pragma unroll
    for (int ww = 0; ww < 8; ++ww) tot += RED[ww];
    const float rs = rsqrtf(tot * (1.0f / 512.0f) + EPS);
    MGS[(size_t)s * DM + tid] = (bf16)f2bf(o * rs * gout[tid]);
    __syncthreads();
}

template <int NTW>
__device__ __forceinline__ void sconv_unit(bool sample, int b, int t0, const bf16* __restrict__ Zp, bf16* __restrict__ MGp, const float* __restrict__ cw, const float* __restrict__ gout,
                                           const float* __restrict__ sbuf, float* __restrict__ st_out) {
    int tid_o = threadIdx.x; asm volatile("" : "+v"(tid_o)); const int tid = tid_o, w = tid >> 6, lane = tid & 63, c = 4 * lane;
    const f32x4 w0 = *(const f32x4*)(cw + c), w1 = *(const f32x4*)(cw + 256 + c), w2 = *(const f32x4*)(cw + 512 + c), gg = *(const f32x4*)(gout + 768 + c);
    const f32x4 zero = (f32x4){0.f, 0.f, 0.f, 0.f};
    f32x4 co[NTW];
    if (!sample) {
        const int tb = t0 + NTW * w;
        const bf16* zb = Zp + ((size_t)b * SEQ + tb) * DIN;
        u32x2 rc[NTW + 2], ru[NTW + 2], rb[NTW];
#pragma unroll
        for (int i = 0; i < NTW + 2; ++i) {
            rc[i] = (u32x2){0u, 0u}; ru[i] = (u32x2){0u, 0u};
            if (tb + i - 2 >= 0) { rc[i] = *(const u32x2*)(zb + (long)(i - 2) * DIN + ZSC + c); ru[i] = *(const u32x2*)(zb + (long)(i - 2) * DIN + ZSU + c); }
        }
#pragma unroll
        for (int k = 0; k < NTW; ++k) rb[k] = *(const u32x2*)(zb + (size_t)k * DIN + ZSB + c);
        f32x4 v[NTW + 2];
#pragma unroll
        for (int i = 0; i < NTW + 2; ++i) {
            const f32x4 cc = (f32x4){bf2f(rc[i].x & 0xffffu), bf2f(rc[i].x >> 16), bf2f(rc[i].y & 0xffffu), bf2f(rc[i].y >> 16)};
            const f32x4 uu = (f32x4){bf2f(ru[i].x & 0xffffu), bf2f(ru[i].x >> 16), bf2f(ru[i].y & 0xffffu), bf2f(ru[i].y >> 16)};
            v[i] = cc * uu;
        }
#pragma unroll
        for (int k = 0; k < NTW; ++k) {
            const f32x4 bb = (f32x4){bf2f(rb[k].x & 0xffffu), bf2f(rb[k].x >> 16), bf2f(rb[k].y & 0xffffu), bf2f(rb[k].y >> 16)};
            co[k] = bb * (w0 * v[k] + w1 * v[k + 1] + w2 * v[k + 2]);
            const int t = tb + k;
            if (t >= SEQ - 2) *(f32x4*)(st_out + (size_t)(b * 2 + (t - (SEQ - 2))) * 256 + c) = v[k + 2];
        }
    } else if constexpr (NTW == 8) {
        const size_t sb = t0 + 8 * w;
        u32x2 rc[8], ru[8], rb[8]; f32x4 p0[8], p1[8];
#pragma unroll
        for (int k = 0; k < 8; ++k) {
            const bf16* zr = Zp + (sb + k) * DIN;
            rc[k] = *(const u32x2*)(zr + ZSC + c); ru[k] = *(const u32x2*)(zr + ZSU + c); rb[k] = *(const u32x2*)(zr + ZSB + c);
            p0[k] = *(const f32x4*)(sbuf + ((sb + k) * 2 + 0) * 256 + c); p1[k] = *(const f32x4*)(sbuf + ((sb + k) * 2 + 1) * 256 + c);
        }
#pragma unroll
        for (int k = 0; k < 8; ++k) {
            const f32x4 cc = (f32x4){bf2f(rc[k].x & 0xffffu), bf2f(rc[k].x >> 16), bf2f(rc[k].y & 0xffffu), bf2f(rc[k].y >> 16)};
            const f32x4 uu = (f32x4){bf2f(ru[k].x & 0xffffu), bf2f(ru[k].x >> 16), bf2f(ru[k].y & 0xffffu), bf2f(ru[k].y >> 16)};
            const f32x4 bb = (f32x4){bf2f(rb[k].x & 0xffffu), bf2f(rb[k].x >> 16), bf2f(rb[k].y & 0xffffu), bf2f(rb[k].y >> 16)};
            const f32x4 vcur = cc * uu;
            co[k] = bb * (w0 * p0[k] + w1 * p1[k] + w2 * vcur);
            *(f32x4*)(st_out + ((sb + k) * 2 + 0) * 256 + c) = p1[k]; *(f32x4*)(st_out + ((sb + k) * 2 + 1) * 256 + c) = vcur;
        }
    }
    (void)zero;
    float q[NTW];
#pragma unroll
    for (int k = 0; k < NTW; ++k) q[k] = (co[k].x * co[k].x + co[k].y * co[k].y) + (co[k].z * co[k].z + co[k].w * co[k].w);
#pragma unroll
    for (int o = 1; o < 64; o <<= 1)
#pragma unroll
        for (int k = 0; k < NTW; ++k) q[k] += __shfl_xor(q[k], o);
#pragma unroll
    for (int k = 0; k < NTW; ++k) {
        const size_t row = sample ? (size_t)(t0 + NTW * w + k) : ((size_t)b * SEQ + t0 + NTW * w + k);
        st_bf4(MGp + row * DM + 768 + c, co[k] * gg * rsqrtf(q[k] * (1.0f / 256.0f) + EPS));
    }
}

struct LruW { const float *cw, *cb, *ba, *bi, *lam, *gout; const bf16* lwt; };
__device__ __forceinline__ void lru_unit(LAS unsigned char* lds, bool sample, int b, int t0, const bf16* __restrict__ Zp, bf16* __restrict__ MGp, const LruW W,
                                         bf16* __restrict__ hloc, bf16* __restrict__ cuma, float* __restrict__ agga, float* __restrict__ aggb,
                                         const float* __restrict__ lbuf, const float* __restrict__ h0, float* __restrict__ lc_out, float* __restrict__ rg_out) {
    int tid_o = threadIdx.x; asm volatile("" : "+v"(tid_o)); const int tid = tid_o, w = __builtin_amdgcn_readfirstlane(tid >> 6), lane = tid & 63;
    LAS float* XC = (LAS float*)lds;
    constexpr int LP = 260;
    LAS bf16* XB = (LAS bf16*)(lds + 66560);
    LAS float* AA = (LAS float*)(lds + 66560);
    {
        const int cp = tid & 127, tg = tid >> 7, c = 2 * cp;
        const f32x2 k0 = *(const f32x2*)(W.cw + c), k1 = *(const f32x2*)(W.cw + 256 + c), k2 = *(const f32x2*)(W.cw + 512 + c), k3 = *(const f32x2*)(W.cw + 768 + c), bb = *(const f32x2*)(W.cb + c);
        if (!sample) {
            const int tb = t0 + 16 * tg;
            const bf16* zc = Zp + ((size_t)b * SEQ + tb) * DIN + ZLX + c;
            unsigned xr[19];
#pragma unroll
            for (int i = 0; i < 19; ++i) { xr[i] = 0u; if (tb + i - 3 >= 0) xr[i] = *(const unsigned*)(zc + (long)(i - 3) * DIN); }
#pragma unroll
            for (int i = 0; i < 16; ++i) {
                const f32x2 xm3 = (f32x2){bf2f(xr[i] & 0xffffu), bf2f(xr[i] >> 16)}, xm2 = (f32x2){bf2f(xr[i + 1] & 0xffffu), bf2f(xr[i + 1] >> 16)};
                const f32x2 xm1 = (f32x2){bf2f(xr[i + 2] & 0xffffu), bf2f(xr[i + 2] >> 16)}, x = (f32x2){bf2f(xr[i + 3] & 0xffffu), bf2f(xr[i + 3] >> 16)};
                const f32x2 xc = k0 * xm3 + k1 * xm2 + k2 * xm1 + k3 * x + bb;
                const int tok = 16 * tg + i;
                *(LAS f32x2*)(XC + tok * LP + c) = xc; *(LAS unsigned*)(XB + tok * 264 + c) = pk2(xc.x, xc.y);
                if (tb + i >= SEQ - 3) *(f32x2*)(lc_out + (size_t)(b * 3 + (tb + i - (SEQ - 3))) * 256 + c) = x;
            }
        } else {
#pragma unroll
            for (int i = 0; i < 16; ++i) {
                const int tok = 16 * tg + i; const size_t s = t0 + tok;
                const unsigned u = *(const unsigned*)(Zp + s * DIN + ZLX + c); const f32x2 x = (f32x2){bf2f(u & 0xffffu), bf2f(u >> 16)};
                const f32x2 xm3 = *(const f32x2*)(lbuf + (s * 3 + 0) * 256 + c), xm2 = *(const f32x2*)(lbuf + (s * 3 + 1) * 256 + c), xm1 = *(const f32x2*)(lbuf + (s * 3 + 2) * 256 + c);
                const f32x2 xc = k0 * xm3 + k1 * xm2 + k2 * xm1 + k3 * x + bb;
                *(LAS f32x2*)(XC + tok * LP + c) = xc; *(LAS unsigned*)(XB + tok * 264 + c) = pk2(xc.x, xc.y);
                *(f32x2*)(lc_out + (s * 3 + 0) * 256 + c) = xm2; *(f32x2*)(lc_out + (s * 3 + 1) * 256 + c) = xm1; *(f32x2*)(lc_out + (s * 3 + 2) * 256 + c) = x;
            }
        }
    }
    __syncthreads();
    const int blk = w & 3, dh = w >> 2, qi = lane & 31, hi = lane >> 5, ch = 64 * blk + 32 * dh + qi;
    f32x16 ar[2], ai[2];
    {
        bf16x8 bw[2][4];
#pragma unroll
        for (int gt = 0; gt < 2; ++gt)
#pragma unroll
            for (int st = 0; st < 4; ++st) bw[gt][st] = *(const bf16x8*)(W.lwt + ((size_t)(gt * 4 + blk) * 64 + 32 * dh + qi) * 64 + 16 * st + 8 * hi);
#pragma unroll
        for (int tt = 0; tt < 2; ++tt) {
#pragma unroll
            for (int r = 0; r < 16; ++r) { ar[tt][r] = 0.f; ai[tt][r] = 0.f; }
#pragma unroll
            for (int st = 0; st < 4; ++st) {
                const bf16x8 af = *(const LAS bf16x8*)(XB + (32 * tt + qi) * 264 + 64 * blk + 16 * st + 8 * hi);
                ar[tt] = __builtin_amdgcn_mfma_f32_32x32x16_bf16(af, bw[0][st], ar[tt], 0, 0, 0);
                ai[tt] = __builtin_amdgcn_mfma_f32_32x32x16_bf16(af, bw[1][st], ai[tt], 0, 0, 0);
            }
        }
    }
    __syncthreads();
    {
        const float ba = W.ba[ch], bi = W.bi[ch], lam = W.lam[ch];
        const float c8 = -8.0f * log1pf(__expf(-lam));
#pragma unroll
        for (int tt = 0; tt < 2; ++tt)
#pragma unroll
            for (int r = 0; r < 16; ++r) {
                const int tok = 32 * tt + 8 * (r >> 2) + 4 * hi + (r & 3);
                const float xc = XC[tok * LP + ch];
                const float rg = sigmoidf_(ar[tt][r] + ba), ig = sigmoidf_(ai[tt][r] + bi);
                const float la = c8 * rg, a = __builtin_amdgcn_exp2f(1.4426950408889634f * la), x2 = 2.0f * la, mult = __builtin_amdgcn_sqrtf(fmaxf(-x2 * (1.0f + x2 * (0.5f + x2 * (0.16666667f + x2 * (0.041666668f + x2 * (0.0083333338f + x2 * 0.0013888889f))))), 0.f));
                AA[tok * LP + ch] = a; XC[tok * LP + ch] = mult * ig * xc;
            }
    }
    __syncthreads();
    if (!sample) {
        const int half = tid >> 8, ch = tid & 255;
        float hl[32], cl[32];
        {
            float hh = 0.f, cum = 1.f;
#pragma unroll
            for (int i = 0; i < 32; ++i) { const int tok = 32 * half + i; const float a = AA[tok * LP + ch]; hh = a * hh + XC[tok * LP + ch]; cum *= a; hl[i] = hh; cl[i] = cum; }
        }
        __syncthreads();
        if (!half) { XC[ch] = hl[31]; XC[256 + ch] = cl[31]; }
        __syncthreads();
        if (half) {
            const float h1 = XC[ch], c1 = XC[256 + ch];
#pragma unroll
            for (int i = 0; i < 32; ++i) { hl[i] += cl[i] * h1; cl[i] *= c1; }
            const int chunk = t0 >> 6;
            agga[(size_t)(b * 128 + chunk) * 256 + ch] = cl[31]; aggb[(size_t)(b * 128 + chunk) * 256 + ch] = hl[31];
        }
        const size_t rb = ((size_t)b * SEQ + t0 + 32 * half) * 256 + ch;
#pragma unroll
        for (int i = 0; i < 32; ++i) { hloc[rb + (size_t)i * 256] = (bf16)f2bf(hl[i]); cuma[rb + (size_t)i * 256] = (bf16)f2bf(cl[i]); }
    } else {
        const int c = tid & 255, tk0 = (tid >> 8) * 32;
        float h0r[32]; unsigned short gr[32];
#pragma unroll
        for (int i = 0; i < 32; ++i) { const size_t s = t0 + tk0 + i; h0r[i] = h0[s * 256 + c]; gr[i] = Zp[s * DIN + ZLG + c]; }
#pragma unroll
        for (int i = 0; i < 32; ++i) {
            const int tok = tk0 + i; const size_t s = t0 + tok;
            const float hh = AA[tok * LP + c] * h0r[i] + XC[tok * LP + c];
            rg_out[s * 256 + c] = hh;
            XC[tok * LP + c] = hh * gelu_tanh(bf2f(gr[i]));
        }
        __syncthreads();
        for (int it = 0; it < 8; ++it) {
            const int tok = it * 8 + w; const size_t s = t0 + tok;
            const f32x4 v = *(const LAS f32x4*)(XC + tok * LP + 4 * lane);
            const float rs = rsqrtf(wave_sum((v.x * v.x + v.y * v.y) + (v.z * v.z + v.w * v.w)) * (1.0f / 256.0f) + EPS);
            st_bf4(MGp + s * DM + 512 + 4 * lane, v * *(const f32x4*)(W.gout + 512 + 4 * lane) * rs);
        }
    }
    __syncthreads();
}

__device__ __forceinline__ void lru_fix_unit(LAS unsigned char* lds, int b, int chunk, const bf16* __restrict__ Z, bf16* __restrict__ MG, const float* __restrict__ gout,
                                             const bf16* __restrict__ hloc, const bf16* __restrict__ cuma, const float* __restrict__ agga, const float* __restrict__ aggb, float* __restrict__ rg_out) {
    int tid_o = threadIdx.x; asm volatile("" : "+v"(tid_o)); const int tid = tid_o, w = tid >> 6, lane = tid & 63;
    LAS float* CR = (LAS float*)lds;
    const size_t row0 = (size_t)b * SEQ + chunk * 64 + 8 * w;
    u32x2 hlr[8], car[8]; u32x2 gr[8];
#pragma unroll
    for (int k = 0; k < 8; ++k) { hlr[k] = *(const u32x2*)(hloc + (row0 + k) * 256 + 4 * lane); car[k] = *(const u32x2*)(cuma + (row0 + k) * 256 + 4 * lane); gr[k] = *(const u32x2*)(Z + (row0 + k) * DIN + ZLG + 4 * lane); }
    {
        const int half = tid >> 8, ch = tid & 255, n1 = chunk >> 1, j0 = half ? n1 : 0, j1 = half ? chunk : n1;
        const float* pa = agga + (size_t)b * 128 * 256 + ch; const float* pb = aggb + (size_t)b * 128 * 256 + ch;
        float A = 1.f, B = 0.f;
#pragma unroll 32
        for (int j = j0; j < j1; ++j) { const float a = pa[(size_t)j * 256], bb = pb[(size_t)j * 256]; B = a * B + bb; A *= a; }
        if (half) { CR[ch] = A; CR[256 + ch] = B; }
        __syncthreads();
        if (!half) CR[512 + ch] = CR[ch] * B + CR[256 + ch];
        __syncthreads();
    }
    const f32x4 cr = *(const LAS f32x4*)(CR + 512 + 4 * lane), gg = *(const f32x4*)(gout + 512 + 4 * lane);
    f32x4 bo[8]; float q[8];
#pragma unroll
    for (int k = 0; k < 8; ++k) {
        const f32x4 hlk = (f32x4){bf2f(hlr[k].x & 0xffffu), bf2f(hlr[k].x >> 16), bf2f(hlr[k].y & 0xffffu), bf2f(hlr[k].y >> 16)};
        const f32x4 cak = (f32x4){bf2f(car[k].x & 0xffffu), bf2f(car[k].x >> 16), bf2f(car[k].y & 0xffffu), bf2f(car[k].y >> 16)};
        const f32x4 hh = hlk + cak * cr;
        const f32x4 gt = (f32x4){bf2f(gr[k].x & 0xffffu), bf2f(gr[k].x >> 16), bf2f(gr[k].y & 0xffffu), bf2f(gr[k].y >> 16)};
        bo[k].x = hh.x * gelu_tanh(gt.x); bo[k].y = hh.y * gelu_tanh(gt.y); bo[k].z = hh.z * gelu_tanh(gt.z); bo[k].w = hh.w * gelu_tanh(gt.w);
        q[k] = (bo[k].x * bo[k].x + bo[k].y * bo[k].y) + (bo[k].z * bo[k].z + bo[k].w * bo[k].w);
        if (chunk * 64 + 8 * w + k == SEQ - 1) *(f32x4*)(rg_out + (size_t)b * 256 + 4 * lane) = hh;
    }
#pragma unroll
    for (int o = 1; o < 64; o <<= 1)
#pragma unroll
        for (int k = 0; k < 8; ++k) q[k] += __shfl_xor(q[k], o);
#pragma unroll
    for (int k = 0; k < 8; ++k) st_bf4(MG + (row0 + k) * DM + 512 + 4 * lane, bo[k] * gg * rsqrtf(q[k] * (1.0f / 256.0f) + EPS));
    __syncthreads();
}

#define XB_TMO      128
#define XB_XCNT(j)  (256  + 64 * (j))
#define XB_XSUB(j)  (1280 + 64 * (j))
#define XB_XGEN(j)  (2304 + 64 * (j))
#define XB_TOP      3328
#define XB_TOPGEN   3392
#define XCD_BAR_WORDS 3456
#define XB_SPIN_CAP (1u << 18)

__device__ __forceinline__ unsigned xb_ld(unsigned* p)              { return __hip_atomic_load(p, __ATOMIC_RELAXED, __HIP_MEMORY_SCOPE_AGENT); }
__device__ __forceinline__ unsigned xb_add(unsigned* p, unsigned v) { return __hip_atomic_fetch_add(p, v, __ATOMIC_RELAXED, __HIP_MEMORY_SCOPE_AGENT); }
__device__ __forceinline__ unsigned xb_xcc_id() { return (unsigned)__builtin_amdgcn_s_getreg((3 << 11) | 20) & 0xFu; }
#define XB_SPIN(cond, bar) do { unsigned _sp = 0; while (cond) { __builtin_amdgcn_s_sleep(1); \
    if ((++_sp & 255u) == 0u) { if (xb_ld(&(bar)[XB_TMO])) break; if (_sp > XB_SPIN_CAP) { atomicAdd(&(bar)[XB_TMO], 1u); break; } } } } while (0)

struct XcdBarrier {
    unsigned* bar; unsigned x;
    volatile LAS unsigned* st;
};

__device__ __forceinline__ XcdBarrier xcd_barrier_post(unsigned* bar, volatile LAS unsigned* st) {
    XcdBarrier b; b.bar = bar; b.x = xb_xcc_id(); b.st = st;
    if (threadIdx.x == 0) (void)xb_add(&bar[XB_XCNT(b.x)], 1u);
    return b;
}
__device__ __forceinline__ void xcd_barrier_complete(unsigned* bar, unsigned x, unsigned& nloc, unsigned& nx) {
    const unsigned G = gridDim.x * gridDim.y * gridDim.z;
    unsigned sum, cnt, mine, sp = 0u;
    for (;;) {
        sum = 0u; cnt = 0u; mine = 0u;
#pragma unroll
        for (unsigned j = 0; j < 16; ++j) { const unsigned c = xb_ld(&bar[XB_XCNT(j)]); sum += c; cnt += (c > 0u) ? 1u : 0u; mine = (j == x) ? c : mine; }
        if (sum == G) break;
        __builtin_amdgcn_s_sleep(1);
        if ((++sp & 255u) == 0u) { if (xb_ld(&bar[XB_TMO])) break; if (sp > XB_SPIN_CAP) { atomicAdd(&bar[XB_TMO], 1u); break; } }
    }
    nloc = mine > 0u ? mine : 1u; nx = cnt > 0u ? cnt : 1u;
}

__device__ __forceinline__ void xcd_barrier(const XcdBarrier& b) {
    asm volatile("s_waitcnt vmcnt(0)" ::: "memory");
    __syncthreads();
    if (threadIdx.x == 0) {
        unsigned* bar = b.bar;
        __builtin_amdgcn_s_waitcnt(0);
        unsigned nloc = b.st[0], nx = b.st[1];
        if (nloc == 0u) { xcd_barrier_complete(bar, b.x, nloc, nx); b.st[0] = nloc; b.st[1] = nx; }
        const unsigned old = xb_add(&bar[XB_XSUB(b.x)], 1u);
        const unsigned gen = old / nloc;
        if (old + 1u == (gen + 1u) * nloc) {
            __builtin_amdgcn_fence(__ATOMIC_RELEASE, "agent");
            asm volatile("s_waitcnt vmcnt(0)" ::: "memory");
            const unsigned og = xb_add(&bar[XB_TOP], 1u);
            const unsigned tg = og / nx;
            if (og + 1u == (tg + 1u) * nx) xb_add(&bar[XB_TOPGEN], 1u);
            else XB_SPIN(xb_ld(&bar[XB_TOPGEN]) == tg, bar);
            __builtin_amdgcn_fence(__ATOMIC_ACQUIRE, "agent");
            xb_add(&bar[XB_XGEN(b.x)], 1u);
            asm volatile("s_waitcnt vmcnt(0)" ::: "memory");
        } else {
            XB_SPIN(xb_ld(&bar[XB_XGEN(b.x)]) == gen, bar);
            __builtin_amdgcn_fence(__ATOMIC_ACQUIRE, "agent");
            asm volatile("s_waitcnt vmcnt(0)" ::: "memory");
        }
    }
    __syncthreads();
}

typedef const Args __attribute__((address_space(4))) * KArgsP;
__device__ __forceinline__ KArgsP kargs() { KArgsP p = (KArgsP)__builtin_amdgcn_kernarg_segment_ptr(); asm volatile("" : "+s"(p)); return p; }
#define IN(i) (ka->in[i])
#define WSP(T, off) ((T*)(ka->ws + (off)))
#define OUTP(off) (ka->out + (off))
#define PHASE_VARS KArgsP ka = kargs(); int tid_o = threadIdx.x; asm volatile("" : "+v"(tid_o)); const int tid = tid_o, lane = tid & 63, wave = __builtin_amdgcn_readfirstlane(tid >> 6); \
    const int G = gridDim.x, cu = blockIdx.x, gw = cu * NWAVES + wave, NGW = G * NWAVES; (void)lane; (void)gw; (void)NGW; (void)ka;

#ifndef REP_AT
#define REP_AT 1
#endif
#ifndef REP_LR
#define REP_LR 1
#endif
#ifndef REP_SC
#define REP_SC 1
#endif
#ifndef REP_LF
#define REP_LF 1
#endif
#ifndef REP_AS
#define REP_AS 1
#endif
#ifndef REP_SG
#define REP_SG 1
#endif
#ifndef REP_LS
#define REP_LS 1
#endif
#ifndef REP_P1
#define REP_P1 1
#endif
#ifndef REP_P2
#define REP_P2 1
#endif
#ifndef REP_P3
#define REP_P3 1
#endif
#ifndef REP_P5
#define REP_P5 1
#endif
#ifndef REP_P0
#define REP_P0 1
#endif
__global__ void __launch_bounds__(NTHREADS, 2) fwd_megakernel(Args args) {
    extern __shared__ __attribute__((aligned(16))) unsigned char lds_raw[];
    LAS unsigned char* lds = (LAS unsigned char*)lds_raw;
    cg::grid_group grid = cg::this_grid();
    volatile LAS unsigned* MISC = (volatile LAS unsigned*)(lds + 147392);
    if (threadIdx.x < 16) MISC[threadIdx.x] = 0u;
    __syncthreads();
    const XcdBarrier bar = xcd_barrier_post((unsigned*)(args.ws + 16384), MISC + 8);

    for (int rep_ = 0; rep_ < REP_P0; ++rep_)
    {
        PHASE_VARS
        LAS float* scr = (LAS float*)(lds + wave * 16640);
        constexpr int I_IN = 16 * 32, I_OUT = 16 * 16, I_UP = 16 * 88, I_DN = 44 * 16, I_L = I_IN + I_OUT + I_UP + I_DN;
        for (int it = gw; it < DEPTH * I_L; it += NGW) {
            const int l = it / I_L; int r = it % I_L;
            unsigned char* wl = ka->ws + WS_W + (size_t)l * W_LAYER;
            if (r < I_IN) { transpose_item(IN(9) + (size_t)l * DM * DIN, DM, DIN, (bf16*)(wl + W_IN), 0, scr, r, lane, IN(8) + (size_t)l * DM); continue; } r -= I_IN;
            if (r < I_OUT) { transpose_item(IN(20) + (size_t)l * DM * DM, DM, DM, (bf16*)(wl + W_OUT), 0, scr, r, lane, nullptr); continue; } r -= I_OUT;
            if (r < I_UP) { transpose_item(IN(22) + (size_t)l * DM * DUP, DM, DUP, (bf16*)(wl + W_UP), 1, scr, r, lane, IN(21) + (size_t)l * DM); continue; } r -= I_UP;
            transpose_item(IN(24) + (size_t)l * DFF * DM, DFF, DM, (bf16*)(wl + W_DOWN), 0, scr, r, lane, nullptr);
        }
        bf16* LWT = WSP(bf16, WS_LWT);
        for (int e = cu * NTHREADS + tid; e < DEPTH * 2 * 4 * 4096; e += G * NTHREADS) {
            const int c = e & 63, d = (e >> 6) & 63, blk = (e >> 12) & 3, gt = (e >> 14) & 1, l = e >> 15;
            const float* src = gt ? IN(15) : IN(13);
            LWT[e] = (bf16)f2bf(src[((size_t)(l * 4 + blk) * 64 + c) * 64 + d]);
        }
        const float* xp = IN(0); bf16* X = WSP(bf16, WS_X); float* SSQB = WSP(float, WS_SSQB); float* SSQA = WSP(float, WS_SSQA);
        for (int m0 = gw; m0 < MP; m0 += 4 * NGW) {
            f32x4 v[4][4];
#pragma unroll
            for (int r = 0; r < 4; ++r) { const int m = m0 + r * NGW; if (m < MP) {
#pragma unroll
                for (int j = 0; j < 4; ++j) v[r][j] = __builtin_nontemporal_load((const f32x4*)(xp + (size_t)m * DM + 4 * lane + 256 * j)); } }
#pragma unroll
            for (int r = 0; r < 4; ++r) { const int m = m0 + r * NGW; if (m < MP) {
                float q = 0.f;
#pragma unroll
                for (int j = 0; j < 4; ++j) { q += (v[r][j].x * v[r][j].x + v[r][j].y * v[r][j].y) + (v[r][j].z * v[r][j].z + v[r][j].w * v[r][j].w); st_bf4(X + (size_t)m * DM + 4 * lane + 256 * j, v[r][j]); }
                q = wave_sum(q);
                if (lane == 0) *(f32x4*)(SSQB + 4 * (size_t)m) = (f32x4){q, 0.f, 0.f, 0.f}; } }
        }
        (void)SSQA;
        { const float* xs0 = IN(1); bf16* XSB = WSP(bf16, WS_XSB);
          for (int e = (cu * NTHREADS + tid) * 4; e < NS * DM; e += G * NTHREADS * 4) st_bf4(XSB + e, *(const f32x4*)(xs0 + e)); }
    }
    xcd_barrier(bar);
    if (gridDim.x == 0x7fffffffu) grid.sync();

#pragma nounroll
    for (int l = 0; l < DEPTH; ++l) {
        for (int rep_ = 0; rep_ < REP_P1; ++rep_)
        {
            PHASE_VARS
            const bf16* Win_t = (const bf16*)(ka->ws + WS_W + (size_t)l * W_LAYER + W_IN);
            pg8::Gemm g{WSP(bf16, WS_X), Win_t, MP, DIN, DM}; pg8::StaticOrder S; S.init(MP, DIN, G, cu);
            EpiZ E{WSP(bf16, WS_Z), WSP(float, WS_SSQB)};
            pg8::gemm_phase<EpiZ, pg8::StaticOrder, true, true, false>(lds, g, S, E);
        }
        xcd_barrier(bar);

        for (int rep_ = 0; rep_ < REP_P2; ++rep_)
        {
            PHASE_VARS
            const float* gout = IN(19) + (size_t)l * DM;
            const float* sinks = IN(10) + l * 8;
            LruW LW{IN(11) + (size_t)l * 4 * 256, IN(12) + (size_t)l * 256, IN(14) + (size_t)l * 256, IN(16) + (size_t)l * 256,
                    IN(17) + (size_t)l * 256, gout, WSP(bf16, WS_LWT) + (size_t)l * 2 * 4 * 4096};
            if (G == 256) {
                if (cu < 64)
                    for (int r2 = 0; r2 < REP_SG; ++r2) small_gemm_unit<0>(lds, cu, WSP(bf16, WS_XSB), (const bf16*)(ka->ws + WS_W + (size_t)l * W_LAYER + W_IN), DM, WSP(bf16, WS_ZS), DIN, nullptr, nullptr, nullptr, nullptr, nullptr);
                { const int b = cu >> 7, qb = cu & 127;
                  for (int r2 = 0; r2 < REP_AT; ++r2) attn_prompt_unit(lds, b, qb * 64, WSP(bf16, WS_Z), WSP(bf16, WS_MG), sinks, gout, OUTP(O_CKP) + (size_t)(l * 2 + b) * 16384, OUTP(O_CVP) + (size_t)(l * 2 + b) * 16384);
                  for (int r2 = 0; r2 < REP_LR; ++r2) lru_unit(lds, false, b, qb * 64, WSP(bf16, WS_Z), WSP(bf16, WS_MG), LW, WSP(bf16, WS_HLOC), WSP(bf16, WS_CUMA), WSP(float, WS_AGGA), WSP(float, WS_AGGB),
                             nullptr, nullptr, OUTP(O_LCP) + (size_t)l * 2 * 3 * 256, nullptr); }
                if (cu >= 64) {
                    const int b = cu >> 7, tb = cu & 127;
                    for (int r2 = 0; r2 < REP_SC; ++r2) sconv_unit<8>(false, b, tb * 64, WSP(bf16, WS_Z), WSP(bf16, WS_MG), IN(18) + (size_t)l * 3 * 256, gout, nullptr, OUTP(O_SCP) + (size_t)l * 2 * 2 * 256);
                    if (cu < 192) { const int u = (cu - 64) >> 1, hf = (cu - 64) & 1;
                        sconv_unit<4>(false, 0, u * 64 + 32 * hf, WSP(bf16, WS_Z), WSP(bf16, WS_MG), IN(18) + (size_t)l * 3 * 256, gout, nullptr, OUTP(O_SCP) + (size_t)l * 2 * 2 * 256); }
                }
            } else
            for (int idx0 = cu; idx0 < 64 + 768; idx0 += G) {
                if (idx0 < 64) {
                    for (int r2 = 0; r2 < REP_SG; ++r2) small_gemm_unit<0>(lds, idx0, WSP(bf16, WS_XSB), (const bf16*)(ka->ws + WS_W + (size_t)l * W_LAYER + W_IN), DM, WSP(bf16, WS_ZS), DIN, nullptr, nullptr, nullptr, nullptr, nullptr);
                    continue;
                }
                const int idx = idx0 - 64;
                if (idx < 256) {
                    const int b = idx >> 7, qb = idx & 127;
                    for (int r2 = 0; r2 < REP_AT; ++r2) attn_prompt_unit(lds, b, qb * 64, WSP(bf16, WS_Z), WSP(bf16, WS_MG), sinks, gout, OUTP(O_CKP) + (size_t)(l * 2 + b) * 16384, OUTP(O_CVP) + (size_t)(l * 2 + b) * 16384);
                } else if (idx < 512) {
                    LruW LW{IN(11) + (size_t)l * 4 * 256, IN(12) + (size_t)l * 256, IN(14) + (size_t)l * 256, IN(16) + (size_t)l * 256,
                            IN(17) + (size_t)l * 256, gout, WSP(bf16, WS_LWT) + (size_t)l * 2 * 4 * 4096};
                    const int u = idx - 256, b = u >> 7, chunk = u & 127;
                    for (int r2 = 0; r2 < REP_LR; ++r2) lru_unit(lds, false, b, chunk * 64, WSP(bf16, WS_Z), WSP(bf16, WS_MG), LW, WSP(bf16, WS_HLOC), WSP(bf16, WS_CUMA), WSP(float, WS_AGGA), WSP(float, WS_AGGB),
                             nullptr, nullptr, OUTP(O_LCP) + (size_t)l * 2 * 3 * 256, nullptr);
                } else {
                    const int u = idx - 512, b = u >> 7, tb = u & 127;
                    for (int r2 = 0; r2 < REP_SC; ++r2) sconv_unit<8>(false, b, tb * 64, WSP(bf16, WS_Z), WSP(bf16, WS_MG), IN(18) + (size_t)l * 3 * 256, gout, nullptr, OUTP(O_SCP) + (size_t)l * 2 * 2 * 256);
                }
            }
        }
        xcd_barrier(bar);

        for (int rep_ = 0; rep_ < REP_P3; ++rep_)
        {
            PHASE_VARS
            const float* gout = IN(19) + (size_t)l * DM;
            for (int k = 0; k < 2; ++k) {
                int idx = -1;
                if (G == 256) {
                    if (k == 0) idx = (cu >= 128 && cu < 132) ? 256 + cu : cu;
                    else idx = (cu < 128) ? 256 + cu : ((cu >= 132 && cu < 136) ? cu - 4 : -1);
                    if (idx >= 384) idx = idx;
                }
                for (int i2 = (G == 256 ? idx : cu + k * 100000); i2 >= 0 && i2 < 388; i2 += (G == 256 ? 100000 : G)) {
                    const int id = i2;
                    if (id < 256) {
                        for (int r2 = 0; r2 < REP_LF; ++r2) lru_fix_unit(lds, id >> 7, id & 127, WSP(bf16, WS_Z), WSP(bf16, WS_MG), gout, WSP(bf16, WS_HLOC), WSP(bf16, WS_CUMA),
                                     WSP(float, WS_AGGA), WSP(float, WS_AGGB), OUTP(O_RGP) + (size_t)l * 2 * 256);
                    } else if (id < 384) {
                        const int s = id - 256;
                        for (int r2 = 0; r2 < REP_AS; ++r2) attn_sample_unit(lds, s, WSP(bf16, WS_ZS), WSP(bf16, WS_MGS), IN(10) + l * 8, gout, IN(2) + (size_t)l * NS * 16384, IN(3) + (size_t)l * NS * 16384,
                                         OUTP(O_CKS) + (size_t)l * NS * 16384, OUTP(O_CVS) + (size_t)l * NS * 16384);
                    } else if (id < 386) {
                        LruW LW{IN(11) + (size_t)l * 4 * 256, IN(12) + (size_t)l * 256, IN(14) + (size_t)l * 256, IN(16) + (size_t)l * 256,
                                IN(17) + (size_t)l * 256, gout, WSP(bf16, WS_LWT) + (size_t)l * 2 * 4 * 4096};
                        for (int r2 = 0; r2 < REP_LS; ++r2) lru_unit(lds, true, 0, (id - 384) * 64, WSP(bf16, WS_ZS), WSP(bf16, WS_MGS), LW, nullptr, nullptr, nullptr, nullptr, IN(5) + (size_t)l * NS * 3 * 256, IN(4) + (size_t)l * NS * 256,
                                 OUTP(O_LCS) + (size_t)l * NS * 3 * 256, OUTP(O_RGS) + (size_t)l * NS * 256);
                    } else {
                        sconv_unit<8>(true, 0, (id - 386) * 64, WSP(bf16, WS_ZS), WSP(bf16, WS_MGS), IN(18) + (size_t)l * 3 * 256, gout, IN(6) + (size_t)l * NS * 2 * 256, OUTP(O_SCS) + (size_t)l * NS * 2 * 256);
                    }
                }
                if (G != 256) break;
            }
        }
        xcd_barrier(bar);

        {
            PHASE_VARS
            const bf16* Wout_t = (const bf16*)(ka->ws + WS_W + (size_t)l * W_LAYER + W_OUT);
            if (cu < 32) {
                const float* xs_in = (l == 0) ? IN(1) : WSP(float, WS_XS);
                small_gemm_unit<1>(lds, cu, WSP(bf16, WS_MGS), Wout_t, DM, WSP(bf16, WS_XSB), 0, xs_in, WSP(float, WS_XS), nullptr, nullptr, nullptr);
            }
            pg8::Gemm g{WSP(bf16, WS_MG), Wout_t, MP, DM, DM}; pg8::StaticOrder S; S.init(MP, DM, G, cu);
            EpiRes E{WSP(bf16, WS_X), WSP(float, WS_SSQA), (LAS float*)(lds + 131072), lds, G == 256};
            if (G == 256) pg8::gemm_phase<EpiRes, pg8::StaticOrder, true, true, false, true>(lds, g, S, E);
            else pg8::gemm_phase<EpiRes, pg8::StaticOrder, true, true, false>(lds, g, S, E);
        }
        xcd_barrier(bar);

        for (int rep_ = 0; rep_ < REP_P5; ++rep_)
        {
            PHASE_VARS
            const bf16* Wup_t = (const bf16*)(ka->ws + WS_W + (size_t)l * W_LAYER + W_UP);
            const float* fcw = IN(23) + (size_t)l * 3 * DUP;
            pg8::Gemm g{WSP(bf16, WS_X), Wup_t, 66 * 256, DUP, DM}; pg8::StaticOrder S; S.init(66 * 256, DUP, G, cu);
            EpiFfn E{WSP(bf16, WS_ACT), fcw, OUTP(O_FFP) + (size_t)l * 2 * 2 * DUP, WSP(float, WS_SSQA)};
            pg8::gemm_phase<EpiFfn, pg8::StaticOrder, true, true, true>(lds, g, S, E);
            const int nwg = 66 * 22, rem = nwg % G, n_idle = rem ? G - rem : G, first_idle = G - n_idle;
            if (cu >= first_idle)
                for (int j3 = cu - first_idle; j3 < 59; j3 += n_idle)
                    small_ffn_unit(lds, j3, WSP(bf16, WS_XSB), Wup_t, WSP(bf16, WS_ACTS), fcw, IN(7) + (size_t)l * NS * 2 * DUP, OUTP(O_FFS) + (size_t)l * NS * 2 * DUP);
        }
        xcd_barrier(bar);

        {
            PHASE_VARS
            const bf16* Wdown_t = (const bf16*)(ka->ws + WS_W + (size_t)l * W_LAYER + W_DOWN);
            if (cu < 32)
                small_gemm_unit<1>(lds, cu, WSP(bf16, WS_ACTS), Wdown_t, DFF, WSP(bf16, WS_XSB), 0, WSP(float, WS_XS), WSP(float, WS_XS), nullptr, nullptr, nullptr);
            pg8::Gemm g{WSP(bf16, WS_ACT), Wdown_t, MP, DM, DFF}; pg8::StaticOrder S; S.init(MP, DM, G, cu);
            EpiRes E{WSP(bf16, WS_X), WSP(float, WS_SSQB), (LAS float*)(lds + 131072), lds, G == 256};
            if (G == 256) pg8::gemm_phase<EpiRes, pg8::StaticOrder, true, true, false, true>(lds, g, S, E);
            else pg8::gemm_phase<EpiRes, pg8::StaticOrder, true, true, false>(lds, g, S, E);
        }
        xcd_barrier(bar);
    }
    {
        PHASE_VARS
        const float* gfin = IN(25); const float* XS = WSP(float, WS_XS); float* ys = OUTP(O_YS); float* Y = OUTP(O_Y);
        const bf16* X = WSP(bf16, WS_X); const float* SSQB = WSP(float, WS_SSQB);
        f32x4 gg[4];
#pragma unroll
        for (int j = 0; j < 4; ++j) gg[j] = *(const f32x4*)(gfin + 4 * lane + 256 * j);
        for (int m0 = gw; m0 < MP; m0 += 4 * NGW) {
            u32x2 xr[4][4]; f32x4 sq[4];
#pragma unroll
            for (int r = 0; r < 4; ++r) { const int m = m0 + r * NGW; if (m < MP) { sq[r] = *(const f32x4*)(SSQB + 4 * (size_t)m);
#pragma unroll
                for (int j = 0; j < 4; ++j) xr[r][j] = *(const u32x2*)(X + (size_t)m * DM + 4 * lane + 256 * j); } }
#pragma unroll
            for (int r = 0; r < 4; ++r) { const int m = m0 + r * NGW; if (m < MP) {
                const float rs = rsqrtf(((sq[r].x + sq[r].y) + (sq[r].z + sq[r].w)) * (1.0f / DM) + EPS);
#pragma unroll
                for (int j = 0; j < 4; ++j) { const f32x4 v = (f32x4){bf2f(xr[r][j].x & 0xffffu), bf2f(xr[r][j].x >> 16), bf2f(xr[r][j].y & 0xffffu), bf2f(xr[r][j].y >> 16)};
                    *(f32x4*)(Y + (size_t)m * DM + 4 * lane + 256 * j) = v * gg[j] * rs; } } }
        }
        for (int m = gw; m < NS; m += NGW) rms_row_f32(XS + (size_t)m * DM, gfin, ys + (size_t)m * DM, lane);
    }
}

extern "C" void kernel_launch(void* const* d_in, const int* in_sizes, int n_in, void* d_out, int out_size, void* d_ws, size_t ws_size, hipStream_t stream) {
    static int grid = 0;
    if (grid == 0) {
        if (n_in != 26 || ws_size < WS_END) { fprintf(stderr, "kernel_launch: unexpected n_in %d / ws_size %zu\n", n_in, ws_size); grid = -1; return; }
        int dev = 0, cus = 0, per_cu = 0;
        hipGetDevice(&dev);
        hipDeviceGetAttribute(&cus, hipDeviceAttributeMultiprocessorCount, dev);
        hipFuncSetAttribute((const void*)fwd_megakernel, hipFuncAttributeMaxDynamicSharedMemorySize, LDS_BYTES);
        hipOccupancyMaxActiveBlocksPerMultiprocessor(&per_cu, (const void*)fwd_megakernel, NTHREADS, LDS_BYTES);
        if (per_cu < 1) per_cu = 1;
        (void)hipGetLastError();
        grid = cus;
    }
    if (grid < 0) return;
    if (hipMemsetAsync(d_ws, 0, 65536, stream) != hipSuccess) { fprintf(stderr, "memset failed\n"); return; }
    Args a{};
    for (int i = 0; i < 26; ++i) a.in[i] = (const float*)d_in[i];
    a.out = (float*)d_out; a.ws = (unsigned char*)d_ws;
    void* kargs[] = {&a};
    hipError_t e = hipLaunchCooperativeKernel((const void*)fwd_megakernel, dim3(grid), dim3(NTHREADS), kargs, LDS_BYTES, stream);
    if (e != hipSuccess) fprintf(stderr, "cooperative launch failed: %s (grid %d)\n", hipGetErrorString(e), grid);
}
```

```cpp
#include <hip/hip_runtime.h>
#include <hip/hip_cooperative_groups.h>
#include <cstdio>
#include <cstdint>
namespace cg = cooperative_groups;
namespace pg8 {
#define PG8_LAS __attribute__((address_space(3)))
typedef unsigned short bf16_t;
typedef short bf16x8 __attribute__((ext_vector_type(8)));
typedef float f32x4 __attribute__((ext_vector_type(4)));
typedef unsigned u32x4 __attribute__((ext_vector_type(4)));
constexpr int BM = 256, BK = 64, HALF = 128, HTB = HALF * BK * 2  , STAGE_BYTES = 8 * HTB, NXCD = 8, WGM = 8;

__host__ __device__ __forceinline__ int lds_byte(int r, int c) { const int st = (r >> 4) * 2 + (c >> 5), rr = r & 15, cc = c & 31, ob = rr * 64 + cc * 2; return st * 1024 + (ob ^ (((ob >> 9) & 1) << 5)); }
__host__ __device__ __forceinline__ void stage_rc(int b, int& R, int& C) { const int st = b / 1024, sb = b % 1024, swz = sb ^ (((sb >> 9) & 1) << 5); R = (st >> 1) * 16 + swz / 64; C = (st & 1) * 32 + (swz % 64) / 2; }
__host__ __device__ __forceinline__ int perm32(int rho) { const int n = rho >> 4, i = rho & 15; return 8 * (i >> 2) + 4 * n + (i & 3); }

struct Unit { int pm, pn; };
struct Gemm { const bf16_t* A; const bf16_t* Bt; int M, N, K; };

struct StaticOrder {
    int nM, nN, nwg, G, c;
    __host__ __device__ void init(int M, int N, int G_, int c_) { nM = M / BM; nN = N / BM; nwg = nM * nN; G = G_; c = c_; }
    __host__ __device__ bool next(int i, Unit& u) const {
        const long L = (long)i * G + c; if (L >= nwg) return false;
        int wgid = (int)L; { const int q = nwg / NXCD, r = nwg % NXCD, xcd = wgid % NXCD, off = wgid / NXCD; wgid = (xcd < r ? xcd * (q + 1) : r * (q + 1) + (xcd - r) * q) + off; }
        const int nig = WGM * nN, gid = wgid / nig, fm = gid * WGM, gsz = (nM - fm) < WGM ? (nM - fm) : WGM;
        u.pm = fm + ((wgid % nig) % gsz); u.pn = (wgid % nig) / gsz; return true;
    }
    __device__ __forceinline__ void a_ready(const Unit&) const {}
    __device__ __forceinline__ void done(const Unit&) const {}
};

__device__ __forceinline__ unsigned cvt_pk_bf16(float lo, float hi) { unsigned r; asm volatile("v_cvt_pk_bf16_f32 %0, %1, %2" : "=v"(r) : "v"(lo), "v"(hi)); return r; }
typedef float f32x2 __attribute__((ext_vector_type(2)));
__device__ __forceinline__ f32x2 gelu_pk(f32x2 v) {
    const f32x2 av = __builtin_elementwise_abs(v), d = av * 0.2316418882f + 1.0f;
    f32x2 t; t.x = __builtin_amdgcn_rcpf(d.x); t.y = __builtin_amdgcn_rcpf(d.y);
    f32x2 q = t * 0.5307027145f + (-0.7265760135f); q = q * t + 0.7107068705f; q = q * t + (-0.142248368f); q = q * t + 0.127414796f; q = q * t;
    const f32x2 s = (v * v) * (-0.72134752044f);
    f32x2 e; e.x = __builtin_amdgcn_exp2f(s.x); e.y = __builtin_amdgcn_exp2f(s.y);
    const f32x2 m = v * (q * e), r = v - m;
    f32x2 o; o.x = v.x < 0.f ? m.x : r.x; o.y = v.y < 0.f ? m.y : r.y; return o;
}

template <int ACT  > struct EpiBf16 {
    static constexpr bool PERM = true, AFTER_DRAIN = false; static_assert(ACT == 0 || ACT == 1, "EpiBf16: ACT is 0 (none) or 1 (gelu_pk)");
    bf16_t* O; int ldc; const float* bias; int split_cols; size_t split_stride; float scale0;
    __device__ __forceinline__ void operator()(const f32x4 (&acc)[2][2][4][2], const Unit& u, int wr, int wc, int fr, int fq) const {
        const int row0 = u.pm * BM + wr * 64 + fr; int colt = u.pn * BM; bf16_t* base = O;
        float sc = 1.f; if (split_cols) { const int t = colt / split_cols; base += (size_t)t * split_stride; colt -= t * split_cols; if (t == 0) sc = scale0; }
        const int col0 = colt + wc * 32 + 8 * fq, bcol0 = u.pn * BM + wc * 32 + 8 * fq;
        f32x4 bv[2][2];
#pragma unroll
        for (int bj = 0; bj < 2; ++bj)
#pragma unroll
            for (int n = 0; n < 2; ++n) bv[bj][n] = bias ? *(const f32x4*)(bias + bcol0 + bj * HALF + 4 * n) : (f32x4){0.f, 0.f, 0.f, 0.f};
#pragma unroll
        for (int ai = 0; ai < 2; ++ai)
#pragma unroll
            for (int m = 0; m < 4; ++m) { bf16_t* rowp = base + (size_t)(row0 + ai * HALF + m * 16) * ldc + col0;
#pragma unroll
                for (int bj = 0; bj < 2; ++bj) { f32x4 v0 = acc[ai][bj][m][0] + bv[bj][0], v1 = acc[ai][bj][m][1] + bv[bj][1];
                    if (ACT == 1) { f32x2 a = gelu_pk((f32x2){v0[0], v0[1]}), b = gelu_pk((f32x2){v0[2], v0[3]}), c = gelu_pk((f32x2){v1[0], v1[1]}), d = gelu_pk((f32x2){v1[2], v1[3]});
                        v0 = (f32x4){a.x, a.y, b.x, b.y}; v1 = (f32x4){c.x, c.y, d.x, d.y}; }
                    v0 = v0 * sc; v1 = v1 * sc; u32x4 w; w.x = cvt_pk_bf16(v0[0], v0[1]); w.y = cvt_pk_bf16(v0[2], v0[3]); w.z = cvt_pk_bf16(v1[0], v1[1]); w.w = cvt_pk_bf16(v1[2], v1[3]);
                    *(u32x4*)(rowp + bj * HALF) = w; } }
    }
};

struct PanelStats {
    unsigned* xbuf;
    unsigned* cnt;
    unsigned* tmo;
    int ntn; float eps;
    unsigned code;
    __device__ __forceinline__ bool run(const f32x4 (&v)[2][2][4][2], const Unit& u, int wr, int wc, int fr, int fq, PG8_LAS unsigned char* lds, int wid, int lane) const {
        typedef float f32x2v __attribute__((ext_vector_type(2)));
        PG8_LAS f32x2v* P = (PG8_LAS f32x2v*)lds;
        PG8_LAS f32x2v* S = (PG8_LAS f32x2v*)(lds + 8192);
        PG8_LAS unsigned* flag = (PG8_LAS unsigned*)(lds + 8192 + 2048);
#pragma unroll
        for (int ai = 0; ai < 2; ++ai)
#pragma unroll
            for (int m = 0; m < 4; ++m) {
                float s = 0.f;
#pragma unroll
                for (int bj = 0; bj < 2; ++bj)
#pragma unroll
                    for (int n = 0; n < 2; ++n) { const f32x4 x = v[ai][bj][m][n]; s += (x[0] + x[1]) + (x[2] + x[3]); }
                s += __shfl_xor(s, 16); s += __shfl_xor(s, 32);
                const float mw = s * (1.0f / 64.0f); float q = 0.f;
#pragma unroll
                for (int bj = 0; bj < 2; ++bj)
#pragma unroll
                    for (int n = 0; n < 2; ++n) { const f32x4 d = v[ai][bj][m][n] - mw; q += (d[0] * d[0] + d[1] * d[1]) + (d[2] * d[2] + d[3] * d[3]); }
                q += __shfl_xor(q, 16); q += __shfl_xor(q, 32);
                if (fq == 0) P[(ai * HALF + wr * 64 + m * 16 + fr) * 4 + wc] = (f32x2v){mw, q};
            }
        asm volatile("s_waitcnt lgkmcnt(0)" ::: "memory"); __builtin_amdgcn_s_barrier(); asm volatile("" ::: "memory");
#if defined(BROKEN_EXCHANGE_NO_WAIT)
#warning BROKEN CONTROL BUILD: the row-statistics exchange does not wait; results are wrong by design
        if (blockIdx.x >= 64) { const long long t0_ = clock64(); while (clock64() - t0_ < 60000) __builtin_amdgcn_s_sleep(8); }
#endif
        const int row = wid * 32 + (lane & 31);
        if (lane < 32) {
            const f32x2v a = P[row * 4 + 0], b = P[row * 4 + 1], c = P[row * 4 + 2], d = P[row * 4 + 3];
            const float mt = (a.x + b.x + c.x + d.x) * 0.25f;
            const float da = a.x - mt, db = b.x - mt, dc = c.x - mt, dd = d.x - mt;
            const float m2 = (a.y + b.y) + (c.y + d.y) + 64.0f * ((da * da + db * db) + (dc * dc + dd * dd));
            unsigned long long* slot = (unsigned long long*)xbuf + ((size_t)(u.pm * BM + row) * 4 + u.pn);
            __hip_atomic_store(slot, ((unsigned long long)__float_as_uint(m2) << 32) | __float_as_uint(mt), __ATOMIC_RELAXED, __HIP_MEMORY_SCOPE_AGENT);
        }
        asm volatile("s_waitcnt vmcnt(0)" ::: "memory");
        if (lane == 0) __hip_atomic_fetch_add(cnt + 64 * u.pm, 1u, __ATOMIC_RELAXED, __HIP_MEMORY_SCOPE_AGENT);
        if (wid == 0) {
            bool dead = false; const unsigned long long t0 = __builtin_amdgcn_s_memrealtime(); const unsigned want = 8u * (unsigned)ntn;
            for (;;) {
#if defined(BROKEN_EXCHANGE_NO_WAIT)
                break;
#endif
                if ((unsigned)__builtin_amdgcn_readfirstlane(__hip_atomic_load(cnt + 64 * u.pm, __ATOMIC_RELAXED, __HIP_MEMORY_SCOPE_AGENT)) >= want) break;
                if (__builtin_amdgcn_s_memrealtime() - t0 > 2000000ull) {
                    if (lane == 0) { unsigned expect = 0u; __hip_atomic_compare_exchange_strong(tmo + 1, &expect, code | (unsigned)(u.pm & 0xff), __ATOMIC_RELAXED, __ATOMIC_RELAXED, __HIP_MEMORY_SCOPE_AGENT);
                                     __hip_atomic_store(tmo, 1u, __ATOMIC_RELAXED, __HIP_MEMORY_SCOPE_AGENT); }
                    dead = true; break; }
                __builtin_amdgcn_s_sleep(2);
            }
            __builtin_amdgcn_fence(__ATOMIC_ACQUIRE, "agent");
            if (lane == 0) flag[0] = dead ? 1u : 0u;
        }
        asm volatile("s_waitcnt vmcnt(0) lgkmcnt(0)" ::: "memory"); __builtin_amdgcn_s_barrier(); asm volatile("" ::: "memory");
        const bool bad = flag[0] != 0u;
        if (lane < 32) {
            const unsigned long long* slot = (const unsigned long long*)xbuf + (size_t)(u.pm * BM + row) * 4; float mt[4], m2[4]; float ms = 0.f;
#pragma unroll
            for (int t = 0; t < 4; ++t) { if (t < ntn) { const unsigned long long w = __hip_atomic_load(slot + t, __ATOMIC_RELAXED, __HIP_MEMORY_SCOPE_AGENT); mt[t] = __uint_as_float((unsigned)w); m2[t] = __uint_as_float((unsigned)(w >> 32)); } else { mt[t] = 0.f; m2[t] = 0.f; } ms += mt[t]; }
            const float mean = ms / (float)ntn; float q = 0.f;
#pragma unroll
            for (int t = 0; t < 4; ++t) if (t < ntn) { const float dm = mt[t] - mean; q += m2[t] + 256.0f * dm * dm; }
            S[row] = (f32x2v){mean, 1.0f / sqrtf(q / (256.0f * (float)ntn) + eps)};
        }
        asm volatile("s_waitcnt lgkmcnt(0)" ::: "memory"); __builtin_amdgcn_s_barrier(); asm volatile("" ::: "memory");
        return bad;
    }
};
struct EpiLnRes {
    static constexpr bool PERM = false, AFTER_DRAIN = true;
    const float* base; float* out; int ldc; const float* bias; PanelStats st; unsigned poison;
    __device__ __forceinline__ void fused(f32x4 (&acc)[2][2][4][2], const Unit& u, int wr, int wc, int fr, int fq, PG8_LAS unsigned char* lds, int wid, int lane) const {
        typedef float f32x2v __attribute__((ext_vector_type(2)));
        const PG8_LAS f32x2v* S = (const PG8_LAS f32x2v*)(lds + 8192);
        const int col0 = u.pn * BM + wc * 32 + 4 * fq;
#pragma unroll
        for (int bj = 0; bj < 2; ++bj)
#pragma unroll
            for (int n = 0; n < 2; ++n) { const f32x4 bv = bias ? *(const f32x4*)(bias + col0 + bj * HALF + n * 16) : (f32x4){0.f, 0.f, 0.f, 0.f};
#pragma unroll
                for (int ai = 0; ai < 2; ++ai)
#pragma unroll
                    for (int m = 0; m < 4; ++m) acc[ai][bj][m][n] += bv; }
        f32x4 pre[4][2][2];
#pragma unroll
        for (int m = 0; m < 4; ++m) { const size_t off = (size_t)(u.pm * BM + wr * 64 + m * 16 + fr) * ldc + col0;
#pragma unroll
            for (int bj = 0; bj < 2; ++bj)
#pragma unroll
                for (int n = 0; n < 2; ++n) pre[m][bj][n] = *(const f32x4*)(base + off + bj * HALF + n * 16); }
        const bool bad = st.run(acc, u, wr, wc, fr, fq, lds, wid, lane) || poison != 0u;
        const float qnan = __builtin_nanf("");
#pragma unroll
        for (int ai = 0; ai < 2; ++ai)
#pragma unroll
            for (int m = 0; m < 4; ++m) { const int r = ai * HALF + wr * 64 + m * 16 + fr; const f32x2v sr = S[r]; const size_t off = (size_t)(u.pm * BM + r) * ldc + col0;
#pragma unroll
                for (int bj = 0; bj < 2; ++bj)
#pragma unroll
                    for (int n = 0; n < 2; ++n) { const f32x4 bs = ai == 0 ? pre[m][bj][n] : *(const f32x4*)(base + off + bj * HALF + n * 16); f32x4 o = bs + (acc[ai][bj][m][n] - sr.x) * sr.y;
                        if (bad) o = (f32x4){qnan, qnan, qnan, qnan}; *(f32x4*)(out + off + bj * HALF + n * 16) = o; }
                if (m & 1) asm volatile("" ::: "memory"); }
    }
};
struct EpiLnResLn {
    static constexpr bool PERM = false, AFTER_DRAIN = true;
    const float* base; float* out; bf16_t* xn; int ldc; const float* bias; PanelStats st1, st2; unsigned poison;
    __device__ __forceinline__ void fused(f32x4 (&acc)[2][2][4][2], const Unit& u, int wr, int wc, int fr, int fq, PG8_LAS unsigned char* lds, int wid, int lane) const {
        typedef float f32x2v __attribute__((ext_vector_type(2))); typedef unsigned u32x2v __attribute__((ext_vector_type(2)));
        const PG8_LAS f32x2v* S = (const PG8_LAS f32x2v*)(lds + 8192);
        const int col0 = u.pn * BM + wc * 32 + 4 * fq;
#pragma unroll
        for (int bj = 0; bj < 2; ++bj)
#pragma unroll
            for (int n = 0; n < 2; ++n) { const f32x4 bv = bias ? *(const f32x4*)(bias + col0 + bj * HALF + n * 16) : (f32x4){0.f, 0.f, 0.f, 0.f};
#pragma unroll
                for (int ai = 0; ai < 2; ++ai)
#pragma unroll
                    for (int m = 0; m < 4; ++m) acc[ai][bj][m][n] += bv; }
        bool bad = st1.run(acc, u, wr, wc, fr, fq, lds, wid, lane) || poison != 0u;
        const float qnan = __builtin_nanf("");
#pragma unroll
        for (int ai = 0; ai < 2; ++ai)
#pragma unroll
            for (int m = 0; m < 4; ++m) { const int r = ai * HALF + wr * 64 + m * 16 + fr; const f32x2v sr = S[r]; const size_t off = (size_t)(u.pm * BM + r) * ldc + col0;
#pragma unroll
                for (int bj = 0; bj < 2; ++bj)
#pragma unroll
                    for (int n = 0; n < 2; ++n) { const f32x4 bs = *(const f32x4*)(base + off + bj * HALF + n * 16); acc[ai][bj][m][n] = bs + (acc[ai][bj][m][n] - sr.x) * sr.y; }
                asm volatile("" : "+v"(acc[ai][0][m][0]), "+v"(acc[ai][0][m][1]), "+v"(acc[ai][1][m][0]), "+v"(acc[ai][1][m][1]));
                if (m & 1) asm volatile("" ::: "memory"); }
        const bool bad1 = bad;
        bad = st2.run(acc, u, wr, wc, fr, fq, lds, wid, lane) || bad;
#pragma unroll
        for (int ai = 0; ai < 2; ++ai)
#pragma unroll
            for (int m = 0; m < 4; ++m) { const int r = ai * HALF + wr * 64 + m * 16 + fr; const f32x2v sr = S[r]; const size_t off = (size_t)(u.pm * BM + r) * ldc + col0;
#pragma unroll
                for (int bj = 0; bj < 2; ++bj)
#pragma unroll
                    for (int n = 0; n < 2; ++n) { const f32x4 x1 = acc[ai][bj][m][n]; *(f32x4*)(out + off + bj * HALF + n * 16) = bad1 ? (f32x4){qnan, qnan, qnan, qnan} : x1;
                        const f32x4 o = (x1 - sr.x) * sr.y; u32x2v w; w.x = cvt_pk_bf16(o[0], o[1]); w.y = cvt_pk_bf16(o[2], o[3]);
                        if (bad) { w.x = 0x7fc07fc0u; w.y = 0x7fc07fc0u; } *(u32x2v*)(xn + off + bj * HALF + n * 16) = w; }
                asm volatile("" ::: "memory"); }
    }
};

template <class Epi, class Sched, bool ALIGN_EPI = false, bool SP2 = false, bool AMAP = false, bool XPRE = false>
__device__ __forceinline__ void gemm_phase(PG8_LAS unsigned char* lds, const Gemm g, const Sched& S, const Epi& E) {
    int tid_o = threadIdx.x; asm volatile("" : "+v"(tid_o)); const int tid = tid_o, wid = __builtin_amdgcn_readfirstlane(tid >> 6), lane = tid & 63, wr = wid >> 2, wc = wid & 3, fr = lane & 15, fq = lane >> 4;
    const int K = g.K, nt = K / BK;
    unsigned voffA[2], voffB[2];
#pragma unroll
    for (int i = 0; i < 2; ++i) { int R, C; stage_rc(tid * 16 + i * 8192, R, C); const int Rb = Epi::PERM ? ((R & ~31) + perm32(R & 31)) : R;
        const int Ra = AMAP ? ((R >> 6) * 126 + 8 * (R & 15) + ((R >> 4) & 3)) : R;
        voffA[i] = (unsigned)(Ra * K + C) * 2u; voffB[i] = (unsigned)(Rb * K + C) * 2u; }
    const size_t kstep = (size_t)(BK * 2);
    const size_t hstep = (size_t)HALF * K * 2;
    const size_t tstep = 2 * hstep;
    const size_t hstepA = AMAP ? (size_t)4 * K * 2 : hstep;
#define PG8_AROW(pm) (AMAP ? ((long)((pm) / 33) * 8192 + (long)((pm) % 33) * 252 - 2) : (long)(pm) * 256)
    const unsigned ldsw = (unsigned)wid * 1024u;
    const int aoff = lds_byte(wr * 64 + fr, fq * 8), boff = lds_byte(wc * 32 + fr, fq * 8);
#define PG8_SA(b, h) (((b) * 2 + (h)) * HTB)
#define PG8_SB(b, h) ((4 + (b) * 2 + (h)) * HTB)
#define PG8_STAGE(bufoff, gbase, voff) do { _Pragma("unroll") for (int _i = 0; _i < 2; ++_i) \
        __builtin_amdgcn_global_load_lds((const unsigned*)((const char*)(gbase) + (voff)[_i]), (PG8_LAS unsigned*)(lds + (bufoff) + ldsw + _i * 8192), 16, 0, 0); } while (0)
#define PG8_LDA(dst, b, h) do { _Pragma("unroll") for (int m = 0; m < 4; ++m) _Pragma("unroll") for (int k = 0; k < 2; ++k) dst[m][k] = *(const PG8_LAS bf16x8*)(lds + PG8_SA(b, h) + aoff + m * 2048 + k * 1024); } while (0)
#define PG8_LDB(dst, b, h) do { _Pragma("unroll") for (int n = 0; n < 2; ++n) _Pragma("unroll") for (int k = 0; k < 2; ++k) dst[n][k] = *(const PG8_LAS bf16x8*)(lds + PG8_SB(b, h) + boff + n * 2048 + k * 1024); } while (0)
#define PG8_MMA(ai, bj, At, Bt) do { __builtin_amdgcn_s_setprio(1); _Pragma("unroll") for (int m = 0; m < 4; ++m) _Pragma("unroll") for (int n = 0; n < 2; ++n) _Pragma("unroll") for (int k = 0; k < 2; ++k) \
        acc[ai][bj][m][n] = __builtin_amdgcn_mfma_f32_16x16x32_bf16(Bt[n][k], At[m][k], acc[ai][bj][m][n], 0, 0, 0); __builtin_amdgcn_s_setprio(0); } while (0)
#define PG8_WAIT_V(n) asm volatile("s_waitcnt vmcnt(" #n ")" ::: "memory")
#define PG8_WAIT_L(n) asm volatile("s_waitcnt lgkmcnt(" #n ")" ::: "memory")
#define PG8_BAR __builtin_amdgcn_s_barrier()
#define PG8_SCHED __builtin_amdgcn_sched_barrier(0)
    Unit cur, nxt; int ui = 0;
    if (!S.next(0, cur)) return;
    f32x4 acc[2][2][4][2];
#pragma unroll
    for (int a = 0; a < 2; ++a)
#pragma unroll
        for (int b = 0; b < 2; ++b)
#pragma unroll
            for (int m = 0; m < 4; ++m)
#pragma unroll
                for (int n = 0; n < 2; ++n) acc[a][b][m][n] = (f32x4){0.f, 0.f, 0.f, 0.f};
    bf16x8 At[4][2], B0[2][2], B1[2][2];
    const char* cA = (const char*)g.A + PG8_AROW(cur.pm) * (long)K * 2; const char* cB = (const char*)g.Bt + (size_t)cur.pn * tstep;
    S.a_ready(cur);
    if constexpr (SP2) {
        PG8_STAGE(PG8_SB(0, 0), cB, voffB); PG8_STAGE(PG8_SB(0, 1), cB + hstep, voffB); PG8_STAGE(PG8_SA(0, 0), cA, voffA); PG8_STAGE(PG8_SA(0, 1), cA + hstepA, voffA);
        if (wr == 1) PG8_BAR;
        PG8_WAIT_V(2); PG8_BAR;
        PG8_STAGE(PG8_SB(1, 0), cB + kstep, voffB); PG8_STAGE(PG8_SA(1, 0), cA + kstep, voffA); PG8_STAGE(PG8_SB(1, 1), cB + hstep + kstep, voffB);
        PG8_WAIT_V(6); PG8_BAR;
    } else {
        PG8_STAGE(PG8_SB(0, 0), cB, voffB); PG8_STAGE(PG8_SA(0, 0), cA, voffA); PG8_STAGE(PG8_SB(0, 1), cB + hstep, voffB); PG8_STAGE(PG8_SA(0, 1), cA + hstepA, voffA);
        if (wr == 1) PG8_BAR;
        PG8_WAIT_V(4); PG8_BAR;
        PG8_STAGE(PG8_SB(1, 0), cB + kstep, voffB); PG8_STAGE(PG8_SA(1, 0), cA + kstep, voffA); PG8_STAGE(PG8_SB(1, 1), cB + hstep + kstep, voffB);
        PG8_WAIT_V(6); PG8_BAR;
    }
    for (;;) {
        const bool has_next = S.next(ui + 1, nxt);
        const char* nA = has_next ? (const char*)g.A + PG8_AROW(nxt.pm) * (long)K * 2 : cA; const char* nB = has_next ? (const char*)g.Bt + (size_t)nxt.pn * tstep : cB;
        for (int t = 0; t < nt; t += 2) {
            const bool last = (t == nt - 2);
            const bool xl = XPRE && last && !has_next;
            unsigned vx0 = 0u, vx1 = 0u; const char* xb = nullptr;
            if constexpr (XPRE) { if (xl) { int t_ = threadIdx.x; asm volatile("" : "+v"(t_)); int R_, C_; stage_rc(t_ * 16, R_, C_); vx0 = (unsigned)(R_ * 1024 + C_) * 2u; stage_rc(t_ * 16 + 8192, R_, C_); vx1 = (unsigned)(R_ * 1024 + C_) * 2u;
                xb = (const char*)E.X + ((size_t)cur.pm * 256 * 1024 + (size_t)cur.pn * 256) * 2; } }
#define PG8_STAGE_X(bufoff, q) do { const char* _g = xb + ((size_t)((q) & 1) * 128 * 1024 + (size_t)((q) >> 1) * 64) * 2; \
        __builtin_amdgcn_global_load_lds((const unsigned*)(_g + vx0), (PG8_LAS unsigned*)(lds + (bufoff) + ldsw), 16, 0, 0); \
        __builtin_amdgcn_global_load_lds((const unsigned*)(_g + vx1), (PG8_LAS unsigned*)(lds + (bufoff) + ldsw + 8192), 16, 0, 0); } while (0)
            const char* a1 = cA + (size_t)(t + 1) * kstep;
            const char* a2 = last ? nA : cA + (size_t)(t + 2) * kstep; const char* b2 = last ? nB : cB + (size_t)(t + 2) * kstep;
            const char* a3 = a2 + kstep; const char* b3 = b2 + kstep;
            if (last && has_next) S.a_ready(nxt);
            if constexpr (SP2) {
            PG8_LDB(B0, 0, 0); PG8_LDB(B1, 0, 1); PG8_SCHED; PG8_LDA(At, 0, 0); PG8_STAGE(PG8_SA(1, 1), a1 + hstepA, voffA);
            PG8_WAIT_V(8); PG8_WAIT_L(0); PG8_BAR; PG8_MMA(0, 0, At, B0); PG8_MMA(0, 1, At, B1); PG8_BAR; PG8_SCHED;
            PG8_LDA(At, 0, 1); if (xl) { PG8_STAGE_X(PG8_SB(0, 0), 0); PG8_STAGE_X(PG8_SB(0, 1), 1); PG8_STAGE_X(PG8_SA(0, 0), 2); } else { PG8_STAGE(PG8_SB(0, 0), b2, voffB); PG8_STAGE(PG8_SB(0, 1), b2 + hstep, voffB); PG8_STAGE(PG8_SA(0, 0), a2, voffA); }
            PG8_WAIT_V(8); PG8_WAIT_L(0); PG8_BAR; PG8_MMA(1, 0, At, B0); PG8_MMA(1, 1, At, B1); PG8_BAR; PG8_SCHED;
            PG8_LDB(B0, 1, 0); PG8_LDB(B1, 1, 1); PG8_SCHED; PG8_LDA(At, 1, 0); if (xl) { PG8_STAGE_X(PG8_SA(0, 1), 3); } else { PG8_STAGE(PG8_SA(0, 1), a2 + hstepA, voffA); }
            PG8_WAIT_V(8); PG8_WAIT_L(0); PG8_BAR; PG8_MMA(0, 0, At, B0); PG8_MMA(0, 1, At, B1); PG8_BAR; PG8_SCHED;
            PG8_LDA(At, 1, 1); if (xl) { PG8_STAGE_X(PG8_SB(1, 0), 4); PG8_STAGE_X(PG8_SB(1, 1), 5); PG8_STAGE_X(PG8_SA(1, 0), 6); } else { PG8_STAGE(PG8_SB(1, 0), b3, voffB); PG8_STAGE(PG8_SB(1, 1), b3 + hstep, voffB); PG8_STAGE(PG8_SA(1, 0), a3, voffA); }
            PG8_WAIT_V(8); PG8_WAIT_L(0); PG8_BAR; PG8_MMA(1, 0, At, B0); PG8_MMA(1, 1, At, B1); PG8_BAR; PG8_SCHED;
            } else {
            PG8_LDB(B0, 0, 0); PG8_SCHED; PG8_LDA(At, 0, 0); PG8_STAGE(PG8_SA(1, 1), a1 + hstepA, voffA);
            PG8_WAIT_L(8); PG8_BAR; PG8_WAIT_L(0); PG8_MMA(0, 0, At, B0); PG8_BAR; PG8_SCHED;
            PG8_LDB(B1, 0, 1); PG8_STAGE(PG8_SB(0, 0), b2, voffB);
            PG8_BAR; PG8_WAIT_L(0); PG8_MMA(0, 1, At, B1); PG8_BAR;
            PG8_LDA(At, 0, 1); PG8_STAGE(PG8_SA(0, 0), a2, voffA);
            PG8_BAR; PG8_WAIT_L(0); PG8_MMA(1, 0, At, B0); PG8_BAR; PG8_SCHED;
            PG8_STAGE(PG8_SB(0, 1), b2 + hstep, voffB);
            PG8_WAIT_V(6); PG8_BAR; PG8_MMA(1, 1, At, B1); PG8_BAR;
            PG8_LDB(B0, 1, 0); PG8_SCHED; PG8_LDA(At, 1, 0); PG8_STAGE(PG8_SA(0, 1), a2 + hstepA, voffA);
            PG8_WAIT_L(8); PG8_BAR; PG8_WAIT_L(0); PG8_MMA(0, 0, At, B0); PG8_BAR; PG8_SCHED;
            PG8_LDB(B1, 1, 1); PG8_STAGE(PG8_SB(1, 0), b3, voffB);
            PG8_BAR; PG8_WAIT_L(0); PG8_MMA(0, 1, At, B1); PG8_BAR;
            PG8_LDA(At, 1, 1); PG8_STAGE(PG8_SA(1, 0), a3, voffA);
            PG8_BAR; PG8_WAIT_L(0); PG8_MMA(1, 0, At, B0); PG8_BAR; PG8_SCHED;
            PG8_STAGE(PG8_SB(1, 1), b3 + hstep, voffB);
            PG8_WAIT_V(6); PG8_BAR; PG8_MMA(1, 1, At, B1); PG8_BAR;
            }
        }
        if constexpr (ALIGN_EPI) { if (wr == 0) PG8_BAR; }
        if constexpr (!Epi::AFTER_DRAIN) { E(acc, cur, wr, wc, fr, fq); S.done(cur); }
        if (!has_next) break;
#pragma unroll
        for (int a = 0; a < 2; ++a)
#pragma unroll
            for (int b = 0; b < 2; ++b)
#pragma unroll
                for (int m = 0; m < 4; ++m)
#pragma unroll
                    for (int n = 0; n < 2; ++n) acc[a][b][m][n] = (f32x4){0.f, 0.f, 0.f, 0.f};
        cur = nxt; cA = nA; cB = nB; ++ui;
        if constexpr (ALIGN_EPI) { if (wr == 1) PG8_BAR; }
    }
    PG8_WAIT_V(0);
    if constexpr (!ALIGN_EPI) { if (wr == 0) PG8_BAR; }
    PG8_BAR;
    if constexpr (Epi::AFTER_DRAIN) { E.fused(acc, cur, wr, wc, fr, fq, lds, wid, lane); S.done(cur); }
#undef PG8_AROW
#undef PG8_STAGE_X
#undef PG8_SA
#undef PG8_SB
#undef PG8_STAGE
#undef PG8_LDA
#undef PG8_LDB
#undef PG8_MMA
#undef PG8_WAIT_V
#undef PG8_WAIT_L
#undef PG8_BAR
#undef PG8_SCHED
}
}

#define GAS __attribute__((address_space(1)))
#define LAS __attribute__((address_space(3)))
typedef unsigned short bf16;
typedef float f32x4 __attribute__((ext_vector_type(4)));
typedef float f32x2 __attribute__((ext_vector_type(2)));
typedef float f32x16 __attribute__((ext_vector_type(16)));
typedef short bf16x8 __attribute__((ext_vector_type(8)));
typedef unsigned u32x4 __attribute__((ext_vector_type(4)));
typedef unsigned u32x2 __attribute__((ext_vector_type(2)));

constexpr int DM = 1024, SEQ = 8192, NBATCH = 2, MP = NBATCH * SEQ, NS = 128, DEPTH = 4;
constexpr int DIN = 2048, DFF = 2816, DUP = 5632, DLRU = 256;
constexpr float EPS = 1e-6f;
constexpr int NWAVES = 8, NTHREADS = 512;
constexpr int LDS_BYTES = 147456;
constexpr int ZQ = 0, ZK = 512, ZV = 640, ZLX = 768, ZLG = 1024, ZSB = 1280, ZSC = 1536, ZSU = 1792;
constexpr size_t O_Y = 0, O_YS = 16777216, O_CKP = 16908288, O_CVP = 17039360, O_RGP = 17170432, O_LCP = 17172480, O_SCP = 17178624,
                 O_FFP = 17182720, O_CKS = 17272832, O_CVS = 25661440, O_RGS = 34050048, O_LCS = 34181120, O_SCS = 34574336, O_FFS = 34836480;
constexpr size_t MiB = 1u << 20;
constexpr size_t WS_LWT = 1 * MiB;
constexpr size_t WS_W = 2 * MiB, W_LAYER = 23592960;
constexpr size_t W_IN = 0, W_OUT = 4 * MiB, W_UP = 6 * MiB, W_DOWN = 17 * MiB;
constexpr size_t WS_XS = 92 * MiB;
constexpr size_t WS_ZS = WS_XS + 512 * 1024;
constexpr size_t WS_MGS = WS_ZS + 512 * 1024;
constexpr size_t WS_ACTS = WS_MGS + 256 * 1024;
constexpr size_t WS_XSB = WS_ACTS + 768 * 1024;
constexpr size_t WS_AGGA = 95 * MiB, WS_AGGB = 95 * MiB + 512 * 1024;
constexpr size_t WS_Z = 96 * MiB;
constexpr size_t WS_MG = 160 * MiB;
constexpr size_t WS_HLOC = 192 * MiB, WS_CUMA = 208 * MiB;
constexpr size_t WS_XN = 192 * MiB;
constexpr size_t WS_ACT = 226 * MiB;
constexpr size_t WS_SSQA = 94 * MiB + 256 * 1024 + 4096, WS_SSQB = 94 * MiB + 640 * 1024 + 4096;
constexpr size_t WS_X = 316 * MiB + 64 * 1024;
constexpr size_t WS_END = 349 * MiB;

__device__ __forceinline__ float bf2f(unsigned v) { return __uint_as_float(v << 16); }
__device__ __forceinline__ unsigned f2bf(float f) { unsigned u = __float_as_uint(f); return (u + 0x7fffu + ((u >> 16) & 1u)) >> 16; }
__device__ __forceinline__ unsigned pk2(float lo, float hi) { unsigned r; asm volatile("v_cvt_pk_bf16_f32 %0, %1, %2" : "=v"(r) : "v"(lo), "v"(hi)); return r; }
__device__ __forceinline__ float wave_sum(float v) {
#pragma unroll
    for (int o = 1; o < 64; o <<= 1) v += __shfl_xor(v, o);
    return v;
}
__device__ __forceinline__ float wave_max(float v) {
#pragma unroll
    for (int o = 1; o < 64; o <<= 1) v = fmaxf(v, __shfl_xor(v, o));
    return v;
}
__device__ __forceinline__ float sigmoidf_(float x) { return __builtin_amdgcn_rcpf(1.0f + __builtin_amdgcn_exp2f(-1.4426950408889634f * x)); }
__device__ __forceinline__ float gelu_tanh(float x) { const float u = 0.7978845608028654f * (x + 0.044715f * x * x * x); return x * __builtin_amdgcn_rcpf(1.0f + __builtin_amdgcn_exp2f(-2.8853900817779268f * u)); }
__device__ __forceinline__ f32x4 ld_bf4(const bf16* p) { const u32x2 w = *(const u32x2*)p; return (f32x4){bf2f(w.x & 0xffffu), bf2f(w.x >> 16), bf2f(w.y & 0xffffu), bf2f(w.y >> 16)}; }
__device__ __forceinline__ void st_bf4(bf16* p, f32x4 v) { u32x2 w; w.x = pk2(v.x, v.y); w.y = pk2(v.z, v.w); *(u32x2*)p = w; }

struct Args { const float* in[26]; float* out; unsigned char* ws; };

struct EpiZ {
    static constexpr bool PERM = true, AFTER_DRAIN = false;
    bf16* O; const float* ssq;
    __device__ __forceinline__ void operator()(const pg8::f32x4 (&acc)[2][2][4][2], const pg8::Unit& u, int wr, int wc, int fr, int fq) const {
        const int row0 = u.pm * 256 + wr * 64 + fr, col0 = u.pn * 256 + wc * 32 + 8 * fq;
#pragma unroll
        for (int ai = 0; ai < 2; ++ai)
#pragma unroll
            for (int m = 0; m < 4; ++m) {
                const int row = row0 + ai * 128 + m * 16;
                const f32x4 sq = *(const f32x4*)(ssq + 4 * (size_t)row);
                const float rs = __builtin_amdgcn_rsqf(((sq.x + sq.y) + (sq.z + sq.w)) * (1.0f / DM) + EPS);
                bf16* rowp = O + (size_t)row * DIN + col0;
#pragma unroll
                for (int bj = 0; bj < 2; ++bj) {
                    const f32x4 v0 = acc[ai][bj][m][0] * rs, v1 = acc[ai][bj][m][1] * rs;
                    u32x4 w; w.x = pk2(v0[0], v0[1]); w.y = pk2(v0[2], v0[3]); w.z = pk2(v1[0], v1[1]); w.w = pk2(v1[2], v1[3]);
                    *(u32x4*)(rowp + bj * 128) = w;
                }
            }
    }
};
struct EpiRes {
    static constexpr bool PERM = true, AFTER_DRAIN = false;
    bf16* X; float* ssq_out; LAS float* P;
    LAS unsigned char* ring; bool xpre;
    __device__ __forceinline__ void operator()(const pg8::f32x4 (&acc)[2][2][4][2], const pg8::Unit& u, int wr, int wc, int fr, int fq) const {
        const int row0 = u.pm * 256 + wr * 64 + fr, col0 = u.pn * 256 + wc * 32 + 8 * fq;
        if (xpre) { asm volatile("s_waitcnt vmcnt(0)" ::: "memory"); __builtin_amdgcn_s_barrier(); asm volatile("" ::: "memory"); }
#pragma unroll
        for (int ai = 0; ai < 2; ++ai) {
            u32x4 xin[4][2];
#pragma unroll
            for (int m = 0; m < 4; ++m)
#pragma unroll
                for (int bj = 0; bj < 2; ++bj) {
                    const int q = 2 * (2 * bj + (wc >> 1)) + ai;
                    if (xpre && q < 7) {
                        const int boff = (q == 0 ? 4 : q == 1 ? 5 : q == 2 ? 0 : q == 3 ? 1 : q == 4 ? 6 : q == 5 ? 7 : 2) * 16384;
                        xin[m][bj] = *(const LAS u32x4*)(ring + boff + pg8::lds_byte(wr * 64 + m * 16 + fr, (wc & 1) * 32 + 8 * fq));
                    } else xin[m][bj] = *(const u32x4*)(X + (size_t)(row0 + ai * 128 + m * 16) * DM + col0 + bj * 128);
                }
#pragma unroll
            for (int m = 0; m < 4; ++m) {
                const int row = row0 + ai * 128 + m * 16;
                float q = 0.f;
#pragma unroll
                for (int bj = 0; bj < 2; ++bj) {
                    const u32x4 xi = xin[m][bj];
                    const f32x4 a0 = acc[ai][bj][m][0], a1 = acc[ai][bj][m][1];
                    const float y0 = bf2f(xi.x & 0xffffu) + a0[0], y1 = bf2f(xi.x >> 16) + a0[1], y2 = bf2f(xi.y & 0xffffu) + a0[2], y3 = bf2f(xi.y >> 16) + a0[3];
                    const float y4 = bf2f(xi.z & 0xffffu) + a1[0], y5 = bf2f(xi.z >> 16) + a1[1], y6 = bf2f(xi.w & 0xffffu) + a1[2], y7 = bf2f(xi.w >> 16) + a1[3];
                    q += (y0 * y0 + y1 * y1) + (y2 * y2 + y3 * y3) + (y4 * y4 + y5 * y5) + (y6 * y6 + y7 * y7);
                    u32x4 w; w.x = pk2(y0, y1); w.y = pk2(y2, y3); w.z = pk2(y4, y5); w.w = pk2(y6, y7);
                    *(u32x4*)(X + (size_t)row * DM + col0 + bj * 128) = w;
                }
                q += __shfl_xor(q, 16); q += __shfl_xor(q, 32);
                if (fq == 0) P[(ai * 128 + wr * 64 + m * 16 + fr) * 4 + wc] = q;
            }
        }
        asm volatile("s_waitcnt lgkmcnt(0)" ::: "memory"); __builtin_amdgcn_s_barrier(); asm volatile("" ::: "memory");
        const int t = (wr * 4 + wc) * 64 + fq * 16 + fr;
        if (t < 256) { const f32x4 v = *(const LAS f32x4*)(P + 4 * t); ssq_out[(size_t)(u.pm * 256 + t) * 4 + u.pn] = (v.x + v.y) + (v.z + v.w); }
    }
};
struct EpiFfn {
    static constexpr bool PERM = true, AFTER_DRAIN = false;
    bf16* act; const float* cw; float* st_out; const float* ssq;
    __device__ __forceinline__ void operator()(const pg8::f32x4 (&acc)[2][2][4][2], const pg8::Unit& u, int wr, int wc, int fr, int fq) const {
        const int bb = u.pm / 33, tt = u.pm % 33;
        const int t0 = tt * 252 + wr * 126 - 2 + 8 * fr;
        float rs[8];
#pragma unroll
        for (int j = 0; j < 8; ++j) { const f32x4 sq = *(const f32x4*)(ssq + 4 * (long)(bb * SEQ + t0 + j)); rs[j] = __builtin_amdgcn_rsqf(((sq.x + sq.y) + (sq.z + sq.w)) * (1.0f / DM) + EPS); }
#define DPP_SHR1(x) __builtin_bit_cast(float, __builtin_amdgcn_update_dpp(0, __builtin_bit_cast(int, (float)(x)), 0x111, 0xf, 0xf, true))
        const float rs6p = DPP_SHR1(rs[6]), rs7p = DPP_SHR1(rs[7]);
        const bool kill = (tt == 0) && (wr == 0) && (fr == 0);
        const int cu = u.pn * 128 + wc * 32 + 8 * fq;
        u32x4 outw[8];
#pragma unroll
        for (int n = 0; n < 2; ++n) {
            const int cn = cu + 4 * n;
            const f32x4 w0u = *(const f32x4*)(cw + cn), w1u = *(const f32x4*)(cw + DUP + cn), w2u = *(const f32x4*)(cw + 2 * DUP + cn);
            const f32x4 w0g = *(const f32x4*)(cw + DFF + cn), w1g = *(const f32x4*)(cw + DUP + DFF + cn), w2g = *(const f32x4*)(cw + 2 * DUP + DFF + cn);
            f32x4 pu6, pu7, pg6, pg7;
#pragma unroll
            for (int e = 0; e < 4; ++e) {
                pu6[e] = DPP_SHR1(acc[1][0][2][n][e]) * rs6p; pu7[e] = DPP_SHR1(acc[1][0][3][n][e]) * rs7p;
                pg6[e] = DPP_SHR1(acc[1][1][2][n][e]) * rs6p; pg7[e] = DPP_SHR1(acc[1][1][3][n][e]) * rs7p;
            }
            typedef float f2 __attribute__((ext_vector_type(2)));
            const f2 w0ua = w0u.xy, w0ub = w0u.zw, w1ua = w1u.xy, w1ub = w1u.zw, w2ua = w2u.xy, w2ub = w2u.zw;
            const f2 w0ga = w0g.xy, w0gb = w0g.zw, w1ga = w1g.xy, w1gb = w1g.zw, w2ga = w2g.xy, w2gb = w2g.zw;
            f2 um2a = pu6.xy, um2b = pu6.zw, um1a = pu7.xy, um1b = pu7.zw, gm2a = pg6.xy, gm2b = pg6.zw, gm1a = pg7.xy, gm1b = pg7.zw;
#pragma unroll
            for (int j = 0; j < 8; ++j) {
                const f32x4 au = acc[j >> 2][0][j & 3][n], ag = acc[j >> 2][1][j & 3][n];
                const f2 rsv = (f2){rs[j], rs[j]};
                f2 Ua = au.xy * rsv, Ub = au.zw * rsv, Ga = ag.xy * rsv, Gb = ag.zw * rsv;
                const int t = t0 + j;
                if (j < 2) { const f2 z = (f2){0.f, 0.f}; Ua = kill ? z : Ua; Ub = kill ? z : Ub; Ga = kill ? z : Ga; Gb = kill ? z : Gb; }
                const f2 uca = __builtin_elementwise_fma(w0ua, um2a, __builtin_elementwise_fma(w1ua, um1a, w2ua * Ua));
                const f2 ucb = __builtin_elementwise_fma(w0ub, um2b, __builtin_elementwise_fma(w1ub, um1b, w2ub * Ub));
                const f2 gca = __builtin_elementwise_fma(w0ga, gm2a, __builtin_elementwise_fma(w1ga, gm1a, w2ga * Ga));
                const f2 gcb = __builtin_elementwise_fma(w0gb, gm2b, __builtin_elementwise_fma(w1gb, gm1b, w2gb * Gb));
                const f2 nl = (f2){-1.4426950408889634f, -1.4426950408889634f}, one = (f2){1.f, 1.f};
                const f2 xa = gca * nl, xb = gcb * nl;
                f2 ea, eb; ea.x = __builtin_amdgcn_exp2f(xa.x); ea.y = __builtin_amdgcn_exp2f(xa.y); eb.x = __builtin_amdgcn_exp2f(xb.x); eb.y = __builtin_amdgcn_exp2f(xb.y);
                const f2 da = ea + one, db = eb + one;
                f2 ra, rb; ra.x = __builtin_amdgcn_rcpf(da.x); ra.y = __builtin_amdgcn_rcpf(da.y); rb.x = __builtin_amdgcn_rcpf(db.x); rb.y = __builtin_amdgcn_rcpf(db.y);
                const f2 oa = (uca * gca) * ra, ob = (ucb * gcb) * rb;
                if (n == 0) { outw[j].x = pk2(oa.x, oa.y); outw[j].y = pk2(ob.x, ob.y); } else { outw[j].z = pk2(oa.x, oa.y); outw[j].w = pk2(ob.x, ob.y); }
                if (t >= SEQ - 2 && t < SEQ && (8 * fr + j >= 2)) {
                    float* so = st_out + (size_t)(bb * 2 + (t - (SEQ - 2))) * DUP + cn;
                    *(f32x4*)so = (f32x4){Ua.x, Ua.y, Ub.x, Ub.y}; *(f32x4*)(so + DFF) = (f32x4){Ga.x, Ga.y, Gb.x, Gb.y};
                }
                um2a = um1a; um2b = um1b; um1a = Ua; um1b = Ub; gm2a = gm1a; gm2b = gm1b; gm1a = Ga; gm1b = Gb;
            }
        }
#pragma unroll
        for (int j = 0; j < 8; ++j) {
            const int t = t0 + j;
            if ((8 * fr + j >= 2) && (t < SEQ)) *(u32x4*)(act + (size_t)(bb * SEQ + t) * DFF + cu) = outw[j];
        }
    }
};

constexpr int SG_PITCH = 2832;
template <int MODE>
__device__ __forceinline__ void small_gemm_unit(LAS unsigned char* lds, int j, const bf16* Ap, const bf16* Bt, int K,
                                                bf16* obf, int ldo, const float* base, float* outf,
                                                const float* cw, const float* fbuf, float* fst) {
    int tid_o = threadIdx.x; asm volatile("" : "+v"(tid_o)); const int tid = tid_o, w = tid >> 6, lane = tid & 63, fr = lane & 15, fq = lane >> 4;
    const int row = 16 * w + fr;
    int bn0, bn1;
    if (MODE == 2) { bn0 = 256 * ((16 * j) / 128) + ((16 * j) % 128); bn1 = bn0 + 128; } else { bn0 = 32 * j; bn1 = bn0 + 16; }
    pg8::f32x4 acc0 = {0.f, 0.f, 0.f, 0.f}, acc1 = {0.f, 0.f, 0.f, 0.f};
    float ssq = 0.f;
    const bf16* ap = Ap + (size_t)row * K + 8 * fq;
    const int KC = (K > 1024) ? 1408 : 1024;
    for (int kc = 0; kc < K; kc += KC) {
        const int kl = (K - kc) < KC ? (K - kc) : KC, parts = kl >> 3;
        u32x4 af[16];
#pragma unroll
        for (int i = 0; i < 16; ++i) af[i] = *(const u32x4*)(ap + kc + 32 * i);
        __syncthreads();
        {
            u32x4 sg[11];
#pragma unroll
            for (int i = 0; i < 11; ++i) {
                const int c = tid + NTHREADS * i;
                if (c < 32 * parts) { const int r = c / parts, p = c - r * parts; sg[i] = *(const u32x4*)(Bt + (size_t)((r < 16 ? bn0 + r : bn1 + r - 16)) * K + kc + 8 * p); }
            }
#pragma unroll
            for (int i = 0; i < 11; ++i) {
                const int c = tid + NTHREADS * i;
                if (c < 32 * parts) { const int r = c / parts, p = c - r * parts; *(LAS u32x4*)(lds + r * SG_PITCH + 16 * p) = sg[i]; }
            }
        }
        __syncthreads();
        const LAS unsigned char* b0p = lds + fr * SG_PITCH + 16 * fq;
        const LAS unsigned char* b1p = lds + (16 + fr) * SG_PITCH + 16 * fq;
        for (int g0 = 0; g0 < kl; g0 += 512) {
            const int nst = (kl - g0) < 512 ? ((kl - g0) >> 5) : 16;
            if (g0 > 0) {
#pragma unroll
                for (int i = 0; i < 16; ++i) if (i < nst) af[i] = *(const u32x4*)(ap + kc + g0 + 32 * i);
            }
#pragma unroll
            for (int i = 0; i < 16; ++i) {
                if (i < nst) {
                    const u32x4 au = af[i];
                    if (MODE != 1) {
                        const float x0 = bf2f(au.x & 0xffffu), x1 = bf2f(au.x >> 16), x2 = bf2f(au.y & 0xffffu), x3 = bf2f(au.y >> 16);
                        const float x4 = bf2f(au.z & 0xffffu), x5 = bf2f(au.z >> 16), x6 = bf2f(au.w & 0xffffu), x7 = bf2f(au.w >> 16);
                        ssq += (x0 * x0 + x1 * x1) + (x2 * x2 + x3 * x3) + (x4 * x4 + x5 * x5) + (x6 * x6 + x7 * x7);
                    }
                    const bf16x8 a = __builtin_bit_cast(bf16x8, au);
                    const int k0 = g0 + 32 * i;
                    const bf16x8 b0 = *(const LAS bf16x8*)(b0p + 2 * k0), b1 = *(const LAS bf16x8*)(b1p + 2 * k0);
                    acc0 = __builtin_amdgcn_mfma_f32_16x16x32_bf16(b0, a, acc0, 0, 0, 0);
                    acc1 = __builtin_amdgcn_mfma_f32_16x16x32_bf16(b1, a, acc1, 0, 0, 0);
                }
            }
        }
    }
    if (MODE != 1) { ssq += __shfl_xor(ssq, 16); ssq += __shfl_xor(ssq, 32); }
    if (MODE == 0) {
        const float rs = rsqrtf(ssq * (1.0f / DM) + EPS);
        bf16* o = obf + (size_t)row * ldo + 32 * j + 4 * fq;
        st_bf4(o, acc0 * rs); st_bf4(o + 16, acc1 * rs);
    } else if (MODE == 1) {
        const size_t off = (size_t)row * DM + 32 * j + 4 * fq;
        const f32x4 r0 = *(const f32x4*)(base + off) + acc0, r1 = *(const f32x4*)(base + off + 16) + acc1;
        *(f32x4*)(outf + off) = r0; *(f32x4*)(outf + off + 16) = r1;
        st_bf4(obf + off, r0); st_bf4(obf + off + 16, r1);
    } else {
        const float rs = rsqrtf(ssq * (1.0f / DM) + EPS);
        const int cu = 16 * j + 4 * fq;
        const f32x4 U = acc0 * rs, G = acc1 * rs;
        const float* b0r = fbuf + (size_t)(row * 2 + 0) * DUP + cu; const float* b1r = fbuf + (size_t)(row * 2 + 1) * DUP + cu;
        const f32x4 u0 = *(const f32x4*)b0r, u1 = *(const f32x4*)b1r, g0 = *(const f32x4*)(b0r + DFF), g1 = *(const f32x4*)(b1r + DFF);
        const f32x4 uc = *(const f32x4*)(cw + cu) * u0 + *(const f32x4*)(cw + DUP + cu) * u1 + *(const f32x4*)(cw + 2 * DUP + cu) * U;
        const f32x4 gc = *(const f32x4*)(cw + DFF + cu) * g0 + *(const f32x4*)(cw + DUP + DFF + cu) * g1 + *(const f32x4*)(cw + 2 * DUP + DFF + cu) * G;
        f32x4 a;
#pragma unroll
        for (int e = 0; e < 4; ++e) a[e] = uc[e] * gc[e] / (1.0f + __expf(-gc[e]));
        st_bf4(obf + (size_t)row * DFF + cu, a);
        float* s0 = fst + (size_t)(row * 2 + 0) * DUP + cu; float* s1 = fst + (size_t)(row * 2 + 1) * DUP + cu;
        *(f32x4*)s0 = u1; *(f32x4*)(s0 + DFF) = g1; *(f32x4*)s1 = U; *(f32x4*)(s1 + DFF) = G;
    }
    __syncthreads();
}

constexpr int SF_PITCH = 1040;
__device__ __forceinline__ void small_ffn_unit(LAS unsigned char* lds, int j3, const bf16* __restrict__ Ap, const bf16* __restrict__ Bt, bf16* __restrict__ obf,
                                               const float* __restrict__ cw, const float* __restrict__ fbuf, float* __restrict__ fst) {
    int tid_o = threadIdx.x; asm volatile("" : "+v"(tid_o)); const int tid = tid_o, w = tid >> 6, lane = tid & 63, fr = lane & 15, fq = lane >> 4;
    const int row = 16 * w + fr, bl0 = 3 * j3, nb = (176 - bl0) < 3 ? (176 - bl0) : 3, K = DM;
    pg8::f32x4 acc[3][2];
#pragma unroll
    for (int b = 0; b < 3; ++b) { acc[b][0] = (pg8::f32x4){0.f, 0.f, 0.f, 0.f}; acc[b][1] = acc[b][0]; }
    float ssq = 0.f;
    const bf16* ap = Ap + (size_t)row * K + 8 * fq;
    for (int kc = 0; kc < K; kc += 512) {
        u32x4 af[16];
#pragma unroll
        for (int i = 0; i < 16; ++i) af[i] = *(const u32x4*)(ap + kc + 32 * i);
        __syncthreads();
        {
            u32x4 sg[12];
#pragma unroll
            for (int i = 0; i < 12; ++i) {
                const int c = tid + NTHREADS * i, r = c >> 6, p = c & 63, b = r >> 5, rr = r & 31;
                if (b < nb) { const int bl = bl0 + b, bn0 = 256 * ((16 * bl) / 128) + ((16 * bl) % 128); sg[i] = *(const u32x4*)(Bt + (size_t)(rr < 16 ? bn0 + rr : bn0 + 128 + rr - 16) * K + kc + 8 * p); }
            }
#pragma unroll
            for (int i = 0; i < 12; ++i) {
                const int c = tid + NTHREADS * i, r = c >> 6, p = c & 63, b = r >> 5;
                if (b < nb) *(LAS u32x4*)(lds + r * SF_PITCH + 16 * p) = sg[i];
            }
        }
        __syncthreads();
#pragma unroll
        for (int i = 0; i < 16; ++i) {
            const u32x4 au = af[i];
            const float x0 = bf2f(au.x & 0xffffu), x1 = bf2f(au.x >> 16), x2 = bf2f(au.y & 0xffffu), x3 = bf2f(au.y >> 16);
            const float x4 = bf2f(au.z & 0xffffu), x5 = bf2f(au.z >> 16), x6 = bf2f(au.w & 0xffffu), x7 = bf2f(au.w >> 16);
            ssq += (x0 * x0 + x1 * x1) + (x2 * x2 + x3 * x3) + (x4 * x4 + x5 * x5) + (x6 * x6 + x7 * x7);
            const bf16x8 a = __builtin_bit_cast(bf16x8, au);
#pragma unroll
            for (int b = 0; b < 3; ++b) {
                if (b < nb) {
                    const bf16x8 b0 = *(const LAS bf16x8*)(lds + (32 * b + fr) * SF_PITCH + 16 * fq + 64 * i), b1 = *(const LAS bf16x8*)(lds + (32 * b + 16 + fr) * SF_PITCH + 16 * fq + 64 * i);
                    acc[b][0] = __builtin_amdgcn_mfma_f32_16x16x32_bf16(b0, a, acc[b][0], 0, 0, 0);
                    acc[b][1] = __builtin_amdgcn_mfma_f32_16x16x32_bf16(b1, a, acc[b][1], 0, 0, 0);
                }
            }
        }
    }
    ssq += __shfl_xor(ssq, 16); ssq += __shfl_xor(ssq, 32);
    const float rs = rsqrtf(ssq * (1.0f / DM) + EPS);
#pragma unroll
    for (int b = 0; b < 3; ++b) {
        if (b < nb) {
            const int cu = 16 * (bl0 + b) + 4 * fq;
            const f32x4 U = acc[b][0] * rs, G = acc[b][1] * rs;
            const float* b0r = fbuf + (size_t)(row * 2 + 0) * DUP + cu; const float* b1r = fbuf + (size_t)(row * 2 + 1) * DUP + cu;
            const f32x4 u0 = *(const f32x4*)b0r, u1 = *(const f32x4*)b1r, g0 = *(const f32x4*)(b0r + DFF), g1 = *(const f32x4*)(b1r + DFF);
            const f32x4 uc = *(const f32x4*)(cw + cu) * u0 + *(const f32x4*)(cw + DUP + cu) * u1 + *(const f32x4*)(cw + 2 * DUP + cu) * U;
            const f32x4 gc = *(const f32x4*)(cw + DFF + cu) * g0 + *(const f32x4*)(cw + DUP + DFF + cu) * g1 + *(const f32x4*)(cw + 2 * DUP + DFF + cu) * G;
            f32x4 a;
#pragma unroll
            for (int e = 0; e < 4; ++e) a[e] = uc[e] * gc[e] * __builtin_amdgcn_rcpf(1.0f + __builtin_amdgcn_exp2f(-1.4426950408889634f * gc[e]));
            st_bf4(obf + (size_t)row * DFF + cu, a);
            float* s0 = fst + (size_t)(row * 2 + 0) * DUP + cu; float* s1 = fst + (size_t)(row * 2 + 1) * DUP + cu;
            *(f32x4*)s0 = u1; *(f32x4*)(s0 + DFF) = g1; *(f32x4*)s1 = U; *(f32x4*)(s1 + DFF) = G;
        }
    }
    __syncthreads();
}

__device__ __forceinline__ void transpose_item(const float* __restrict__ W, int K, int N, bf16* __restrict__ WT, int upmap, LAS float* scr, int item, int lane, const float* __restrict__ gain) {
    const int nblk = N / 64, kb = item / nblk, nb = item % nblk, k0 = 64 * kb, n0 = 64 * nb;
    float v[64];
#pragma unroll
    for (int i = 0; i < 64; ++i) v[i] = __builtin_nontemporal_load(W + (size_t)(k0 + i) * N + n0 + lane);
    if (gain) {
#pragma unroll
        for (int i = 0; i < 64; ++i) v[i] *= gain[k0 + i];
    }
#pragma unroll
    for (int i = 0; i < 64; ++i) scr[i * 65 + lane] = v[i];
    asm volatile("s_waitcnt lgkmcnt(0)" ::: "memory");
    int r0 = n0;
    if (upmap) { r0 = (n0 < DFF) ? (256 * (n0 / 128) + (n0 % 128)) : (256 * ((n0 - DFF) / 128) + 128 + ((n0 - DFF) % 128)); }
    const int c = lane & 7;
#pragma unroll
    for (int j = 0; j < 8; ++j) { const int n = (lane >> 3) + 8 * j; const LAS float* s = scr + (8 * c) * 65 + n;
        u32x4 o; o.x = pk2(s[0 * 65], s[1 * 65]); o.y = pk2(s[2 * 65], s[3 * 65]); o.z = pk2(s[4 * 65], s[5 * 65]); o.w = pk2(s[6 * 65], s[7 * 65]);
        *(u32x4*)(WT + (size_t)(r0 + n) * K + k0 + 8 * c) = o; }
    asm volatile("s_waitcnt lgkmcnt(0)" ::: "memory");
}
__device__ __forceinline__ void rms_row_bf16(const float* xrow, bf16* orow, int lane) {
    f32x4 v[4]; float s = 0.f;
#pragma unroll
    for (int j = 0; j < 4; ++j) { v[j] = *(const f32x4*)(xrow + 4 * lane + 256 * j); s += (v[j].x * v[j].x + v[j].y * v[j].y) + (v[j].z * v[j].z + v[j].w * v[j].w); }
    const float rs = rsqrtf(wave_sum(s) * (1.0f / DM) + EPS);
#pragma unroll
    for (int j = 0; j < 4; ++j) st_bf4(orow + 4 * lane + 256 * j, v[j] * rs);
}
__device__ __forceinline__ void init_row(const float* xrow, bf16* orow, float* ssq, int lane) {
    f32x4 v[4]; float s = 0.f;
#pragma unroll
    for (int j = 0; j < 4; ++j) { v[j] = *(const f32x4*)(xrow + 4 * lane + 256 * j); s += (v[j].x * v[j].x + v[j].y * v[j].y) + (v[j].z * v[j].z + v[j].w * v[j].w); }
    s = wave_sum(s);
#pragma unroll
    for (int j = 0; j < 4; ++j) st_bf4(orow + 4 * lane + 256 * j, v[j]);
    if (lane == 0) *(f32x4*)ssq = (f32x4){s, 0.f, 0.f, 0.f};
}
__device__ __forceinline__ void final_row(const bf16* xrow, float ssq, const float* g, float* orow, int lane) {
    const float rs = rsqrtf(ssq * (1.0f / DM) + EPS);
#pragma unroll
    for (int j = 0; j < 4; ++j) { const f32x4 v = ld_bf4(xrow + 4 * lane + 256 * j); const f32x4 gg = *(const f32x4*)(g + 4 * lane + 256 * j); *(f32x4*)(orow + 4 * lane + 256 * j) = v * gg * rs; }
}
__device__ __forceinline__ void rms_row_f32(const float* xrow, const float* g, float* orow, int lane) {
    f32x4 v[4]; float s = 0.f;
#pragma unroll
    for (int j = 0; j < 4; ++j) { v[j] = *(const f32x4*)(xrow + 4 * lane + 256 * j); s += (v[j].x * v[j].x + v[j].y * v[j].y) + (v[j].z * v[j].z + v[j].w * v[j].w); }
    const float rs = rsqrtf(wave_sum(s) * (1.0f / DM) + EPS);
#pragma unroll
    for (int j = 0; j < 4; ++j) { const f32x4 gg = *(const f32x4*)(g + 4 * lane + 256 * j); *(f32x4*)(orow + 4 * lane + 256 * j) = v[j] * gg * rs; }
}

__device__ __forceinline__ void attn_prompt_unit(LAS unsigned char* lds, int b, int t0, const bf16* Z, bf16* MG, const float* sinks, const float* gout,
                                                 float* ck_out, float* cv_out) {
    int tid_o = threadIdx.x; asm volatile("" : "+v"(tid_o)); const int tid = tid_o, h = __builtin_amdgcn_readfirstlane(tid >> 6), lane = tid & 63, qi = lane & 31, hi = lane >> 5, g = h >> 2;
    LAS bf16* Ks = (LAS bf16*)lds;
    LAS bf16* Vt = (LAS bf16*)(lds + 55296);
    LAS float* SS = (LAS float*)(lds + 55296 + 51200);
    const bool wr_cache = (t0 >= SEQ - 128);
    bf16x8 qf[2][4];
#pragma unroll
    for (int sub = 0; sub < 2; ++sub) {
        const bf16* qp = Z + (size_t)(b * SEQ + t0 + 32 * sub + qi) * DIN + ZQ + 64 * h + 8 * hi;
#pragma unroll
        for (int st = 0; st < 4; ++st) qf[sub][st] = *(const bf16x8*)(qp + 16 * st);
    }
    {
        u32x4 kvr[6], vvr[6];
#pragma unroll
        for (int i = 0; i < 6; ++i) {
            const int c = tid + NTHREADS * i, row = c >> 4, part = c & 15, gg = part >> 3, d8 = part & 7, tok = t0 - 128 + row;
            kvr[i] = (u32x4){0u, 0u, 0u, 0u}; vvr[i] = (u32x4){0u, 0u, 0u, 0u};
            if (tok >= 0) { const bf16* zr = Z + (size_t)(b * SEQ + tok) * DIN + gg * 64 + d8 * 8; kvr[i] = *(const u32x4*)(zr + ZK); vvr[i] = *(const u32x4*)(zr + ZV); }
        }
#pragma unroll
        for (int i = 0; i < 6; ++i) {
            const int c = tid + NTHREADS * i, row = c >> 4, part = c & 15, gg = part >> 3, d8 = part & 7, tok = t0 - 128 + row;
            const u32x4 kv = kvr[i], vv = vvr[i];
            *(LAS u32x4*)(Ks + (gg * 192 + row) * 72 + d8 * 8) = kv;
            LAS bf16* vt = Vt + (gg * 64 + d8 * 8) * 200 + (row ^ (4 * d8));
            vt[0 * 200] = (bf16)(vv.x & 0xffffu); vt[1 * 200] = (bf16)(vv.x >> 16); vt[2 * 200] = (bf16)(vv.y & 0xffffu); vt[3 * 200] = (bf16)(vv.y >> 16);
            vt[4 * 200] = (bf16)(vv.z & 0xffffu); vt[5 * 200] = (bf16)(vv.z >> 16); vt[6 * 200] = (bf16)(vv.w & 0xffffu); vt[7 * 200] = (bf16)(vv.w >> 16);
            if (wr_cache && row >= 128) {
                const size_t o = ((size_t)(tok - (SEQ - 128)) * 2 + gg) * 64 + d8 * 8;
                *(f32x4*)(ck_out + o) = (f32x4){bf2f(kv.x & 0xffffu), bf2f(kv.x >> 16), bf2f(kv.y & 0xffffu), bf2f(kv.y >> 16)};
                *(f32x4*)(ck_out + o + 4) = (f32x4){bf2f(kv.z & 0xffffu), bf2f(kv.z >> 16), bf2f(kv.w & 0xffffu), bf2f(kv.w >> 16)};
                *(f32x4*)(cv_out + o) = (f32x4){bf2f(vv.x & 0xffffu), bf2f(vv.x >> 16), bf2f(vv.y & 0xffffu), bf2f(vv.y >> 16)};
                *(f32x4*)(cv_out + o + 4) = (f32x4){bf2f(vv.z & 0xffffu), bf2f(vv.z >> 16), bf2f(vv.w & 0xffffu), bf2f(vv.w >> 16)};
            }
        }
    }
    __syncthreads();
    const float L2E = 1.4426950408889634f;
    const float sc = 0.125f * L2E, sinkl = sinks[h] * L2E;
    f32x16 O[2][2];
#pragma unroll
    for (int sub = 0; sub < 2; ++sub) {
        f32x16 S[5];
#pragma unroll
        for (int kt = 0; kt < 5; ++kt) {
#pragma unroll
            for (int r = 0; r < 16; ++r) S[kt][r] = 0.f;
            const LAS bf16* kp = Ks + (g * 192 + 32 * sub + 32 * kt + qi) * 72 + 8 * hi;
#pragma unroll
            for (int st = 0; st < 4; ++st) { const bf16x8 kf = *(const LAS bf16x8*)(kp + 16 * st); S[kt] = __builtin_amdgcn_mfma_f32_32x32x16_bf16(kf, qf[sub][st], S[kt], 0, 0, 0); }
        }
        float m = sinkl;
#pragma unroll
        for (int kt = 0; kt < 5; ++kt)
#pragma unroll
            for (int r = 0; r < 16; ++r) {
                const int keyrow = 8 * (r >> 2) + 4 * hi + (r & 3);
                bool valid = true;
                if (kt == 0) valid = keyrow >= qi;
                if (kt == 4) valid = keyrow <= qi;
                if (t0 - 128 + 32 * sub + 32 * kt + keyrow < 0) valid = false;
                const float s = valid ? S[kt][r] * sc : -INFINITY;
                S[kt][r] = s; m = fmaxf(m, s);
            }
        m = fmaxf(m, __shfl_xor(m, 32));
        float sum = 0.f;
#pragma unroll
        for (int kt = 0; kt < 5; ++kt)
#pragma unroll
            for (int r = 0; r < 16; ++r) { const float p = __builtin_amdgcn_exp2f(S[kt][r] - m); S[kt][r] = p; sum += p; }
        sum += __shfl_xor(sum, 32);
        sum += exp2f(sinkl - m);
        const float inv = 1.0f / sum;
        f32x16 o0, o1;
#pragma unroll
        for (int r = 0; r < 16; ++r) { o0[r] = 0.f; o1[r] = 0.f; }
#pragma unroll
        for (int kt = 0; kt < 5; ++kt)
#pragma unroll
            for (int hf = 0; hf < 2; ++hf) {
                u32x4 pw; pw.x = pk2(S[kt][8 * hf + 0], S[kt][8 * hf + 1]); pw.y = pk2(S[kt][8 * hf + 2], S[kt][8 * hf + 3]);
                pw.z = pk2(S[kt][8 * hf + 4], S[kt][8 * hf + 5]); pw.w = pk2(S[kt][8 * hf + 6], S[kt][8 * hf + 7]);
                const bf16x8 pb = __builtin_bit_cast(bf16x8, pw);
                const int kb = 32 * sub + 32 * kt + 16 * hf + 4 * hi;
                const int f0 = 4 * (qi >> 3), f1 = 4 * (4 + (qi >> 3));
                const LAS bf16* v0 = Vt + (g * 64 + qi) * 200;
                const LAS bf16* v1 = Vt + (g * 64 + 32 + qi) * 200;
                u32x4 a0, a1; const u32x2 x0 = *(const LAS u32x2*)(v0 + (kb ^ f0)), x1 = *(const LAS u32x2*)(v0 + ((kb + 8) ^ f0)), y0 = *(const LAS u32x2*)(v1 + (kb ^ f1)), y1 = *(const LAS u32x2*)(v1 + ((kb + 8) ^ f1));
                a0.x = x0.x; a0.y = x0.y; a0.z = x1.x; a0.w = x1.y; a1.x = y0.x; a1.y = y0.y; a1.z = y1.x; a1.w = y1.y;
                o0 = __builtin_amdgcn_mfma_f32_32x32x16_bf16(__builtin_bit_cast(bf16x8, a0), pb, o0, 0, 0, 0);
                o1 = __builtin_amdgcn_mfma_f32_32x32x16_bf16(__builtin_bit_cast(bf16x8, a1), pb, o1, 0, 0, 0);
            }
        float q2 = 0.f;
#pragma unroll
        for (int r = 0; r < 16; ++r) { o0[r] *= inv; o1[r] *= inv; q2 += o0[r] * o0[r] + o1[r] * o1[r]; }
        q2 += __shfl_xor(q2, 32);
        if (hi == 0) SS[(sub * 8 + h) * 32 + qi] = q2;
        O[sub][0] = o0; O[sub][1] = o1;
    }
    __syncthreads();
    {
        LAS bf16* OT = (LAS bf16*)lds + h * (64 * 72);
#pragma unroll
        for (int sub = 0; sub < 2; ++sub) {
            float tot = 0.f;
#pragma unroll
            for (int hh = 0; hh < 8; ++hh) tot += SS[(sub * 8 + hh) * 32 + qi];
            const float rs = rsqrtf(tot * (1.0f / 512.0f) + EPS);
#pragma unroll
            for (int dt = 0; dt < 2; ++dt)
#pragma unroll
                for (int rq = 0; rq < 4; ++rq) {
                    const int d = 32 * dt + 8 * rq + 4 * hi;
                    const f32x4 gg = *(const f32x4*)(gout + 64 * h + d);
                    f32x4 v; v.x = O[sub][dt][4 * rq + 0]; v.y = O[sub][dt][4 * rq + 1]; v.z = O[sub][dt][4 * rq + 2]; v.w = O[sub][dt][4 * rq + 3];
                    v = v * gg * rs;
                    u32x2 w2; w2.x = pk2(v.x, v.y); w2.y = pk2(v.z, v.w);
                    *(LAS u32x2*)(OT + (32 * sub + qi) * 72 + d) = w2;
                }
        }
        asm volatile("s_waitcnt lgkmcnt(0)" ::: "memory");
#pragma unroll
        for (int i = 0; i < 8; ++i) {
            const int q = 8 * i + (lane >> 3), ch = lane & 7;
            const u32x4 w4 = *(const LAS u32x4*)(OT + q * 72 + 8 * ch);
            *(u32x4*)(MG + (size_t)(b * SEQ + t0 + q) * DM + 64 * h + 8 * ch) = w4;
        }
    }
    __syncthreads();
}

__device__ __forceinline__ void attn_sample_unit(LAS unsigned char* lds, int s, const bf16* __restrict__ ZS, bf16* __restrict__ MGS, const float* __restrict__ sinks, const float* __restrict__ gout,
                                                 const float* __restrict__ ck, const float* __restrict__ cv, float* __restrict__ cko, float* __restrict__ cvo) {
    int tid_o = threadIdx.x; asm volatile("" : "+v"(tid_o)); const int tid = tid_o, w = tid >> 6, lane = tid & 63;
    LAS float* KS = (LAS float*)lds;
    LAS float* VS = (LAS float*)(lds + 68112);
    LAS float* QS = (LAS float*)(lds + 68112 + 66048);
    LAS float* SC = QS + 512;
    LAS float* RED = SC + 8 * 132;
    const bf16* zr = ZS + (size_t)s * DIN;
    const float* ckb = ck + (size_t)s * 16384; float* ckob = cko + (size_t)s * 16384;
    const float* cvb = cv + (size_t)s * 16384; float* cvob = cvo + (size_t)s * 16384;
    {
        f32x4 kr[8], vr[8];
#pragma unroll
        for (int i = 0; i < 8; ++i) { const int e = (tid + NTHREADS * i) * 4; kr[i] = __builtin_nontemporal_load((const f32x4*)(ckb + e)); vr[i] = __builtin_nontemporal_load((const f32x4*)(cvb + e)); }
#pragma unroll
        for (int i = 0; i < 8; ++i) {
            const int e = (tid + NTHREADS * i) * 4, row = e >> 7, col = e & 127;
            *(LAS f32x4*)(KS + row * 132 + col) = kr[i]; *(LAS f32x4*)(VS + row * 128 + col) = vr[i];
            if (row >= 1) { __builtin_nontemporal_store(kr[i], (f32x4*)(ckob + e - 128)); __builtin_nontemporal_store(vr[i], (f32x4*)(cvob + e - 128)); }
        }
        QS[tid] = bf2f(zr[ZQ + tid]);
        if (tid < 128) {
            const float kn = bf2f(zr[ZK + tid]), vn = bf2f(zr[ZV + tid]);
            KS[128 * 132 + tid] = kn; VS[128 * 128 + tid] = vn;
            ckob[127 * 128 + tid] = kn; cvob[127 * 128 + tid] = vn;
        }
    }
    __syncthreads();
    {
        const int part = tid >> 7, g = part >> 1, h0 = 4 * g + 2 * (part & 1);
        for (int pass = 0; pass < 2; ++pass) {
            const int j = pass ? 128 : (tid & 127);
            if (pass && (tid & 127) != 0) break;
            const LAS float* kp = KS + j * 132 + 64 * g; const LAS float* q0 = QS + h0 * 64; const LAS float* q1 = q0 + 64;
            float a0 = 0.f, a1 = 0.f;
#pragma unroll
            for (int d = 0; d < 64; d += 4) { const f32x4 kv = *(const LAS f32x4*)(kp + d), x0 = *(const LAS f32x4*)(q0 + d), x1 = *(const LAS f32x4*)(q1 + d);
                a0 += (kv.x * x0.x + kv.y * x0.y) + (kv.z * x0.z + kv.w * x0.w); a1 += (kv.x * x1.x + kv.y * x1.y) + (kv.z * x1.z + kv.w * x1.w); }
            SC[h0 * 132 + j] = a0 * 0.125f; SC[(h0 + 1) * 132 + j] = a1 * 0.125f;
        }
    }
    __syncthreads();
    {
        const float sink = sinks[w];
        const float s0 = SC[w * 132 + lane], s1 = SC[w * 132 + 64 + lane], s2 = (lane == 0) ? SC[w * 132 + 128] : -INFINITY;
        const float m = fmaxf(wave_max(fmaxf(fmaxf(s0, s1), s2)), sink);
        const float p0 = __expf(s0 - m), p1 = __expf(s1 - m), p2 = (lane == 0) ? __expf(s2 - m) : 0.f;
        const float inv = 1.0f / (wave_sum(p0 + p1 + p2) + __expf(sink - m));
        SC[w * 132 + lane] = p0 * inv; SC[w * 132 + 64 + lane] = p1 * inv; if (lane == 0) SC[w * 132 + 128] = p2 * inv;
    }
    __syncthreads();
    float o = 0.f;
    {
        const LAS float* pp = SC + w * 132; const LAS float* vp = VS + 64 * (w >> 2) + lane;
#pragma unroll 8
        for (int jj = 0; jj < 128; jj += 4) { const f32x4 p4 = *(const LAS f32x4*)(pp + jj);
            o += p4.x * vp[(jj + 0) * 128] + p4.y * vp[(jj + 1) * 128] + p4.z * vp[(jj + 2) * 128] + p4.w * vp[(jj + 3) * 128]; }
        o += pp[128] * vp[128 * 128];
    }
    const float q2 = wave_sum(o * o);
    if (lane == 0) RED[w] = q2;
    __syncthreads();
    float tot = 0.f;
#pragma unroll
    for (int ww = 0; ww < 8; ++ww) tot += RED[ww];
    const float rs = rsqrtf(tot * (1.0f / 512.0f) + EPS);
    MGS[(size_t)s * DM + tid] = (bf16)f2bf(o * rs * gout[tid]);
    __syncthreads();
}

template <int NTW>
__device__ __forceinline__ void sconv_unit(bool sample, int b, int t0, const bf16* __restrict__ Zp, bf16* __restrict__ MGp, const float* __restrict__ cw, const float* __restrict__ gout,
                                           const float* __restrict__ sbuf, float* __restrict__ st_out) {
    int tid_o = threadIdx.x; asm volatile("" : "+v"(tid_o)); const int tid = tid_o, w = tid >> 6, lane = tid & 63, c = 4 * lane;
    const f32x4 w0 = *(const f32x4*)(cw + c), w1 = *(const f32x4*)(cw + 256 + c), w2 = *(const f32x4*)(cw + 512 + c), gg = *(const f32x4*)(gout + 768 + c);
    const f32x4 zero = (f32x4){0.f, 0.f, 0.f, 0.f};
    f32x4 co[NTW];
    if (!sample) {
        const int tb = t0 + NTW * w;
        const bf16* zb = Zp + ((size_t)b * SEQ + tb) * DIN;
        u32x2 rc[NTW + 2], ru[NTW + 2], rb[NTW];
#pragma unroll
        for (int i = 0; i < NTW + 2; ++i) {
            rc[i] = (u32x2){0u, 0u}; ru[i] = (u32x2){0u, 0u};
            if (tb + i - 2 >= 0) { rc[i] = *(const u32x2*)(zb + (long)(i - 2) * DIN + ZSC + c); ru[i] = *(const u32x2*)(zb + (long)(i - 2) * DIN + ZSU + c); }
        }
#pragma unroll
        for (int k = 0; k < NTW; ++k) rb[k] = *(const u32x2*)(zb + (size_t)k * DIN + ZSB + c);
        f32x4 v[NTW + 2];
#pragma unroll
        for (int i = 0; i < NTW + 2; ++i) {
            const f32x4 cc = (f32x4){bf2f(rc[i].x & 0xffffu), bf2f(rc[i].x >> 16), bf2f(rc[i].y & 0xffffu), bf2f(rc[i].y >> 16)};
            const f32x4 uu = (f32x4){bf2f(ru[i].x & 0xffffu), bf2f(ru[i].x >> 16), bf2f(ru[i].y & 0xffffu), bf2f(ru[i].y >> 16)};
            v[i] = cc * uu;
        }
#pragma unroll
        for (int k = 0; k < NTW; ++k) {
            const f32x4 bb = (f32x4){bf2f(rb[k].x & 0xffffu), bf2f(rb[k].x >> 16), bf2f(rb[k].y & 0xffffu), bf2f(rb[k].y >> 16)};
            co[k] = bb * (w0 * v[k] + w1 * v[k + 1] + w2 * v[k + 2]);
            const int t = tb + k;
            if (t >= SEQ - 2) *(f32x4*)(st_out + (size_t)(b * 2 + (t - (SEQ - 2))) * 256 + c) = v[k + 2];
        }
    } else if constexpr (NTW == 8) {
        const size_t sb = t0 + 8 * w;
        u32x2 rc[8], ru[8], rb[8]; f32x4 p0[8], p1[8];
#pragma unroll
        for (int k = 0; k < 8; ++k) {
            const bf16* zr = Zp + (sb + k) * DIN;
            rc[k] = *(const u32x2*)(zr + ZSC + c); ru[k] = *(const u32x2*)(zr + ZSU + c); rb[k] = *(const u32x2*)(zr + ZSB + c);
            p0[k] = *(const f32x4*)(sbuf + ((sb + k) * 2 + 0) * 256 + c); p1[k] = *(const f32x4*)(sbuf + ((sb + k) * 2 + 1) * 256 + c);
        }
#pragma unroll
        for (int k = 0; k < 8; ++k) {
            const f32x4 cc = (f32x4){bf2f(rc[k].x & 0xffffu), bf2f(rc[k].x >> 16), bf2f(rc[k].y & 0xffffu), bf2f(rc[k].y >> 16)};
            const f32x4 uu = (f32x4){bf2f(ru[k].x & 0xffffu), bf2f(ru[k].x >> 16), bf2f(ru[k].y & 0xffffu), bf2f(ru[k].y >> 16)};
            const f32x4 bb = (f32x4){bf2f(rb[k].x & 0xffffu), bf2f(rb[k].x >> 16), bf2f(rb[k].y & 0xffffu), bf2f(rb[k].y >> 16)};
            const f32x4 vcur = cc * uu;
            co[k] = bb * (w0 * p0[k] + w1 * p1[k] + w2 * vcur);
            *(f32x4*)(st_out + ((sb + k) * 2 + 0) * 256 + c) = p1[k]; *(f32x4*)(st_out + ((sb + k) * 2 + 1) * 256 + c) = vcur;
        }
    }
    (void)zero;
    float q[NTW];
#pragma unroll
    for (int k = 0; k < NTW; ++k) q[k] = (co[k].x * co[k].x + co[k].y * co[k].y) + (co[k].z * co[k].z + co[k].w * co[k].w);
#pragma unroll
    for (int o = 1; o < 64; o <<= 1)
#pragma unroll
        for (int k = 0; k < NTW; ++k) q[k] += __shfl_xor(q[k], o);
#pragma unroll
    for (int k = 0; k < NTW; ++k) {
        const size_t row = sample ? (size_t)(t0 + NTW * w + k) : ((size_t)b * SEQ + t0 + NTW * w + k);
        st_bf4(MGp + row * DM + 768 + c, co[k] * gg * rsqrtf(q[k] * (1.0f / 256.0f) + EPS));
    }
}

struct LruW { const float *cw, *cb, *ba, *bi, *lam, *gout; const bf16* lwt; };
__device__ __forceinline__ void lru_unit(LAS unsigned char* lds, bool sample, int b, int t0, const bf16* __restrict__ Zp, bf16* __restrict__ MGp, const LruW W,
                                         bf16* __restrict__ hloc, bf16* __restrict__ cuma, float* __restrict__ agga, float* __restrict__ aggb,
                                         const float* __restrict__ lbuf, const float* __restrict__ h0, float* __restrict__ lc_out, float* __restrict__ rg_out) {
    int tid_o = threadIdx.x; asm volatile("" : "+v"(tid_o)); const int tid = tid_o, w = __builtin_amdgcn_readfirstlane(tid >> 6), lane = tid & 63;
    LAS float* XC = (LAS float*)lds;
    constexpr int LP = 260;
    LAS bf16* XB = (LAS bf16*)(lds + 66560);
    LAS float* AA = (LAS float*)(lds + 66560);
    {
        const int cp = tid & 127, tg = tid >> 7, c = 2 * cp;
        const f32x2 k0 = *(const f32x2*)(W.cw + c), k1 = *(const f32x2*)(W.cw + 256 + c), k2 = *(const f32x2*)(W.cw + 512 + c), k3 = *(const f32x2*)(W.cw + 768 + c), bb = *(const f32x2*)(W.cb + c);
        if (!sample) {
            const int tb = t0 + 16 * tg;
            const bf16* zc = Zp + ((size_t)b * SEQ + tb) * DIN + ZLX + c;
            unsigned xr[19];
#pragma unroll
            for (int i = 0; i < 19; ++i) { xr[i] = 0u; if (tb + i - 3 >= 0) xr[i] = *(const unsigned*)(zc + (long)(i - 3) * DIN); }
#pragma unroll
            for (int i = 0; i < 16; ++i) {
                const f32x2 xm3 = (f32x2){bf2f(xr[i] & 0xffffu), bf2f(xr[i] >> 16)}, xm2 = (f32x2){bf2f(xr[i + 1] & 0xffffu), bf2f(xr[i + 1] >> 16)};
                const f32x2 xm1 = (f32x2){bf2f(xr[i + 2] & 0xffffu), bf2f(xr[i + 2] >> 16)}, x = (f32x2){bf2f(xr[i + 3] & 0xffffu), bf2f(xr[i + 3] >> 16)};
                const f32x2 xc = k0 * xm3 + k1 * xm2 + k2 * xm1 + k3 * x + bb;
                const int tok = 16 * tg + i;
                *(LAS f32x2*)(XC + tok * LP + c) = xc; *(LAS unsigned*)(XB + tok * 264 + c) = pk2(xc.x, xc.y);
                if (tb + i >= SEQ - 3) *(f32x2*)(lc_out + (size_t)(b * 3 + (tb + i - (SEQ - 3))) * 256 + c) = x;
            }
        } else {
#pragma unroll
            for (int i = 0; i < 16; ++i) {
                const int tok = 16 * tg + i; const size_t s = t0 + tok;
                const unsigned u = *(const unsigned*)(Zp + s * DIN + ZLX + c); const f32x2 x = (f32x2){bf2f(u & 0xffffu), bf2f(u >> 16)};
                const f32x2 xm3 = *(const f32x2*)(lbuf + (s * 3 + 0) * 256 + c), xm2 = *(const f32x2*)(lbuf + (s * 3 + 1) * 256 + c), xm1 = *(const f32x2*)(lbuf + (s * 3 + 2) * 256 + c);
                const f32x2 xc = k0 * xm3 + k1 * xm2 + k2 * xm1 + k3 * x + bb;
                *(LAS f32x2*)(XC + tok * LP + c) = xc; *(LAS unsigned*)(XB + tok * 264 + c) = pk2(xc.x, xc.y);
                *(f32x2*)(lc_out + (s * 3 + 0) * 256 + c) = xm2; *(f32x2*)(lc_out + (s * 3 + 1) * 256 + c) = xm1; *(f32x2*)(lc_out + (s * 3 + 2) * 256 + c) = x;
            }
        }
    }
    __syncthreads();
    const int blk = w & 3, dh = w >> 2, qi = lane & 31, hi = lane >> 5, ch = 64 * blk + 32 * dh + qi;
    f32x16 ar[2], ai[2];
    {
        bf16x8 bw[2][4];
#pragma unroll
        for (int gt = 0; gt < 2; ++gt)
#pragma unroll
            for (int st = 0; st < 4; ++st) bw[gt][st] = *(const bf16x8*)(W.lwt + ((size_t)(gt * 4 + blk) * 64 + 32 * dh + qi) * 64 + 16 * st + 8 * hi);
#pragma unroll
        for (int tt = 0; tt < 2; ++tt) {
#pragma unroll
            for (int r = 0; r < 16; ++r) { ar[tt][r] = 0.f; ai[tt][r] = 0.f; }
#pragma unroll
            for (int st = 0; st < 4; ++st) {
                const bf16x8 af = *(const LAS bf16x8*)(XB + (32 * tt + qi) * 264 + 64 * blk + 16 * st + 8 * hi);
                ar[tt] = __builtin_amdgcn_mfma_f32_32x32x16_bf16(af, bw[0][st], ar[tt], 0, 0, 0);
                ai[tt] = __builtin_amdgcn_mfma_f32_32x32x16_bf16(af, bw[1][st], ai[tt], 0, 0, 0);
            }
        }
    }
    __syncthreads();
    {
        const float ba = W.ba[ch], bi = W.bi[ch], lam = W.lam[ch];
        const float c8 = -8.0f * log1pf(__expf(-lam));
#pragma unroll
        for (int tt = 0; tt < 2; ++tt)
#pragma unroll
            for (int r = 0; r < 16; ++r) {
                const int tok = 32 * tt + 8 * (r >> 2) + 4 * hi + (r & 3);
                const float xc = XC[tok * LP + ch];
                const float rg = sigmoidf_(ar[tt][r] + ba), ig = sigmoidf_(ai[tt][r] + bi);
                const float la = c8 * rg, a = __builtin_amdgcn_exp2f(1.4426950408889634f * la), x2 = 2.0f * la, mult = __builtin_amdgcn_sqrtf(fmaxf(-x2 * (1.0f + x2 * (0.5f + x2 * (0.16666667f + x2 * (0.041666668f + x2 * (0.0083333338f + x2 * 0.0013888889f))))), 0.f));
                AA[tok * LP + ch] = a; XC[tok * LP + ch] = mult * ig * xc;
            }
    }
    __syncthreads();
    if (!sample) {
        const int half = tid >> 8, ch = tid & 255;
        float hl[32], cl[32];
        {
            float hh = 0.f, cum = 1.f;
#pragma unroll
            for (int i = 0; i < 32; ++i) { const int tok = 32 * half + i; const float a = AA[tok * LP + ch]; hh = a * hh + XC[tok * LP + ch]; cum *= a; hl[i] = hh; cl[i] = cum; }
        }
        __syncthreads();
        if (!half) { XC[ch] = hl[31]; XC[256 + ch] = cl[31]; }
        __syncthreads();
        if (half) {
            const float h1 = XC[ch], c1 = XC[256 + ch];
#pragma unroll
            for (int i = 0; i < 32; ++i) { hl[i] += cl[i] * h1; cl[i] *= c1; }
            const int chunk = t0 >> 6;
            agga[(size_t)(b * 128 + chunk) * 256 + ch] = cl[31]; aggb[(size_t)(b * 128 + chunk) * 256 + ch] = hl[31];
        }
        const size_t rb = ((size_t)b * SEQ + t0 + 32 * half) * 256 + ch;
#pragma unroll
        for (int i = 0; i < 32; ++i) { hloc[rb + (size_t)i * 256] = (bf16)f2bf(hl[i]); cuma[rb + (size_t)i * 256] = (bf16)f2bf(cl[i]); }
    } else {
        const int c = tid & 255, tk0 = (tid >> 8) * 32;
        float h0r[32]; unsigned short gr[32];
#pragma unroll
        for (int i = 0; i < 32; ++i) { const size_t s = t0 + tk0 + i; h0r[i] = h0[s * 256 + c]; gr[i] = Zp[s * DIN + ZLG + c]; }
#pragma unroll
        for (int i = 0; i < 32; ++i) {
            const int tok = tk0 + i; const size_t s = t0 + tok;
            const float hh = AA[tok * LP + c] * h0r[i] + XC[tok * LP + c];
            rg_out[s * 256 + c] = hh;
            XC[tok * LP + c] = hh * gelu_tanh(bf2f(gr[i]));
        }
        __syncthreads();
        for (int it = 0; it < 8; ++it) {
            const int tok = it * 8 + w; const size_t s = t0 + tok;
            const f32x4 v = *(const LAS f32x4*)(XC + tok * LP + 4 * lane);
            const float rs = rsqrtf(wave_sum((v.x * v.x + v.y * v.y) + (v.z * v.z + v.w * v.w)) * (1.0f / 256.0f) + EPS);
            st_bf4(MGp + s * DM + 512 + 4 * lane, v * *(const f32x4*)(W.gout + 512 + 4 * lane) * rs);
        }
    }
    __syncthreads();
}

__device__ __forceinline__ void lru_fix_unit(LAS unsigned char* lds, int b, int chunk, const bf16* __restrict__ Z, bf16* __restrict__ MG, const float* __restrict__ gout,
                                             const bf16* __restrict__ hloc, const bf16* __restrict__ cuma, const float* __restrict__ agga, const float* __restrict__ aggb, float* __restrict__ rg_out) {
    int tid_o = threadIdx.x; asm volatile("" : "+v"(tid_o)); const int tid = tid_o, w = tid >> 6, lane = tid & 63;
    LAS float* CR = (LAS float*)lds;
    const size_t row0 = (size_t)b * SEQ + chunk * 64 + 8 * w;
    u32x2 hlr[8], car[8]; u32x2 gr[8];
#pragma unroll
    for (int k = 0; k < 8; ++k) { hlr[k] = *(const u32x2*)(hloc + (row0 + k) * 256 + 4 * lane); car[k] = *(const u32x2*)(cuma + (row0 + k) * 256 + 4 * lane); gr[k] = *(const u32x2*)(Z + (row0 + k) * DIN + ZLG + 4 * lane); }
    {
        const int half = tid >> 8, ch = tid & 255, n1 = chunk >> 1, j0 = half ? n1 : 0, j1 = half ? chunk : n1;
        const float* pa = agga + (size_t)b * 128 * 256 + ch; const float* pb = aggb + (size_t)b * 128 * 256 + ch;
        float A = 1.f, B = 0.f;
#pragma unroll 32
        for (int j = j0; j < j1; ++j) { const float a = pa[(size_t)j * 256], bb = pb[(size_t)j * 256]; B = a * B + bb; A *= a; }
        if (half) { CR[ch] = A; CR[256 + ch] = B; }
        __syncthreads();
        if (!half) CR[512 + ch] = CR[ch] * B + CR[256 + ch];
        __syncthreads();
    }
    const f32x4 cr = *(const LAS f32x4*)(CR + 512 + 4 * lane), gg = *(const f32x4*)(gout + 512 + 4 * lane);
    f32x4 bo[8]; float q[8];
#pragma unroll
    for (int k = 0; k < 8; ++k) {
        const f32x4 hlk = (f32x4){bf2f(hlr[k].x & 0xffffu), bf2f(hlr[k].x >> 16), bf2f(hlr[k].y & 0xffffu), bf2f(hlr[k].y >> 16)};
        const f32x4 cak = (f32x4){bf2f(car[k].x & 0xffffu), bf2f(car[k].x >> 16), bf2f(car[k].y & 0xffffu), bf2f(car[k].y >> 16)};
        const f32x4 hh = hlk + cak * cr;
        const f32x4 gt = (f32x4){bf2f(gr[k].x & 0xffffu), bf2f(gr[k].x >> 16), bf2f(gr[k].y & 0xffffu), bf2f(gr[k].y >> 16)};
        bo[k].x = hh.x * gelu_tanh(gt.x); bo[k].y = hh.y * gelu_tanh(gt.y); bo[k].z = hh.z * gelu_tanh(gt.z); bo[k].w = hh.w * gelu_tanh(gt.w);
        q[k] = (bo[k].x * bo[k].x + bo[k].y * bo[k].y) + (bo[k].z * bo[k].z + bo[k].w * bo[k].w);
        if (chunk * 64 + 8 * w + k == SEQ - 1) *(f32x4*)(rg_out + (size_t)b * 256 + 4 * lane) = hh;
    }
#pragma unroll
    for (int o = 1; o < 64; o <<= 1)
#pragma unroll
        for (int k = 0; k < 8; ++k) q[k] += __shfl_xor(q[k], o);
#pragma unroll
    for (int k = 0; k < 8; ++k) st_bf4(MG + (row0 + k) * DM + 512 + 4 * lane, bo[k] * gg * rsqrtf(q[k] * (1.0f / 256.0f) + EPS));
    __syncthreads();
}

#define XB_TMO      128
#define XB_XCNT(j)  (256  + 64 * (j))
#define XB_XSUB(j)  (1280 + 64 * (j))
#define XB_XGEN(j)  (2304 + 64 * (j))
#define XB_TOP      3328
#define XB_TOPGEN   3392
#define XCD_BAR_WORDS 3456
#define XB_SPIN_CAP (1u << 18)

__device__ __forceinline__ unsigned xb_ld(unsigned* p)              { return __hip_atomic_load(p, __ATOMIC_RELAXED, __HIP_MEMORY_SCOPE_AGENT); }
__device__ __forceinline__ unsigned xb_add(unsigned* p, unsigned v) { return __hip_atomic_fetch_add(p, v, __ATOMIC_RELAXED, __HIP_MEMORY_SCOPE_AGENT); }
__device__ __forceinline__ unsigned xb_xcc_id() { return (unsigned)__builtin_amdgcn_s_getreg((3 << 11) | 20) & 0xFu; }
#define XB_SPIN(cond, bar) do { unsigned _sp = 0; while (cond) { __builtin_amdgcn_s_sleep(1); \
    if ((++_sp & 255u) == 0u) { if (xb_ld(&(bar)[XB_TMO])) break; if (_sp > XB_SPIN_CAP) { atomicAdd(&(bar)[XB_TMO], 1u); break; } } } } while (0)

struct XcdBarrier {
    unsigned* bar; unsigned x;
    volatile LAS unsigned* st;
};

__device__ __forceinline__ XcdBarrier xcd_barrier_post(unsigned* bar, volatile LAS unsigned* st) {
    XcdBarrier b; b.bar = bar; b.x = xb_xcc_id(); b.st = st;
    if (threadIdx.x == 0) (void)xb_add(&bar[XB_XCNT(b.x)], 1u);
    return b;
}
__device__ __forceinline__ void xcd_barrier_complete(unsigned* bar, unsigned x, unsigned& nloc, unsigned& nx) {
    const unsigned G = gridDim.x * gridDim.y * gridDim.z;
    unsigned sum, cnt, mine, sp = 0u;
    for (;;) {
        sum = 0u; cnt = 0u; mine = 0u;
#pragma unroll
        for (unsigned j = 0; j < 16; ++j) { const unsigned c = xb_ld(&bar[XB_XCNT(j)]); sum += c; cnt += (c > 0u) ? 1u : 0u; mine = (j == x) ? c : mine; }
        if (sum == G) break;
        __builtin_amdgcn_s_sleep(1);
        if ((++sp & 255u) == 0u) { if (xb_ld(&bar[XB_TMO])) break; if (sp > XB_SPIN_CAP) { atomicAdd(&bar[XB_TMO], 1u); break; } }
    }
    nloc = mine > 0u ? mine : 1u; nx = cnt > 0u ? cnt : 1u;
}

__device__ __forceinline__ void xcd_barrier(const XcdBarrier& b) {
    asm volatile("s_waitcnt vmcnt(0)" ::: "memory");
    __syncthreads();
    if (threadIdx.x == 0) {
        unsigned* bar = b.bar;
        __builtin_amdgcn_s_waitcnt(0);
        unsigned nloc = b.st[0], nx = b.st[1];
        if (nloc == 0u) { xcd_barrier_complete(bar, b.x, nloc, nx); b.st[0] = nloc; b.st[1] = nx; }
        const unsigned old = xb_add(&bar[XB_XSUB(b.x)], 1u);
        const unsigned gen = old / nloc;
        if (old + 1u == (gen + 1u) * nloc) {
            __builtin_amdgcn_fence(__ATOMIC_RELEASE, "agent");
            asm volatile("s_waitcnt vmcnt(0)" ::: "memory");
            const unsigned og = xb_add(&bar[XB_TOP], 1u);
            const unsigned tg = og / nx;
            if (og + 1u == (tg + 1u) * nx) xb_add(&bar[XB_TOPGEN], 1u);
            else XB_SPIN(xb_ld(&bar[XB_TOPGEN]) == tg, bar);
            __builtin_amdgcn_fence(__ATOMIC_ACQUIRE, "agent");
            xb_add(&bar[XB_XGEN(b.x)], 1u);
            asm volatile("s_waitcnt vmcnt(0)" ::: "memory");
        } else {
            XB_SPIN(xb_ld(&bar[XB_XGEN(b.x)]) == gen, bar);
            __builtin_amdgcn_fence(__ATOMIC_ACQUIRE, "agent");
            asm volatile("s_waitcnt vmcnt(0)" ::: "memory");
        }
    }
    __syncthreads();
}

typedef const Args __attribute__((address_space(4))) * KArgsP;
__device__ __forceinline__ KArgsP kargs() { KArgsP p = (KArgsP)__builtin_amdgcn_kernarg_segment_ptr(); asm volatile("" : "+s"(p)); return p; }
#define IN(i) (ka->in[i])
#define WSP(T, off) ((T*)(ka->ws + (off)))
#define OUTP(off) (ka->out + (off))
#define PHASE_VARS KArgsP ka = kargs(); int tid_o = threadIdx.x; asm volatile("" : "+v"(tid_o)); const int tid = tid_o, lane = tid & 63, wave = __builtin_amdgcn_readfirstlane(tid >> 6); \
    const int G = gridDim.x, cu = blockIdx.x, gw = cu * NWAVES + wave, NGW = G * NWAVES; (void)lane; (void)gw; (void)NGW; (void)ka;

#ifndef REP_AT
#define REP_AT 1
#endif
#ifndef REP_LR
#define REP_LR 1
#endif
#ifndef REP_SC
#define REP_SC 1
#endif
#ifndef REP_LF
#define REP_LF 1
#endif
#ifndef REP_AS
#define REP_AS 1
#endif
#ifndef REP_SG
#define REP_SG 1
#endif
#ifndef REP_LS
#define REP_LS 1
#endif
#ifndef REP_P1
#define REP_P1 1
#endif
#ifndef REP_P2
#define REP_P2 1
#endif
#ifndef REP_P3
#define REP_P3 1
#endif
#ifndef REP_P5
#define REP_P5 1
#endif
#ifndef REP_P0
#define REP_P0 1
#endif
__global__ void __launch_bounds__(NTHREADS, 2) fwd_megakernel(Args args) {
    extern __shared__ __attribute__((aligned(16))) unsigned char lds_raw[];
    LAS unsigned char* lds = (LAS unsigned char*)lds_raw;
    cg::grid_group grid = cg::this_grid();
    volatile LAS unsigned* MISC = (volatile LAS unsigned*)(lds + 147392);
    if (threadIdx.x < 16) MISC[threadIdx.x] = 0u;
    __syncthreads();
    const XcdBarrier bar = xcd_barrier_post((unsigned*)(args.ws + 16384), MISC + 8);

    for (int rep_ = 0; rep_ < REP_P0; ++rep_)
    {
        PHASE_VARS
        LAS float* scr = (LAS float*)(lds + wave * 16640);
        constexpr int I_IN = 16 * 32, I_OUT = 16 * 16, I_UP = 16 * 88, I_DN = 44 * 16, I_L = I_IN + I_OUT + I_UP + I_DN;
        for (int it = gw; it < DEPTH * I_L; it += NGW) {
            const int l = it / I_L; int r = it % I_L;
            unsigned char* wl = ka->ws + WS_W + (size_t)l * W_LAYER;
            if (r < I_IN) { transpose_item(IN(9) + (size_t)l * DM * DIN, DM, DIN, (bf16*)(wl + W_IN), 0, scr, r, lane, IN(8) + (size_t)l * DM); continue; } r -= I_IN;
            if (r < I_OUT) { transpose_item(IN(20) + (size_t)l * DM * DM, DM, DM, (bf16*)(wl + W_OUT), 0, scr, r, lane, nullptr); continue; } r -= I_OUT;
            if (r < I_UP) { transpose_item(IN(22) + (size_t)l * DM * DUP, DM, DUP, (bf16*)(wl + W_UP), 1, scr, r, lane, IN(21) + (size_t)l * DM); continue; } r -= I_UP;
            transpose_item(IN(24) + (size_t)l * DFF * DM, DFF, DM, (bf16*)(wl + W_DOWN), 0, scr, r, lane, nullptr);
        }
        bf16* LWT = WSP(bf16, WS_LWT);
        for (int e = cu * NTHREADS + tid; e < DEPTH * 2 * 4 * 4096; e += G * NTHREADS) {
            const int c = e & 63, d = (e >> 6) & 63, blk = (e >> 12) & 3, gt = (e >> 14) & 1, l = e >> 15;
            const float* src = gt ? IN(15) : IN(13);
            LWT[e] = (bf16)f2bf(src[((size_t)(l * 4 + blk) * 64 + c) * 64 + d]);
        }
        const float* xp = IN(0); bf16* X = WSP(bf16, WS_X); float* SSQB = WSP(float, WS_SSQB); float* SSQA = WSP(float, WS_SSQA);
        for (int m0 = gw; m0 < MP; m0 += 4 * NGW) {
            f32x4 v[4][4];
#pragma unroll
            for (int r = 0; r < 4; ++r) { const int m = m0 + r * NGW; if (m < MP) {
#pragma unroll
                for (int j = 0; j < 4; ++j) v[r][j] = __builtin_nontemporal_load((const f32x4*)(xp + (size_t)m * DM + 4 * lane + 256 * j)); } }
#pragma unroll
            for (int r = 0; r < 4; ++r) { const int m = m0 + r * NGW; if (m < MP) {
                float q = 0.f;
#pragma unroll
                for (int j = 0; j < 4; ++j) { q += (v[r][j].x * v[r][j].x + v[r][j].y * v[r][j].y) + (v[r][j].z * v[r][j].z + v[r][j].w * v[r][j].w); st_bf4(X + (size_t)m * DM + 4 * lane + 256 * j, v[r][j]); }
                q = wave_sum(q);
                if (lane == 0) *(f32x4*)(SSQB + 4 * (size_t)m) = (f32x4){q, 0.f, 0.f, 0.f}; } }
        }
        (void)SSQA;
        { const float* xs0 = IN(1); bf16* XSB = WSP(bf16, WS_XSB);
          for (int e = (cu * NTHREADS + tid) * 4; e < NS * DM; e += G * NTHREADS * 4) st_bf4(XSB + e, *(const f32x4*)(xs0 + e)); }
    }
    xcd_barrier(bar);
    if (gridDim.x == 0x7fffffffu) grid.sync();

#pragma nounroll
    for (int l = 0; l < DEPTH; ++l) {
        for (int rep_ = 0; rep_ < REP_P1; ++rep_)
        {
            PHASE_VARS
            const bf16* Win_t = (const bf16*)(ka->ws + WS_W + (size_t)l * W_LAYER + W_IN);
            pg8::Gemm g{WSP(bf16, WS_X), Win_t, MP, DIN, DM}; pg8::StaticOrder S; S.init(MP, DIN, G, cu);
            EpiZ E{WSP(bf16, WS_Z), WSP(float, WS_SSQB)};
            pg8::gemm_phase<EpiZ, pg8::StaticOrder, true, true, false>(lds, g, S, E);
        }
        xcd_barrier(bar);

        for (int rep_ = 0; rep_ < REP_P2; ++rep_)
        {
            PHASE_VARS
            const float* gout = IN(19) + (size_t)l * DM;
            const float* sinks = IN(10) + l * 8;
            LruW LW{IN(11) + (size_t)l * 4 * 256, IN(12) + (size_t)l * 256, IN(14) + (size_t)l * 256, IN(16) + (size_t)l * 256,
                    IN(17) + (size_t)l * 256, gout, WSP(bf16, WS_LWT) + (size_t)l * 2 * 4 * 4096};
            if (G == 256) {
                if (cu < 64)
                    for (int r2 = 0; r2 < REP_SG; ++r2) small_gemm_unit<0>(lds, cu, WSP(bf16, WS_XSB), (const bf16*)(ka->ws + WS_W + (size_t)l * W_LAYER + W_IN), DM, WSP(bf16, WS_ZS), DIN, nullptr, nullptr, nullptr, nullptr, nullptr);
                { const int b = cu >> 7, qb = cu & 127;
                  for (int r2 = 0; r2 < REP_AT; ++r2) attn_prompt_unit(lds, b, qb * 64, WSP(bf16, WS_Z), WSP(bf16, WS_MG), sinks, gout, OUTP(O_CKP) + (size_t)(l * 2 + b) * 16384, OUTP(O_CVP) + (size_t)(l * 2 + b) * 16384);
                  for (int r2 = 0; r2 < REP_LR; ++r2) lru_unit(lds, false, b, qb * 64, WSP(bf16, WS_Z), WSP(bf16, WS_MG), LW, WSP(bf16, WS_HLOC), WSP(bf16, WS_CUMA), WSP(float, WS_AGGA), WSP(float, WS_AGGB),
                             nullptr, nullptr, OUTP(O_LCP) + (size_t)l * 2 * 3 * 256, nullptr); }
                if (cu >= 64) {
                    const int b = cu >> 7, tb = cu & 127;
                    for (int r2 = 0; r2 < REP_SC; ++r2) sconv_unit<8>(false, b, tb * 64, WSP(bf16, WS_Z), WSP(bf16, WS_MG), IN(18) + (size_t)l * 3 * 256, gout, nullptr, OUTP(O_SCP) + (size_t)l * 2 * 2 * 256);
                    if (cu < 192) { const int u = (cu - 64) >> 1, hf = (cu - 64) & 1;
                        sconv_unit<4>(false, 0, u * 64 + 32 * hf, WSP(bf16, WS_Z), WSP(bf16, WS_MG), IN(18) + (size_t)l * 3 * 256, gout, nullptr, OUTP(O_SCP) + (size_t)l * 2 * 2 * 256); }
                }
            } else
            for (int idx0 = cu; idx0 < 64 + 768; idx0 += G) {
                if (idx0 < 64) {
                    for (int r2 = 0; r2 < REP_SG; ++r2) small_gemm_unit<0>(lds, idx0, WSP(bf16, WS_XSB), (const bf16*)(ka->ws + WS_W + (size_t)l * W_LAYER + W_IN), DM, WSP(bf16, WS_ZS), DIN, nullptr, nullptr, nullptr, nullptr, nullptr);
                    continue;
                }
                const int idx = idx0 - 64;
                if (idx < 256) {
                    const int b = idx >> 7, qb = idx & 127;
                    for (int r2 = 0; r2 < REP_AT; ++r2) attn_prompt_unit(lds, b, qb * 64, WSP(bf16, WS_Z), WSP(bf16, WS_MG), sinks, gout, OUTP(O_CKP) + (size_t)(l * 2 + b) * 16384, OUTP(O_CVP) + (size_t)(l * 2 + b) * 16384);
                } else if (idx < 512) {
                    LruW LW{IN(11) + (size_t)l * 4 * 256, IN(12) + (size_t)l * 256, IN(14) + (size_t)l * 256, IN(16) + (size_t)l * 256,
                            IN(17) + (size_t)l * 256, gout, WSP(bf16, WS_LWT) + (size_t)l * 2 * 4 * 4096};
                    const int u = idx - 256, b = u >> 7, chunk = u & 127;
                    for (int r2 = 0; r2 < REP_LR; ++r2) lru_unit(lds, false, b, chunk * 64, WSP(bf16, WS_Z), WSP(bf16, WS_MG), LW, WSP(bf16, WS_HLOC), WSP(bf16, WS_CUMA), WSP(float, WS_AGGA), WSP(float, WS_AGGB),
                             nullptr, nullptr, OUTP(O_LCP) + (size_t)l * 2 * 3 * 256, nullptr);
                } else {
                    const int u = idx - 512, b = u >> 7, tb = u & 127;
                    for (int r2 = 0; r2 < REP_SC; ++r2) sconv_unit<8>(false, b, tb * 64, WSP(bf16, WS_Z), WSP(bf16, WS_MG), IN(18) + (size_t)l * 3 * 256, gout, nullptr, OUTP(O_SCP) + (size_t)l * 2 * 2 * 256);
                }
            }
        }
        xcd_barrier(bar);

        for (int rep_ = 0; rep_ < REP_P3; ++rep_)
        {
            PHASE_VARS
            const float* gout = IN(19) + (size_t)l * DM;
            for (int k = 0; k < 2; ++k) {
                int idx = -1;
                if (G == 256) {
                    if (k == 0) idx = (cu >= 128 && cu < 132) ? 256 + cu : cu;
                    else idx = (cu < 128) ? 256 + cu : ((cu >= 132 && cu < 136) ? cu - 4 : -1);
                    if (idx >= 384) idx = idx;
                }
                for (int i2 = (G == 256 ? idx : cu + k * 100000); i2 >= 0 && i2 < 388; i2 += (G == 256 ? 100000 : G)) {
                    const int id = i2;
                    if (id < 256) {
                        for (int r2 = 0; r2 < REP_LF; ++r2) lru_fix_unit(lds, id >> 7, id & 127, WSP(bf16, WS_Z), WSP(bf16, WS_MG), gout, WSP(bf16, WS_HLOC), WSP(bf16, WS_CUMA),
                                     WSP(float, WS_AGGA), WSP(float, WS_AGGB), OUTP(O_RGP) + (size_t)l * 2 * 256);
                    } else if (id < 384) {
                        const int s = id - 256;
                        for (int r2 = 0; r2 < REP_AS; ++r2) attn_sample_unit(lds, s, WSP(bf16, WS_ZS), WSP(bf16, WS_MGS), IN(10) + l * 8, gout, IN(2) + (size_t)l * NS * 16384, IN(3) + (size_t)l * NS * 16384,
                                         OUTP(O_CKS) + (size_t)l * NS * 16384, OUTP(O_CVS) + (size_t)l * NS * 16384);
                    } else if (id < 386) {
                        LruW LW{IN(11) + (size_t)l * 4 * 256, IN(12) + (size_t)l * 256, IN(14) + (size_t)l * 256, IN(16) + (size_t)l * 256,
                                IN(17) + (size_t)l * 256, gout, WSP(bf16, WS_LWT) + (size_t)l * 2 * 4 * 4096};
                        for (int r2 = 0; r2 < REP_LS; ++r2) lru_unit(lds, true, 0, (id - 384) * 64, WSP(bf16, WS_ZS), WSP(bf16, WS_MGS), LW, nullptr, nullptr, nullptr, nullptr, IN(5) + (size_t)l * NS * 3 * 256, IN(4) + (size_t)l * NS * 256,
                                 OUTP(O_LCS) + (size_t)l * NS * 3 * 256, OUTP(O_RGS) + (size_t)l * NS * 256);
                    } else {
                        sconv_unit<8>(true, 0, (id - 386) * 64, WSP(bf16, WS_ZS), WSP(bf16, WS_MGS), IN(18) + (size_t)l * 3 * 256, gout, IN(6) + (size_t)l * NS * 2 * 256, OUTP(O_SCS) + (size_t)l * NS * 2 * 256);
                    }
                }
                if (G != 256) break;
            }
        }
        xcd_barrier(bar);

        {
            PHASE_VARS
            const bf16* Wout_t = (const bf16*)(ka->ws + WS_W + (size_t)l * W_LAYER + W_OUT);
            if (cu < 32) {
                const float* xs_in = (l == 0) ? IN(1) : WSP(float, WS_XS);
                small_gemm_unit<1>(lds, cu, WSP(bf16, WS_MGS), Wout_t, DM, WSP(bf16, WS_XSB), 0, xs_in, WSP(float, WS_XS), nullptr, nullptr, nullptr);
            }
            pg8::Gemm g{WSP(bf16, WS_MG), Wout_t, MP, DM, DM}; pg8::StaticOrder S; S.init(MP, DM, G, cu);
            EpiRes E{WSP(bf16, WS_X), WSP(float, WS_SSQA), (LAS float*)(lds + 131072), lds, G == 256};
            if (G == 256) pg8::gemm_phase<EpiRes, pg8::StaticOrder, true, true, false, true>(lds, g, S, E);
            else pg8::gemm_phase<EpiRes, pg8::StaticOrder, true, true, false>(lds, g, S, E);
        }
        xcd_barrier(bar);

        for (int rep_ = 0; rep_ < REP_P5; ++rep_)
        {
            PHASE_VARS
            const bf16* Wup_t = (const bf16*)(ka->ws + WS_W + (size_t)l * W_LAYER + W_UP);
            const float* fcw = IN(23) + (size_t)l * 3 * DUP;
            pg8::Gemm g{WSP(bf16, WS_X), Wup_t, 66 * 256, DUP, DM}; pg8::StaticOrder S; S.init(66 * 256, DUP, G, cu);
            EpiFfn E{WSP(bf16, WS_ACT), fcw, OUTP(O_FFP) + (size_t)l * 2 * 2 * DUP, WSP(float, WS_SSQA)};
            pg8::gemm_phase<EpiFfn, pg8::StaticOrder, true, true, true>(lds, g, S, E);
            const int nwg = 66 * 22, rem = nwg % G, n_idle = rem ? G - rem : G, first_idle = G - n_idle;
            if (cu >= first_idle)
                for (int j3 = cu - first_idle; j3 < 59; j3 += n_idle)
                    small_ffn_unit(lds, j3, WSP(bf16, WS_XSB), Wup_t, WSP(bf16, WS_ACTS), fcw, IN(7) + (size_t)l * NS * 2 * DUP, OUTP(O_FFS) + (size_t)l * NS * 2 * DUP);
        }
        xcd_barrier(bar);

        {
            PHASE_VARS
            const bf16* Wdown_t = (const bf16*)(ka->ws + WS_W + (size_t)l * W_LAYER + W_DOWN);
            if (cu < 32)
                small_gemm_unit<1>(lds, cu, WSP(bf16, WS_ACTS), Wdown_t, DFF, WSP(bf16, WS_XSB), 0, WSP(float, WS_XS), WSP(float, WS_XS), nullptr, nullptr, nullptr);
            pg8::Gemm g{WSP(bf16, WS_ACT), Wdown_t, MP, DM, DFF}; pg8::StaticOrder S; S.init(MP, DM, G, cu);
            EpiRes E{WSP(bf16, WS_X), WSP(float, WS_SSQB), (LAS float*)(lds + 131072), lds, G == 256};
            if (G == 256) pg8::gemm_phase<EpiRes, pg8::StaticOrder, true, true, false, true>(lds, g, S, E);
            else pg8::gemm_phase<EpiRes, pg8::StaticOrder, true, true, false>(lds, g, S, E);
        }
        xcd_barrier(bar);
    }
    {
        PHASE_VARS
        const float* gfin = IN(25); const float* XS = WSP(float, WS_XS); float* ys = OUTP(O_YS); float* Y = OUTP(O_Y);
        const bf16* X = WSP(bf16, WS_X); const float* SSQB = WSP(float, WS_SSQB);
        f32x4 gg[4];
#pragma unroll
        for (int j = 0; j < 4; ++j) gg[j] = *(const f32x4*)(gfin + 4 * lane + 256 * j);
        for (int m0 = gw; m0 < MP; m0 += 4 * NGW) {
            u32x2 xr[4][4]; f32x4 sq[4];
#pragma unroll
            for (int r = 0; r < 4; ++r) { const int m = m0 + r * NGW; if (m < MP) { sq[r] = *(const f32x4*)(SSQB + 4 * (size_t)m);
#pragma unroll
                for (int j = 0; j < 4; ++j) xr[r][j] = *(const u32x2*)(X + (size_t)m * DM + 4 * lane + 256 * j); } }
#pragma unroll
            for (int r = 0; r < 4; ++r) { const int m = m0 + r * NGW; if (m < MP) {
                const float rs = rsqrtf(((sq[r].x + sq[r].y) + (sq[r].z + sq[r].w)) * (1.0f / DM) + EPS);
#pragma unroll
                for (int j = 0; j < 4; ++j) { const f32x4 v = (f32x4){bf2f(xr[r][j].x & 0xffffu), bf2f(xr[r][j].x >> 16), bf2f(xr[r][j].y & 0xffffu), bf2f(xr[r][j].y >> 16)};
                    __builtin_nontemporal_store(v * gg[j] * rs, (f32x4*)(Y + (size_t)m * DM + 4 * lane + 256 * j)); } } }
        }
        for (int m = gw; m < NS; m += NGW) rms_row_f32(XS + (size_t)m * DM, gfin, ys + (size_t)m * DM, lane);
    }
}

extern "C" void kernel_launch(void* const* d_in, const int* in_sizes, int n_in, void* d_out, int out_size, void* d_ws, size_t ws_size, hipStream_t stream) {
    static int grid = 0;
    if (grid == 0) {
        if (n_in != 26 || ws_size < WS_END) { fprintf(stderr, "kernel_launch: unexpected n_in %d / ws_size %zu\n", n_in, ws_size); grid = -1; return; }
        int dev = 0, cus = 0, per_cu = 0;
        hipGetDevice(&dev);
        hipDeviceGetAttribute(&cus, hipDeviceAttributeMultiprocessorCount, dev);
        hipFuncSetAttribute((const void*)fwd_megakernel, hipFuncAttributeMaxDynamicSharedMemorySize, LDS_BYTES);
        hipOccupancyMaxActiveBlocksPerMultiprocessor(&per_cu, (const void*)fwd_megakernel, NTHREADS, LDS_BYTES);
        if (per_cu < 1) per_cu = 1;
        (void)hipGetLastError();
        grid = cus;
    }
    if (grid < 0) return;
    if (hipMemsetAsync(d_ws, 0, 65536, stream) != hipSuccess) { fprintf(stderr, "memset failed\n"); return; }
    Args a{};
    for (int i = 0; i < 26; ++i) a.in[i] = (const float*)d_in[i];
    a.out = (float*)d_out; a.ws = (unsigned char*)d_ws;
    void* kargs[] = {&a};
    hipError_t e = hipLaunchCooperativeKernel((const void*)fwd_megakernel, dim3(grid), dim3(NTHREADS), kargs, LDS_BYTES, stream);
    if (e != hipSuccess) fprintf(stderr, "cooperative launch failed: %s (grid %d)\n", hipGetErrorString(e), grid);
}
```

```cpp
#include <hip/hip_runtime.h>
#include <hip/hip_cooperative_groups.h>
#include <cstdio>
#include <cstdint>
namespace cg = cooperative_groups;
namespace pg8 {
#define PG8_LAS __attribute__((address_space(3)))
typedef unsigned short bf16_t;
typedef short bf16x8 __attribute__((ext_vector_type(8)));
typedef float f32x4 __attribute__((ext_vector_type(4)));
typedef unsigned u32x4 __attribute__((ext_vector_type(4)));
constexpr int BM = 256, BK = 64, HALF = 128, HTB = HALF * BK * 2  , STAGE_BYTES = 8 * HTB, NXCD = 8, WGM = 8;

__host__ __device__ __forceinline__ int lds_byte(int r, int c) { const int st = (r >> 4) * 2 + (c >> 5), rr = r & 15, cc = c & 31, ob = rr * 64 + cc * 2; return st * 1024 + (ob ^ (((ob >> 9) & 1) << 5)); }
__host__ __device__ __forceinline__ void stage_rc(int b, int& R, int& C) { const int st = b / 1024, sb = b % 1024, swz = sb ^ (((sb >> 9) & 1) << 5); R = (st >> 1) * 16 + swz / 64; C = (st & 1) * 32 + (swz % 64) / 2; }
__host__ __device__ __forceinline__ int perm32(int rho) { const int n = rho >> 4, i = rho & 15; return 8 * (i >> 2) + 4 * n + (i & 3); }

struct Unit { int pm, pn; };
struct Gemm { const bf16_t* A; const bf16_t* Bt; int M, N, K; };

struct StaticOrder {
    int nM, nN, nwg, G, c;
    __host__ __device__ void init(int M, int N, int G_, int c_) { nM = M / BM; nN = N / BM; nwg = nM * nN; G = G_; c = c_; }
    __host__ __device__ bool next(int i, Unit& u) const {
        const long L = (long)i * G + c; if (L >= nwg) return false;
        int wgid = (int)L; { const int q = nwg / NXCD, r = nwg % NXCD, xcd = wgid % NXCD, off = wgid / NXCD; wgid = (xcd < r ? xcd * (q + 1) : r * (q + 1) + (xcd - r) * q) + off; }
        const int nig = WGM * nN, gid = wgid / nig, fm = gid * WGM, gsz = (nM - fm) < WGM ? (nM - fm) : WGM;
        u.pm = fm + ((wgid % nig) % gsz); u.pn = (wgid % nig) / gsz; return true;
    }
    __device__ __forceinline__ void a_ready(const Unit&) const {}
    __device__ __forceinline__ void done(const Unit&) const {}
};

__device__ __forceinline__ unsigned cvt_pk_bf16(float lo, float hi) { unsigned r; asm volatile("v_cvt_pk_bf16_f32 %0, %1, %2" : "=v"(r) : "v"(lo), "v"(hi)); return r; }
typedef float f32x2 __attribute__((ext_vector_type(2)));
__device__ __forceinline__ f32x2 gelu_pk(f32x2 v) {
    const f32x2 av = __builtin_elementwise_abs(v), d = av * 0.2316418882f + 1.0f;
    f32x2 t; t.x = __builtin_amdgcn_rcpf(d.x); t.y = __builtin_amdgcn_rcpf(d.y);
    f32x2 q = t * 0.5307027145f + (-0.7265760135f); q = q * t + 0.7107068705f; q = q * t + (-0.142248368f); q = q * t + 0.127414796f; q = q * t;
    const f32x2 s = (v * v) * (-0.72134752044f);
    f32x2 e; e.x = __builtin_amdgcn_exp2f(s.x); e.y = __builtin_amdgcn_exp2f(s.y);
    const f32x2 m = v * (q * e), r = v - m;
    f32x2 o; o.x = v.x < 0.f ? m.x : r.x; o.y = v.y < 0.f ? m.y : r.y; return o;
}

template <int ACT  > struct EpiBf16 {
    static constexpr bool PERM = true, AFTER_DRAIN = false; static_assert(ACT == 0 || ACT == 1, "EpiBf16: ACT is 0 (none) or 1 (gelu_pk)");
    bf16_t* O; int ldc; const float* bias; int split_cols; size_t split_stride; float scale0;
    __device__ __forceinline__ void operator()(const f32x4 (&acc)[2][2][4][2], const Unit& u, int wr, int wc, int fr, int fq) const {
        const int row0 = u.pm * BM + wr * 64 + fr; int colt = u.pn * BM; bf16_t* base = O;
        float sc = 1.f; if (split_cols) { const int t = colt / split_cols; base += (size_t)t * split_stride; colt -= t * split_cols; if (t == 0) sc = scale0; }
        const int col0 = colt + wc * 32 + 8 * fq, bcol0 = u.pn * BM + wc * 32 + 8 * fq;
        f32x4 bv[2][2];
#pragma unroll
        for (int bj = 0; bj < 2; ++bj)
#pragma unroll
            for (int n = 0; n < 2; ++n) bv[bj][n] = bias ? *(const f32x4*)(bias + bcol0 + bj * HALF + 4 * n) : (f32x4){0.f, 0.f, 0.f, 0.f};
#pragma unroll
        for (int ai = 0; ai < 2; ++ai)
#pragma unroll
            for (int m = 0; m < 4; ++m) { bf16_t* rowp = base + (size_t)(row0 + ai * HALF + m * 16) * ldc + col0;
#pragma unroll
                for (int bj = 0; bj < 2; ++bj) { f32x4 v0 = acc[ai][bj][m][0] + bv[bj][0], v1 = acc[ai][bj][m][1] + bv[bj][1];
                    if (ACT == 1) { f32x2 a = gelu_pk((f32x2){v0[0], v0[1]}), b = gelu_pk((f32x2){v0[2], v0[3]}), c = gelu_pk((f32x2){v1[0], v1[1]}), d = gelu_pk((f32x2){v1[2], v1[3]});
                        v0 = (f32x4){a.x, a.y, b.x, b.y}; v1 = (f32x4){c.x, c.y, d.x, d.y}; }
                    v0 = v0 * sc; v1 = v1 * sc; u32x4 w; w.x = cvt_pk_bf16(v0[0], v0[1]); w.y = cvt_pk_bf16(v0[2], v0[3]); w.z = cvt_pk_bf16(v1[0], v1[1]); w.w = cvt_pk_bf16(v1[2], v1[3]);
                    *(u32x4*)(rowp + bj * HALF) = w; } }
    }
};

struct PanelStats {
    unsigned* xbuf;
    unsigned* cnt;
    unsigned* tmo;
    int ntn; float eps;
    unsigned code;
    __device__ __forceinline__ bool run(const f32x4 (&v)[2][2][4][2], const Unit& u, int wr, int wc, int fr, int fq, PG8_LAS unsigned char* lds, int wid, int lane) const {
        typedef float f32x2v __attribute__((ext_vector_type(2)));
        PG8_LAS f32x2v* P = (PG8_LAS f32x2v*)lds;
        PG8_LAS f32x2v* S = (PG8_LAS f32x2v*)(lds + 8192);
        PG8_LAS unsigned* flag = (PG8_LAS unsigned*)(lds + 8192 + 2048);
#pragma unroll
        for (int ai = 0; ai < 2; ++ai)
#pragma unroll
            for (int m = 0; m < 4; ++m) {
                float s = 0.f;
#pragma unroll
                for (int bj = 0; bj < 2; ++bj)
#pragma unroll
                    for (int n = 0; n < 2; ++n) { const f32x4 x = v[ai][bj][m][n]; s += (x[0] + x[1]) + (x[2] + x[3]); }
                s += __shfl_xor(s, 16); s += __shfl_xor(s, 32);
                const float mw = s * (1.0f / 64.0f); float q = 0.f;
#pragma unroll
                for (int bj = 0; bj < 2; ++bj)
#pragma unroll
                    for (int n = 0; n < 2; ++n) { const f32x4 d = v[ai][bj][m][n] - mw; q += (d[0] * d[0] + d[1] * d[1]) + (d[2] * d[2] + d[3] * d[3]); }
                q += __shfl_xor(q, 16); q += __shfl_xor(q, 32);
                if (fq == 0) P[(ai * HALF + wr * 64 + m * 16 + fr) * 4 + wc] = (f32x2v){mw, q};
            }
        asm volatile("s_waitcnt lgkmcnt(0)" ::: "memory"); __builtin_amdgcn_s_barrier(); asm volatile("" ::: "memory");
#if defined(BROKEN_EXCHANGE_NO_WAIT)
#warning BROKEN CONTROL BUILD: the row-statistics exchange does not wait; results are wrong by design
        if (blockIdx.x >= 64) { const long long t0_ = clock64(); while (clock64() - t0_ < 60000) __builtin_amdgcn_s_sleep(8); }
#endif
        const int row = wid * 32 + (lane & 31);
        if (lane < 32) {
            const f32x2v a = P[row * 4 + 0], b = P[row * 4 + 1], c = P[row * 4 + 2], d = P[row * 4 + 3];
            const float mt = (a.x + b.x + c.x + d.x) * 0.25f;
            const float da = a.x - mt, db = b.x - mt, dc = c.x - mt, dd = d.x - mt;
            const float m2 = (a.y + b.y) + (c.y + d.y) + 64.0f * ((da * da + db * db) + (dc * dc + dd * dd));
            unsigned long long* slot = (unsigned long long*)xbuf + ((size_t)(u.pm * BM + row) * 4 + u.pn);
            __hip_atomic_store(slot, ((unsigned long long)__float_as_uint(m2) << 32) | __float_as_uint(mt), __ATOMIC_RELAXED, __HIP_MEMORY_SCOPE_AGENT);
        }
        asm volatile("s_waitcnt vmcnt(0)" ::: "memory");
        if (lane == 0) __hip_atomic_fetch_add(cnt + 64 * u.pm, 1u, __ATOMIC_RELAXED, __HIP_MEMORY_SCOPE_AGENT);
        if (wid == 0) {
            bool dead = false; const unsigned long long t0 = __builtin_amdgcn_s_memrealtime(); const unsigned want = 8u * (unsigned)ntn;
            for (;;) {
#if defined(BROKEN_EXCHANGE_NO_WAIT)
                break;
#endif
                if ((unsigned)__builtin_amdgcn_readfirstlane(__hip_atomic_load(cnt + 64 * u.pm, __ATOMIC_RELAXED, __HIP_MEMORY_SCOPE_AGENT)) >= want) break;
                if (__builtin_amdgcn_s_memrealtime() - t0 > 2000000ull) {
                    if (lane == 0) { unsigned expect = 0u; __hip_atomic_compare_exchange_strong(tmo + 1, &expect, code | (unsigned)(u.pm & 0xff), __ATOMIC_RELAXED, __ATOMIC_RELAXED, __HIP_MEMORY_SCOPE_AGENT);
                                     __hip_atomic_store(tmo, 1u, __ATOMIC_RELAXED, __HIP_MEMORY_SCOPE_AGENT); }
                    dead = true; break; }
                __builtin_amdgcn_s_sleep(2);
            }
            __builtin_amdgcn_fence(__ATOMIC_ACQUIRE, "agent");
            if (lane == 0) flag[0] = dead ? 1u : 0u;
        }
        asm volatile("s_waitcnt vmcnt(0) lgkmcnt(0)" ::: "memory"); __builtin_amdgcn_s_barrier(); asm volatile("" ::: "memory");
        const bool bad = flag[0] != 0u;
        if (lane < 32) {
            const unsigned long long* slot = (const unsigned long long*)xbuf + (size_t)(u.pm * BM + row) * 4; float mt[4], m2[4]; float ms = 0.f;
#pragma unroll
            for (int t = 0; t < 4; ++t) { if (t < ntn) { const unsigned long long w = __hip_atomic_load(slot + t, __ATOMIC_RELAXED, __HIP_MEMORY_SCOPE_AGENT); mt[t] = __uint_as_float((unsigned)w); m2[t] = __uint_as_float((unsigned)(w >> 32)); } else { mt[t] = 0.f; m2[t] = 0.f; } ms += mt[t]; }
            const float mean = ms / (float)ntn; float q = 0.f;
#pragma unroll
            for (int t = 0; t < 4; ++t) if (t < ntn) { const float dm = mt[t] - mean; q += m2[t] + 256.0f * dm * dm; }
            S[row] = (f32x2v){mean, 1.0f / sqrtf(q / (256.0f * (float)ntn) + eps)};
        }
        asm volatile("s_waitcnt lgkmcnt(0)" ::: "memory"); __builtin_amdgcn_s_barrier(); asm volatile("" ::: "memory");
        return bad;
    }
};
struct EpiLnRes {
    static constexpr bool PERM = false, AFTER_DRAIN = true;
    const float* base; float* out; int ldc; const float* bias; PanelStats st; unsigned poison;
    __device__ __forceinline__ void fused(f32x4 (&acc)[2][2][4][2], const Unit& u, int wr, int wc, int fr, int fq, PG8_LAS unsigned char* lds, int wid, int lane) const {
        typedef float f32x2v __attribute__((ext_vector_type(2)));
        const PG8_LAS f32x2v* S = (const PG8_LAS f32x2v*)(lds + 8192);
        const int col0 = u.pn * BM + wc * 32 + 4 * fq;
#pragma unroll
        for (int bj = 0; bj < 2; ++bj)
#pragma unroll
            for (int n = 0; n < 2; ++n) { const f32x4 bv = bias ? *(const f32x4*)(bias + col0 + bj * HALF + n * 16) : (f32x4){0.f, 0.f, 0.f, 0.f};
#pragma unroll
                for (int ai = 0; ai < 2; ++ai)
#pragma unroll
                    for (int m = 0; m < 4; ++m) acc[ai][bj][m][n] += bv; }
        f32x4 pre[4][2][2];
#pragma unroll
        for (int m = 0; m < 4; ++m) { const size_t off = (size_t)(u.pm * BM + wr * 64 + m * 16 + fr) * ldc + col0;
#pragma unroll
            for (int bj = 0; bj < 2; ++bj)
#pragma unroll
                for (int n = 0; n < 2; ++n) pre[m][bj][n] = *(const f32x4*)(base + off + bj * HALF + n * 16); }
        const bool bad = st.run(acc, u, wr, wc, fr, fq, lds, wid, lane) || poison != 0u;
        const float qnan = __builtin_nanf("");
#pragma unroll
        for (int ai = 0; ai < 2; ++ai)
#pragma unroll
            for (int m = 0; m < 4; ++m) { const int r = ai * HALF + wr * 64 + m * 16 + fr; const f32x2v sr = S[r]; const size_t off = (size_t)(u.pm * BM + r) * ldc + col0;
#pragma unroll
                for (int bj = 0; bj < 2; ++bj)
#pragma unroll
                    for (int n = 0; n < 2; ++n) { const f32x4 bs = ai == 0 ? pre[m][bj][n] : *(const f32x4*)(base + off + bj * HALF + n * 16); f32x4 o = bs + (acc[ai][bj][m][n] - sr.x) * sr.y;
                        if (bad) o = (f32x4){qnan, qnan, qnan, qnan}; *(f32x4*)(out + off + bj * HALF + n * 16) = o; }
                if (m & 1) asm volatile("" ::: "memory"); }
    }
};
struct EpiLnResLn {
    static constexpr bool PERM = false, AFTER_DRAIN = true;
    const float* base; float* out; bf16_t* xn; int ldc; const float* bias; PanelStats st1, st2; unsigned poison;
    __device__ __forceinline__ void fused(f32x4 (&acc)[2][2][4][2], const Unit& u, int wr, int wc, int fr, int fq, PG8_LAS unsigned char* lds, int wid, int lane) const {
        typedef float f32x2v __attribute__((ext_vector_type(2))); typedef unsigned u32x2v __attribute__((ext_vector_type(2)));
        const PG8_LAS f32x2v* S = (const PG8_LAS f32x2v*)(lds + 8192);
        const int col0 = u.pn * BM + wc * 32 + 4 * fq;
#pragma unroll
        for (int bj = 0; bj < 2; ++bj)
#pragma unroll
            for (int n = 0; n < 2; ++n) { const f32x4 bv = bias ? *(const f32x4*)(bias + col0 + bj * HALF + n * 16) : (f32x4){0.f, 0.f, 0.f, 0.f};
#pragma unroll
                for (int ai = 0; ai < 2; ++ai)
#pragma unroll
                    for (int m = 0; m < 4; ++m) acc[ai][bj][m][n] += bv; }
        bool bad = st1.run(acc, u, wr, wc, fr, fq, lds, wid, lane) || poison != 0u;
        const float qnan = __builtin_nanf("");
#pragma unroll
        for (int ai = 0; ai < 2; ++ai)
#pragma unroll
            for (int m = 0; m < 4; ++m) { const int r = ai * HALF + wr * 64 + m * 16 + fr; const f32x2v sr = S[r]; const size_t off = (size_t)(u.pm * BM + r) * ldc + col0;
#pragma unroll
                for (int bj = 0; bj < 2; ++bj)
#pragma unroll
                    for (int n = 0; n < 2; ++n) { const f32x4 bs = *(const f32x4*)(base + off + bj * HALF + n * 16); acc[ai][bj][m][n] = bs + (acc[ai][bj][m][n] - sr.x) * sr.y; }
                asm volatile("" : "+v"(acc[ai][0][m][0]), "+v"(acc[ai][0][m][1]), "+v"(acc[ai][1][m][0]), "+v"(acc[ai][1][m][1]));
                if (m & 1) asm volatile("" ::: "memory"); }
        const bool bad1 = bad;
        bad = st2.run(acc, u, wr, wc, fr, fq, lds, wid, lane) || bad;
#pragma unroll
        for (int ai = 0; ai < 2; ++ai)
#pragma unroll
            for (int m = 0; m < 4; ++m) { const int r = ai * HALF + wr * 64 + m * 16 + fr; const f32x2v sr = S[r]; const size_t off = (size_t)(u.pm * BM + r) * ldc + col0;
#pragma unroll
                for (int bj = 0; bj < 2; ++bj)
#pragma unroll
                    for (int n = 0; n < 2; ++n) { const f32x4 x1 = acc[ai][bj][m][n]; *(f32x4*)(out + off + bj * HALF + n * 16) = bad1 ? (f32x4){qnan, qnan, qnan, qnan} : x1;
                        const f32x4 o = (x1 - sr.x) * sr.y; u32x2v w; w.x = cvt_pk_bf16(o[0], o[1]); w.y = cvt_pk_bf16(o[2], o[3]);
                        if (bad) { w.x = 0x7fc07fc0u; w.y = 0x7fc07fc0u; } *(u32x2v*)(xn + off + bj * HALF + n * 16) = w; }
                asm volatile("" ::: "memory"); }
    }
};

template <class Epi, class Sched, bool ALIGN_EPI = false, bool SP2 = false, bool AMAP = false, bool XPRE = false>
__device__ __forceinline__ void gemm_phase(PG8_LAS unsigned char* lds, const Gemm g, const Sched& S, const Epi& E) {
    int tid_o = threadIdx.x; asm volatile("" : "+v"(tid_o)); const int tid = tid_o, wid = __builtin_amdgcn_readfirstlane(tid >> 6), lane = tid & 63, wr = wid >> 2, wc = wid & 3, fr = lane & 15, fq = lane >> 4;
    const int K = g.K, nt = K / BK;
    unsigned voffA[2], voffB[2];
#pragma unroll
    for (int i = 0; i < 2; ++i) { int R, C; stage_rc(tid * 16 + i * 8192, R, C); const int Rb = Epi::PERM ? ((R & ~31) + perm32(R & 31)) : R;
        const int Ra = AMAP ? ((R >> 6) * 126 + 8 * (R & 15) + ((R >> 4) & 3)) : R;
        voffA[i] = (unsigned)(Ra * K + C) * 2u; voffB[i] = (unsigned)(Rb * K + C) * 2u; }
    const size_t kstep = (size_t)(BK * 2);
    const size_t hstep = (size_t)HALF * K * 2;
    const size_t tstep = 2 * hstep;
    const size_t hstepA = AMAP ? (size_t)4 * K * 2 : hstep;
#define PG8_AROW(pm) (AMAP ? ((long)((pm) / 33) * 8192 + (long)((pm) % 33) * 252 - 2) : (long)(pm) * 256)
    const unsigned ldsw = (unsigned)wid * 1024u;
    const int aoff = lds_byte(wr * 64 + fr, fq * 8), boff = lds_byte(wc * 32 + fr, fq * 8);
#define PG8_SA(b, h) (((b) * 2 + (h)) * HTB)
#define PG8_SB(b, h) ((4 + (b) * 2 + (h)) * HTB)
#define PG8_STAGE(bufoff, gbase, voff) do { _Pragma("unroll") for (int _i = 0; _i < 2; ++_i) \
        __builtin_amdgcn_global_load_lds((const unsigned*)((const char*)(gbase) + (voff)[_i]), (PG8_LAS unsigned*)(lds + (bufoff) + ldsw + _i * 8192), 16, 0, 0); } while (0)
#define PG8_LDA(dst, b, h) do { _Pragma("unroll") for (int m = 0; m < 4; ++m) _Pragma("unroll") for (int k = 0; k < 2; ++k) dst[m][k] = *(const PG8_LAS bf16x8*)(lds + PG8_SA(b, h) + aoff + m * 2048 + k * 1024); } while (0)
#define PG8_LDB(dst, b, h) do { _Pragma("unroll") for (int n = 0; n < 2; ++n) _Pragma("unroll") for (int k = 0; k < 2; ++k) dst[n][k] = *(const PG8_LAS bf16x8*)(lds + PG8_SB(b, h) + boff + n * 2048 + k * 1024); } while (0)
#define PG8_MMA(ai, bj, At, Bt) do { __builtin_amdgcn_s_setprio(1); _Pragma("unroll") for (int m = 0; m < 4; ++m) _Pragma("unroll") for (int n = 0; n < 2; ++n) _Pragma("unroll") for (int k = 0; k < 2; ++k) \
        acc[ai][bj][m][n] = __builtin_amdgcn_mfma_f32_16x16x32_bf16(Bt[n][k], At[m][k], acc[ai][bj][m][n], 0, 0, 0); __builtin_amdgcn_s_setprio(0); } while (0)
#define PG8_WAIT_V(n) asm volatile("s_waitcnt vmcnt(" #n ")" ::: "memory")
#define PG8_WAIT_L(n) asm volatile("s_waitcnt lgkmcnt(" #n ")" ::: "memory")
#define PG8_BAR __builtin_amdgcn_s_barrier()
#define PG8_SCHED __builtin_amdgcn_sched_barrier(0)
    Unit cur, nxt; int ui = 0;
    if (!S.next(0, cur)) return;
    f32x4 acc[2][2][4][2];
#pragma unroll
    for (int a = 0; a < 2; ++a)
#pragma unroll
        for (int b = 0; b < 2; ++b)
#pragma unroll
            for (int m = 0; m < 4; ++m)
#pragma unroll
                for (int n = 0; n < 2; ++n) acc[a][b][m][n] = (f32x4){0.f, 0.f, 0.f, 0.f};
    bf16x8 At[4][2], B0[2][2], B1[2][2];
    const char* cA = (const char*)g.A + PG8_AROW(cur.pm) * (long)K * 2; const char* cB = (const char*)g.Bt + (size_t)cur.pn * tstep;
    S.a_ready(cur);
    if constexpr (SP2) {
        PG8_STAGE(PG8_SB(0, 0), cB, voffB); PG8_STAGE(PG8_SB(0, 1), cB + hstep, voffB); PG8_STAGE(PG8_SA(0, 0), cA, voffA); PG8_STAGE(PG8_SA(0, 1), cA + hstepA, voffA);
        if (wr == 1) PG8_BAR;
        PG8_WAIT_V(2); PG8_BAR;
        PG8_STAGE(PG8_SB(1, 0), cB + kstep, voffB); PG8_STAGE(PG8_SA(1, 0), cA + kstep, voffA); PG8_STAGE(PG8_SB(1, 1), cB + hstep + kstep, voffB);
        PG8_WAIT_V(6); PG8_BAR;
    } else {
        PG8_STAGE(PG8_SB(0, 0), cB, voffB); PG8_STAGE(PG8_SA(0, 0), cA, voffA); PG8_STAGE(PG8_SB(0, 1), cB + hstep, voffB); PG8_STAGE(PG8_SA(0, 1), cA + hstepA, voffA);
        if (wr == 1) PG8_BAR;
        PG8_WAIT_V(4); PG8_BAR;
        PG8_STAGE(PG8_SB(1, 0), cB + kstep, voffB); PG8_STAGE(PG8_SA(1, 0), cA + kstep, voffA); PG8_STAGE(PG8_SB(1, 1), cB + hstep + kstep, voffB);
        PG8_WAIT_V(6); PG8_BAR;
    }
    for (;;) {
        const bool has_next = S.next(ui + 1, nxt);
        const char* nA = has_next ? (const char*)g.A + PG8_AROW(nxt.pm) * (long)K * 2 : cA; const char* nB = has_next ? (const char*)g.Bt + (size_t)nxt.pn * tstep : cB;
        for (int t = 0; t < nt; t += 2) {
            const bool last = (t == nt - 2);
            const bool xl = XPRE && last && !has_next;
            unsigned vx0 = 0u, vx1 = 0u; const char* xb = nullptr;
            if constexpr (XPRE) { if (xl) { int t_ = threadIdx.x; asm volatile("" : "+v"(t_)); int R_, C_; stage_rc(t_ * 16, R_, C_); vx0 = (unsigned)(R_ * 1024 + C_) * 2u; stage_rc(t_ * 16 + 8192, R_, C_); vx1 = (unsigned)(R_ * 1024 + C_) * 2u;
                xb = (const char*)E.X + ((size_t)cur.pm * 256 * 1024 + (size_t)cur.pn * 256) * 2; } }
#define PG8_STAGE_X(bufoff, q) do { const char* _g = xb + ((size_t)((q) & 1) * 128 * 1024 + (size_t)((q) >> 1) * 64) * 2; \
        __builtin_amdgcn_global_load_lds((const unsigned*)(_g + vx0), (PG8_LAS unsigned*)(lds + (bufoff) + ldsw), 16, 0, 0); \
        __builtin_amdgcn_global_load_lds((const unsigned*)(_g + vx1), (PG8_LAS unsigned*)(lds + (bufoff) + ldsw + 8192), 16, 0, 0); } while (0)
            const char* a1 = cA + (size_t)(t + 1) * kstep;
            const char* a2 = last ? nA : cA + (size_t)(t + 2) * kstep; const char* b2 = last ? nB : cB + (size_t)(t + 2) * kstep;
            const char* a3 = a2 + kstep; const char* b3 = b2 + kstep;
            if (last && has_next) S.a_ready(nxt);
            if constexpr (SP2) {
            PG8_LDB(B0, 0, 0); PG8_LDB(B1, 0, 1); PG8_SCHED; PG8_LDA(At, 0, 0); PG8_STAGE(PG8_SA(1, 1), a1 + hstepA, voffA);
            PG8_WAIT_V(8); PG8_WAIT_L(0); PG8_BAR; PG8_MMA(0, 0, At, B0); PG8_MMA(0, 1, At, B1); PG8_BAR; PG8_SCHED;
            PG8_LDA(At, 0, 1); if (xl) { PG8_STAGE_X(PG8_SB(0, 0), 0); PG8_STAGE_X(PG8_SB(0, 1), 1); PG8_STAGE_X(PG8_SA(0, 0), 2); } else { PG8_STAGE(PG8_SB(0, 0), b2, voffB); PG8_STAGE(PG8_SB(0, 1), b2 + hstep, voffB); PG8_STAGE(PG8_SA(0, 0), a2, voffA); }
            PG8_WAIT_V(8); PG8_WAIT_L(0); PG8_BAR; PG8_MMA(1, 0, At, B0); PG8_MMA(1, 1, At, B1); PG8_BAR; PG8_SCHED;
            PG8_LDB(B0, 1, 0); PG8_LDB(B1, 1, 1); PG8_SCHED; PG8_LDA(At, 1, 0); if (xl) { PG8_STAGE_X(PG8_SA(0, 1), 3); } else { PG8_STAGE(PG8_SA(0, 1), a2 + hstepA, voffA); }
            PG8_WAIT_V(8); PG8_WAIT_L(0); PG8_BAR; PG8_MMA(0, 0, At, B0); PG8_MMA(0, 1, At, B1); PG8_BAR; PG8_SCHED;
            PG8_LDA(At, 1, 1); if (xl) { PG8_STAGE_X(PG8_SB(1, 0), 4); PG8_STAGE_X(PG8_SB(1, 1), 5); PG8_STAGE_X(PG8_SA(1, 0), 6); } else { PG8_STAGE(PG8_SB(1, 0), b3, voffB); PG8_STAGE(PG8_SB(1, 1), b3 + hstep, voffB); PG8_STAGE(PG8_SA(1, 0), a3, voffA); }
            PG8_WAIT_V(8); PG8_WAIT_L(0); PG8_BAR; PG8_MMA(1, 0, At, B0); PG8_MMA(1, 1, At, B1); PG8_BAR; PG8_SCHED;
            } else {
            PG8_LDB(B0, 0, 0); PG8_SCHED; PG8_LDA(At, 0, 0); PG8_STAGE(PG8_SA(1, 1), a1 + hstepA, voffA);
            PG8_WAIT_L(8); PG8_BAR; PG8_WAIT_L(0); PG8_MMA(0, 0, At, B0); PG8_BAR; PG8_SCHED;
            PG8_LDB(B1, 0, 1); PG8_STAGE(PG8_SB(0, 0), b2, voffB);
            PG8_BAR; PG8_WAIT_L(0); PG8_MMA(0, 1, At, B1); PG8_BAR;
            PG8_LDA(At, 0, 1); PG8_STAGE(PG8_SA(0, 0), a2, voffA);
            PG8_BAR; PG8_WAIT_L(0); PG8_MMA(1, 0, At, B0); PG8_BAR; PG8_SCHED;
            PG8_STAGE(PG8_SB(0, 1), b2 + hstep, voffB);
            PG8_WAIT_V(6); PG8_BAR; PG8_MMA(1, 1, At, B1); PG8_BAR;
            PG8_LDB(B0, 1, 0); PG8_SCHED; PG8_LDA(At, 1, 0); PG8_STAGE(PG8_SA(0, 1), a2 + hstepA, voffA);
            PG8_WAIT_L(8); PG8_BAR; PG8_WAIT_L(0); PG8_MMA(0, 0, At, B0); PG8_BAR; PG8_SCHED;
            PG8_LDB(B1, 1, 1); PG8_STAGE(PG8_SB(1, 0), b3, voffB);
            PG8_BAR; PG8_WAIT_L(0); PG8_MMA(0, 1, At, B1); PG8_BAR;
            PG8_LDA(At, 1, 1); PG8_STAGE(PG8_SA(1, 0), a3, voffA);
            PG8_BAR; PG8_WAIT_L(0); PG8_MMA(1, 0, At, B0); PG8_BAR; PG8_SCHED;
            PG8_STAGE(PG8_SB(1, 1), b3 + hstep, voffB);
            PG8_WAIT_V(6); PG8_BAR; PG8_MMA(1, 1, At, B1); PG8_BAR;
            }
        }
        if constexpr (ALIGN_EPI) { if (wr == 0) PG8_BAR; }
        if constexpr (!Epi::AFTER_DRAIN) { E(acc, cur, wr, wc, fr, fq); S.done(cur); }
        if (!has_next) break;
#pragma unroll
        for (int a = 0; a < 2; ++a)
#pragma unroll
            for (int b = 0; b < 2; ++b)
#pragma unroll
                for (int m = 0; m < 4; ++m)
#pragma unroll
                    for (int n = 0; n < 2; ++n) acc[a][b][m][n] = (f32x4){0.f, 0.f, 0.f, 0.f};
        cur = nxt; cA = nA; cB = nB; ++ui;
        if constexpr (ALIGN_EPI) { if (wr == 1) PG8_BAR; }
    }
    PG8_WAIT_V(0);
    if constexpr (!ALIGN_EPI) { if (wr == 0) PG8_BAR; }
    PG8_BAR;
    if constexpr (Epi::AFTER_DRAIN) { E.fused(acc, cur, wr, wc, fr, fq, lds, wid, lane); S.done(cur); }
#undef PG8_AROW
#undef PG8_STAGE_X
#undef PG8_SA
#undef PG8_SB
#undef PG8_STAGE
#undef PG8_LDA
#undef PG8_LDB
#undef PG8_MMA
#undef PG8_WAIT_V
#undef PG8_WAIT_L
#undef PG8_BAR
#undef PG8_SCHED
}
}

#define GAS __attribute__((address_space(1)))
#define LAS __attribute__((address_space(3)))
typedef unsigned short bf16;
typedef float f32x4 __attribute__((ext_vector_type(4)));
typedef float f32x2 __attribute__((ext_vector_type(2)));
typedef float f32x16 __attribute__((ext_vector_type(16)));
typedef short bf16x8 __attribute__((ext_vector_type(8)));
typedef unsigned u32x4 __attribute__((ext_vector_type(4)));
typedef unsigned u32x2 __attribute__((ext_vector_type(2)));

constexpr int DM = 1024, SEQ = 8192, NBATCH = 2, MP = NBATCH * SEQ, NS = 128, DEPTH = 4;
constexpr int DIN = 2048, DFF = 2816, DUP = 5632, DLRU = 256;
constexpr float EPS = 1e-6f;
constexpr int NWAVES = 8, NTHREADS = 512;
constexpr int LDS_BYTES = 147456;
constexpr int ZQ = 0, ZK = 512, ZV = 640, ZLX = 768, ZLG = 1024, ZSB = 1280, ZSC = 1536, ZSU = 1792;
constexpr size_t O_Y = 0, O_YS = 16777216, O_CKP = 16908288, O_CVP = 17039360, O_RGP = 17170432, O_LCP = 17172480, O_SCP = 17178624,
                 O_FFP = 17182720, O_CKS = 17272832, O_CVS = 25661440, O_RGS = 34050048, O_LCS = 34181120, O_SCS = 34574336, O_FFS = 34836480;
constexpr size_t MiB = 1u << 20;
constexpr size_t WS_LWT = 1 * MiB;
constexpr size_t WS_W = 2 * MiB, W_LAYER = 23592960;
constexpr size_t W_IN = 0, W_OUT = 4 * MiB, W_UP = 6 * MiB, W_DOWN = 17 * MiB;
constexpr size_t WS_XS = 92 * MiB;
constexpr size_t WS_ZS = WS_XS + 512 * 1024;
constexpr size_t WS_MGS = WS_ZS + 512 * 1024;
constexpr size_t WS_ACTS = WS_MGS + 256 * 1024;
constexpr size_t WS_XSB = WS_ACTS + 768 * 1024;
constexpr size_t WS_AGGA = 95 * MiB, WS_AGGB = 95 * MiB + 512 * 1024;
constexpr size_t WS_Z = 96 * MiB;
constexpr size_t WS_MG = 160 * MiB;
constexpr size_t WS_HLOC = 192 * MiB, WS_CUMA = 208 * MiB;
constexpr size_t WS_XN = 192 * MiB;
constexpr size_t WS_ACT = 226 * MiB;
constexpr size_t WS_SSQA = 94 * MiB + 256 * 1024 + 4096, WS_SSQB = 94 * MiB + 640 * 1024 + 4096;
constexpr size_t WS_X = 316 * MiB + 64 * 1024;
constexpr size_t WS_END = 349 * MiB;

__device__ __forceinline__ float bf2f(unsigned v) { return __uint_as_float(v << 16); }
__device__ __forceinline__ unsigned f2bf(float f) { unsigned u = __float_as_uint(f); return (u + 0x7fffu + ((u >> 16) & 1u)) >> 16; }
__device__ __forceinline__ unsigned pk2(float lo, float hi) { unsigned r; asm volatile("v_cvt_pk_bf16_f32 %0, %1, %2" : "=v"(r) : "v"(lo), "v"(hi)); return r; }
__device__ __forceinline__ float wave_sum(float v) {
#pragma unroll
    for (int o = 1; o < 64; o <<= 1) v += __shfl_xor(v, o);
    return v;
}
__device__ __forceinline__ float wave_max(float v) {
#pragma unroll
    for (int o = 1; o < 64; o <<= 1) v = fmaxf(v, __shfl_xor(v, o));
    return v;
}
__device__ __forceinline__ float sigmoidf_(float x) { return __builtin_amdgcn_rcpf(1.0f + __builtin_amdgcn_exp2f(-1.4426950408889634f * x)); }
__device__ __forceinline__ float gelu_tanh(float x) { const float u = 0.7978845608028654f * (x + 0.044715f * x * x * x); return x * __builtin_amdgcn_rcpf(1.0f + __builtin_amdgcn_exp2f(-2.8853900817779268f * u)); }
__device__ __forceinline__ f32x4 ld_bf4(const bf16* p) { const u32x2 w = *(const u32x2*)p; return (f32x4){bf2f(w.x & 0xffffu), bf2f(w.x >> 16), bf2f(w.y & 0xffffu), bf2f(w.y >> 16)}; }
__device__ __forceinline__ void st_bf4(bf16* p, f32x4 v) { u32x2 w; w.x = pk2(v.x, v.y); w.y = pk2(v.z, v.w); *(u32x2*)p = w; }

struct Args { const float* in[26]; float* out; unsigned char* ws; };

struct EpiZ {
    static constexpr bool PERM = true, AFTER_DRAIN = false;
    bf16* O; const float* ssq;
    __device__ __forceinline__ void operator()(const pg8::f32x4 (&acc)[2][2][4][2], const pg8::Unit& u, int wr, int wc, int fr, int fq) const {
        const int row0 = u.pm * 256 + wr * 64 + fr, col0 = u.pn * 256 + wc * 32 + 8 * fq;
#pragma unroll
        for (int ai = 0; ai < 2; ++ai)
#pragma unroll
            for (int m = 0; m < 4; ++m) {
                const int row = row0 + ai * 128 + m * 16;
                const f32x4 sq = *(const f32x4*)(ssq + 4 * (size_t)row);
                const float rs = __builtin_amdgcn_rsqf(((sq.x + sq.y) + (sq.z + sq.w)) * (1.0f / DM) + EPS);
                bf16* rowp = O + (size_t)row * DIN + col0;
#pragma unroll
                for (int bj = 0; bj < 2; ++bj) {
                    const f32x4 v0 = acc[ai][bj][m][0] * rs, v1 = acc[ai][bj][m][1] * rs;
                    u32x4 w; w.x = pk2(v0[0], v0[1]); w.y = pk2(v0[2], v0[3]); w.z = pk2(v1[0], v1[1]); w.w = pk2(v1[2], v1[3]);
                    *(u32x4*)(rowp + bj * 128) = w;
                }
            }
    }
};
struct EpiRes {
    static constexpr bool PERM = true, AFTER_DRAIN = false;
    bf16* X; float* ssq_out; LAS float* P;
    LAS unsigned char* ring; bool xpre;
    __device__ __forceinline__ void operator()(const pg8::f32x4 (&acc)[2][2][4][2], const pg8::Unit& u, int wr, int wc, int fr, int fq) const {
        const int row0 = u.pm * 256 + wr * 64 + fr, col0 = u.pn * 256 + wc * 32 + 8 * fq;
        if (xpre) { asm volatile("s_waitcnt vmcnt(0)" ::: "memory"); __builtin_amdgcn_s_barrier(); asm volatile("" ::: "memory"); }
#pragma unroll
        for (int ai = 0; ai < 2; ++ai) {
            u32x4 xin[4][2];
#pragma unroll
            for (int m = 0; m < 4; ++m)
#pragma unroll
                for (int bj = 0; bj < 2; ++bj) {
                    const int q = 2 * (2 * bj + (wc >> 1)) + ai;
                    if (xpre && q < 7) {
                        const int boff = (q == 0 ? 4 : q == 1 ? 5 : q == 2 ? 0 : q == 3 ? 1 : q == 4 ? 6 : q == 5 ? 7 : 2) * 16384;
                        xin[m][bj] = *(const LAS u32x4*)(ring + boff + pg8::lds_byte(wr * 64 + m * 16 + fr, (wc & 1) * 32 + 8 * fq));
                    } else xin[m][bj] = *(const u32x4*)(X + (size_t)(row0 + ai * 128 + m * 16) * DM + col0 + bj * 128);
                }
#pragma unroll
            for (int m = 0; m < 4; ++m) {
                const int row = row0 + ai * 128 + m * 16;
                float q = 0.f;
#pragma unroll
                for (int bj = 0; bj < 2; ++bj) {
                    const u32x4 xi = xin[m][bj];
                    const f32x4 a0 = acc[ai][bj][m][0], a1 = acc[ai][bj][m][1];
                    const float y0 = bf2f(xi.x & 0xffffu) + a0[0], y1 = bf2f(xi.x >> 16) + a0[1], y2 = bf2f(xi.y & 0xffffu) + a0[2], y3 = bf2f(xi.y >> 16) + a0[3];
                    const float y4 = bf2f(xi.z & 0xffffu) + a1[0], y5 = bf2f(xi.z >> 16) + a1[1], y6 = bf2f(xi.w & 0xffffu) + a1[2], y7 = bf2f(xi.w >> 16) + a1[3];
                    q += (y0 * y0 + y1 * y1) + (y2 * y2 + y3 * y3) + (y4 * y4 + y5 * y5) + (y6 * y6 + y7 * y7);
                    u32x4 w; w.x = pk2(y0, y1); w.y = pk2(y2, y3); w.z = pk2(y4, y5); w.w = pk2(y6, y7);
                    *(u32x4*)(X + (size_t)row * DM + col0 + bj * 128) = w;
                }
                q += __shfl_xor(q, 16); q += __shfl_xor(q, 32);
                if (fq == 0) P[(ai * 128 + wr * 64 + m * 16 + fr) * 4 + wc] = q;
            }
        }
        asm volatile("s_waitcnt lgkmcnt(0)" ::: "memory"); __builtin_amdgcn_s_barrier(); asm volatile("" ::: "memory");
        const int t = (wr * 4 + wc) * 64 + fq * 16 + fr;
        if (t < 256) { const f32x4 v = *(const LAS f32x4*)(P + 4 * t); ssq_out[(size_t)(u.pm * 256 + t) * 4 + u.pn] = (v.x + v.y) + (v.z + v.w); }
    }
};
struct EpiFfn {
    static constexpr bool PERM = true, AFTER_DRAIN = false;
    bf16* act; const float* cw; float* st_out; const float* ssq;
    __device__ __forceinline__ void operator()(const pg8::f32x4 (&acc)[2][2][4][2], const pg8::Unit& u, int wr, int wc, int fr, int fq) const {
        const int bb = u.pm / 33, tt = u.pm % 33;
        const int t0 = tt * 252 + wr * 126 - 2 + 8 * fr;
        float rs[8];
#pragma unroll
        for (int j = 0; j < 8; ++j) { const f32x4 sq = *(const f32x4*)(ssq + 4 * (long)(bb * SEQ + t0 + j)); rs[j] = __builtin_amdgcn_rsqf(((sq.x + sq.y) + (sq.z + sq.w)) * (1.0f / DM) + EPS); }
#define DPP_SHR1(x) __builtin_bit_cast(float, __builtin_amdgcn_update_dpp(0, __builtin_bit_cast(int, (float)(x)), 0x111, 0xf, 0xf, true))
        const float rs6p = DPP_SHR1(rs[6]), rs7p = DPP_SHR1(rs[7]);
        const bool kill = (tt == 0) && (wr == 0) && (fr == 0);
        const int cu = u.pn * 128 + wc * 32 + 8 * fq;
        u32x4 outw[8];
#pragma unroll
        for (int n = 0; n < 2; ++n) {
            const int cn = cu + 4 * n;
            const f32x4 w0u = *(const f32x4*)(cw + cn), w1u = *(const f32x4*)(cw + DUP + cn), w2u = *(const f32x4*)(cw + 2 * DUP + cn);
            const f32x4 w0g = *(const f32x4*)(cw + DFF + cn), w1g = *(const f32x4*)(cw + DUP + DFF + cn), w2g = *(const f32x4*)(cw + 2 * DUP + DFF + cn);
            f32x4 pu6, pu7, pg6, pg7;
#pragma unroll
            for (int e = 0; e < 4; ++e) {
                pu6[e] = DPP_SHR1(acc[1][0][2][n][e]) * rs6p; pu7[e] = DPP_SHR1(acc[1][0][3][n][e]) * rs7p;
                pg6[e] = DPP_SHR1(acc[1][1][2][n][e]) * rs6p; pg7[e] = DPP_SHR1(acc[1][1][3][n][e]) * rs7p;
            }
            typedef float f2 __attribute__((ext_vector_type(2)));
            const f2 w0ua = w0u.xy, w0ub = w0u.zw, w1ua = w1u.xy, w1ub = w1u.zw, w2ua = w2u.xy, w2ub = w2u.zw;
            const f2 w0ga = w0g.xy, w0gb = w0g.zw, w1ga = w1g.xy, w1gb = w1g.zw, w2ga = w2g.xy, w2gb = w2g.zw;
            f2 um2a = pu6.xy, um2b = pu6.zw, um1a = pu7.xy, um1b = pu7.zw, gm2a = pg6.xy, gm2b = pg6.zw, gm1a = pg7.xy, gm1b = pg7.zw;
#pragma unroll
            for (int j = 0; j < 8; ++j) {
                const f32x4 au = acc[j >> 2][0][j & 3][n], ag = acc[j >> 2][1][j & 3][n];
                const f2 rsv = (f2){rs[j], rs[j]};
                f2 Ua = au.xy * rsv, Ub = au.zw * rsv, Ga = ag.xy * rsv, Gb = ag.zw * rsv;
                const int t = t0 + j;
                if (j < 2) { const f2 z = (f2){0.f, 0.f}; Ua = kill ? z : Ua; Ub = kill ? z : Ub; Ga = kill ? z : Ga; Gb = kill ? z : Gb; }
                const f2 uca = __builtin_elementwise_fma(w0ua, um2a, __builtin_elementwise_fma(w1ua, um1a, w2ua * Ua));
                const f2 ucb = __builtin_elementwise_fma(w0ub, um2b, __builtin_elementwise_fma(w1ub, um1b, w2ub * Ub));
                const f2 gca = __builtin_elementwise_fma(w0ga, gm2a, __builtin_elementwise_fma(w1ga, gm1a, w2ga * Ga));
                const f2 gcb = __builtin_elementwise_fma(w0gb, gm2b, __builtin_elementwise_fma(w1gb, gm1b, w2gb * Gb));
                const f2 nl = (f2){-1.4426950408889634f, -1.4426950408889634f}, one = (f2){1.f, 1.f};
                const f2 xa = gca * nl, xb = gcb * nl;
                f2 ea, eb; ea.x = __builtin_amdgcn_exp2f(xa.x); ea.y = __builtin_amdgcn_exp2f(xa.y); eb.x = __builtin_amdgcn_exp2f(xb.x); eb.y = __builtin_amdgcn_exp2f(xb.y);
                const f2 da = ea + one, db = eb + one;
                f2 ra, rb; ra.x = __builtin_amdgcn_rcpf(da.x); ra.y = __builtin_amdgcn_rcpf(da.y); rb.x = __builtin_amdgcn_rcpf(db.x); rb.y = __builtin_amdgcn_rcpf(db.y);
                const f2 oa = (uca * gca) * ra, ob = (ucb * gcb) * rb;
                if (n == 0) { outw[j].x = pk2(oa.x, oa.y); outw[j].y = pk2(ob.x, ob.y); } else { outw[j].z = pk2(oa.x, oa.y); outw[j].w = pk2(ob.x, ob.y); }
                if (t >= SEQ - 2 && t < SEQ && (8 * fr + j >= 2)) {
                    float* so = st_out + (size_t)(bb * 2 + (t - (SEQ - 2))) * DUP + cn;
                    *(f32x4*)so = (f32x4){Ua.x, Ua.y, Ub.x, Ub.y}; *(f32x4*)(so + DFF) = (f32x4){Ga.x, Ga.y, Gb.x, Gb.y};
                }
                um2a = um1a; um2b = um1b; um1a = Ua; um1b = Ub; gm2a = gm1a; gm2b = gm1b; gm1a = Ga; gm1b = Gb;
            }
        }
#pragma unroll
        for (int j = 0; j < 8; ++j) {
            const int t = t0 + j;
            if ((8 * fr + j >= 2) && (t < SEQ)) *(u32x4*)(act + (size_t)(bb * SEQ + t) * DFF + cu) = outw[j];
        }
    }
};

constexpr int SG_PITCH = 2832;
template <int MODE>
__device__ __forceinline__ void small_gemm_unit(LAS unsigned char* lds, int j, const bf16* Ap, const bf16* Bt, int K,
                                                bf16* obf, int ldo, const float* base, float* outf,
                                                const float* cw, const float* fbuf, float* fst) {
    int tid_o = threadIdx.x; asm volatile("" : "+v"(tid_o)); const int tid = tid_o, w = tid >> 6, lane = tid & 63, fr = lane & 15, fq = lane >> 4;
    const int row = 16 * w + fr;
    int bn0, bn1;
    if (MODE == 2) { bn0 = 256 * ((16 * j) / 128) + ((16 * j) % 128); bn1 = bn0 + 128; } else { bn0 = 32 * j; bn1 = bn0 + 16; }
    pg8::f32x4 acc0 = {0.f, 0.f, 0.f, 0.f}, acc1 = {0.f, 0.f, 0.f, 0.f};
    float ssq = 0.f;
    const bf16* ap = Ap + (size_t)row * K + 8 * fq;
    const int KC = (K > 1024) ? 1408 : 1024;
    for (int kc = 0; kc < K; kc += KC) {
        const int kl = (K - kc) < KC ? (K - kc) : KC, parts = kl >> 3;
        u32x4 af[16];
#pragma unroll
        for (int i = 0; i < 16; ++i) af[i] = *(const u32x4*)(ap + kc + 32 * i);
        __syncthreads();
        {
            u32x4 sg[11];
#pragma unroll
            for (int i = 0; i < 11; ++i) {
                const int c = tid + NTHREADS * i;
                if (c < 32 * parts) { const int r = c / parts, p = c - r * parts; sg[i] = *(const u32x4*)(Bt + (size_t)((r < 16 ? bn0 + r : bn1 + r - 16)) * K + kc + 8 * p); }
            }
#pragma unroll
            for (int i = 0; i < 11; ++i) {
                const int c = tid + NTHREADS * i;
                if (c < 32 * parts) { const int r = c / parts, p = c - r * parts; *(LAS u32x4*)(lds + r * SG_PITCH + 16 * p) = sg[i]; }
            }
        }
        __syncthreads();
        const LAS unsigned char* b0p = lds + fr * SG_PITCH + 16 * fq;
        const LAS unsigned char* b1p = lds + (16 + fr) * SG_PITCH + 16 * fq;
        for (int g0 = 0; g0 < kl; g0 += 512) {
            const int nst = (kl - g0) < 512 ? ((kl - g0) >> 5) : 16;
            if (g0 > 0) {
#pragma unroll
                for (int i = 0; i < 16; ++i) if (i < nst) af[i] = *(const u32x4*)(ap + kc + g0 + 32 * i);
            }
#pragma unroll
            for (int i = 0; i < 16; ++i) {
                if (i < nst) {
                    const u32x4 au = af[i];
                    if (MODE != 1) {
                        const float x0 = bf2f(au.x & 0xffffu), x1 = bf2f(au.x >> 16), x2 = bf2f(au.y & 0xffffu), x3 = bf2f(au.y >> 16);
                        const float x4 = bf2f(au.z & 0xffffu), x5 = bf2f(au.z >> 16), x6 = bf2f(au.w & 0xffffu), x7 = bf2f(au.w >> 16);
                        ssq += (x0 * x0 + x1 * x1) + (x2 * x2 + x3 * x3) + (x4 * x4 + x5 * x5) + (x6 * x6 + x7 * x7);
                    }
                    const bf16x8 a = __builtin_bit_cast(bf16x8, au);
                    const int k0 = g0 + 32 * i;
                    const bf16x8 b0 = *(const LAS bf16x8*)(b0p + 2 * k0), b1 = *(const LAS bf16x8*)(b1p + 2 * k0);
                    acc0 = __builtin_amdgcn_mfma_f32_16x16x32_bf16(b0, a, acc0, 0, 0, 0);
                    acc1 = __builtin_amdgcn_mfma_f32_16x16x32_bf16(b1, a, acc1, 0, 0, 0);
                }
            }
        }
    }
    if (MODE != 1) { ssq += __shfl_xor(ssq, 16); ssq += __shfl_xor(ssq, 32); }
    if (MODE == 0) {
        const float rs = rsqrtf(ssq * (1.0f / DM) + EPS);
        bf16* o = obf + (size_t)row * ldo + 32 * j + 4 * fq;
        st_bf4(o, acc0 * rs); st_bf4(o + 16, acc1 * rs);
    } else if (MODE == 1) {
        const size_t off = (size_t)row * DM + 32 * j + 4 * fq;
        const f32x4 r0 = *(const f32x4*)(base + off) + acc0, r1 = *(const f32x4*)(base + off + 16) + acc1;
        *(f32x4*)(outf + off) = r0; *(f32x4*)(outf + off + 16) = r1;
        st_bf4(obf + off, r0); st_bf4(obf + off + 16, r1);
    } else {
        const float rs = rsqrtf(ssq * (1.0f / DM) + EPS);
        const int cu = 16 * j + 4 * fq;
        const f32x4 U = acc0 * rs, G = acc1 * rs;
        const float* b0r = fbuf + (size_t)(row * 2 + 0) * DUP + cu; const float* b1r = fbuf + (size_t)(row * 2 + 1) * DUP + cu;
        const f32x4 u0 = *(const f32x4*)b0r, u1 = *(const f32x4*)b1r, g0 = *(const f32x4*)(b0r + DFF), g1 = *(const f32x4*)(b1r + DFF);
        const f32x4 uc = *(const f32x4*)(cw + cu) * u0 + *(const f32x4*)(cw + DUP + cu) * u1 + *(const f32x4*)(cw + 2 * DUP + cu) * U;
        const f32x4 gc = *(const f32x4*)(cw + DFF + cu) * g0 + *(const f32x4*)(cw + DUP + DFF + cu) * g1 + *(const f32x4*)(cw + 2 * DUP + DFF + cu) * G;
        f32x4 a;
#pragma unroll
        for (int e = 0; e < 4; ++e) a[e] = uc[e] * gc[e] / (1.0f + __expf(-gc[e]));
        st_bf4(obf + (size_t)row * DFF + cu, a);
        float* s0 = fst + (size_t)(row * 2 + 0) * DUP + cu; float* s1 = fst + (size_t)(row * 2 + 1) * DUP + cu;
        *(f32x4*)s0 = u1; *(f32x4*)(s0 + DFF) = g1; *(f32x4*)s1 = U; *(f32x4*)(s1 + DFF) = G;
    }
    __syncthreads();
}

constexpr int SF_PITCH = 1040;
__device__ __forceinline__ void small_ffn_unit(LAS unsigned char* lds, int j3, const bf16* __restrict__ Ap, const bf16* __restrict__ Bt, bf16* __restrict__ obf,
                                               const float* __restrict__ cw, const float* __restrict__ fbuf, float* __restrict__ fst) {
    int tid_o = threadIdx.x; asm volatile("" : "+v"(tid_o)); const int tid = tid_o, w = tid >> 6, lane = tid & 63, fr = lane & 15, fq = lane >> 4;
    const int row = 16 * w + fr, bl0 = 3 * j3, nb = (176 - bl0) < 3 ? (176 - bl0) : 3, K = DM;
    pg8::f32x4 acc[3][2];
#pragma unroll
    for (int b = 0; b < 3; ++b) { acc[b][0] = (pg8::f32x4){0.f, 0.f, 0.f, 0.f}; acc[b][1] = acc[b][0]; }
    float ssq = 0.f;
    const bf16* ap = Ap + (size_t)row * K + 8 * fq;
    for (int kc = 0; kc < K; kc += 512) {
        u32x4 af[16];
#pragma unroll
        for (int i = 0; i < 16; ++i) af[i] = *(const u32x4*)(ap + kc + 32 * i);
        __syncthreads();
        {
            u32x4 sg[12];
#pragma unroll
            for (int i = 0; i < 12; ++i) {
                const int c = tid + NTHREADS * i, r = c >> 6, p = c & 63, b = r >> 5, rr = r & 31;
                if (b < nb) { const int bl = bl0 + b, bn0 = 256 * ((16 * bl) / 128) + ((16 * bl) % 128); sg[i] = *(const u32x4*)(Bt + (size_t)(rr < 16 ? bn0 + rr : bn0 + 128 + rr - 16) * K + kc + 8 * p); }
            }
#pragma unroll
            for (int i = 0; i < 12; ++i) {
                const int c = tid + NTHREADS * i, r = c >> 6, p = c & 63, b = r >> 5;
                if (b < nb) *(LAS u32x4*)(lds + r * SF_PITCH + 16 * p) = sg[i];
            }
        }
        __syncthreads();
#pragma unroll
        for (int i = 0; i < 16; ++i) {
            const u32x4 au = af[i];
            const float x0 = bf2f(au.x & 0xffffu), x1 = bf2f(au.x >> 16), x2 = bf2f(au.y & 0xffffu), x3 = bf2f(au.y >> 16);
            const float x4 = bf2f(au.z & 0xffffu), x5 = bf2f(au.z >> 16), x6 = bf2f(au.w & 0xffffu), x7 = bf2f(au.w >> 16);
            ssq += (x0 * x0 + x1 * x1) + (x2 * x2 + x3 * x3) + (x4 * x4 + x5 * x5) + (x6 * x6 + x7 * x7);
            const bf16x8 a = __builtin_bit_cast(bf16x8, au);
#pragma unroll
            for (int b = 0; b < 3; ++b) {
                if (b < nb) {
                    const bf16x8 b0 = *(const LAS bf16x8*)(lds + (32 * b + fr) * SF_PITCH + 16 * fq + 64 * i), b1 = *(const LAS bf16x8*)(lds + (32 * b + 16 + fr) * SF_PITCH + 16 * fq + 64 * i);
                    acc[b][0] = __builtin_amdgcn_mfma_f32_16x16x32_bf16(b0, a, acc[b][0], 0, 0, 0);
                    acc[b][1] = __builtin_amdgcn_mfma_f32_16x16x32_bf16(b1, a, acc[b][1], 0, 0, 0);
                }
            }
        }
    }
    ssq += __shfl_xor(ssq, 16); ssq += __shfl_xor(ssq, 32);
    const float rs = rsqrtf(ssq * (1.0f / DM) + EPS);
#pragma unroll
    for (int b = 0; b < 3; ++b) {
        if (b < nb) {
            const int cu = 16 * (bl0 + b) + 4 * fq;
            const f32x4 U = acc[b][0] * rs, G = acc[b][1] * rs;
            const float* b0r = fbuf + (size_t)(row * 2 + 0) * DUP + cu; const float* b1r = fbuf + (size_t)(row * 2 + 1) * DUP + cu;
            const f32x4 u0 = *(const f32x4*)b0r, u1 = *(const f32x4*)b1r, g0 = *(const f32x4*)(b0r + DFF), g1 = *(const f32x4*)(b1r + DFF);
            const f32x4 uc = *(const f32x4*)(cw + cu) * u0 + *(const f32x4*)(cw + DUP + cu) * u1 + *(const f32x4*)(cw + 2 * DUP + cu) * U;
            const f32x4 gc = *(const f32x4*)(cw + DFF + cu) * g0 + *(const f32x4*)(cw + DUP + DFF + cu) * g1 + *(const f32x4*)(cw + 2 * DUP + DFF + cu) * G;
            f32x4 a;
#pragma unroll
            for (int e = 0; e < 4; ++e) a[e] = uc[e] * gc[e] * __builtin_amdgcn_rcpf(1.0f + __builtin_amdgcn_exp2f(-1.4426950408889634f * gc[e]));
            st_bf4(obf + (size_t)row * DFF + cu, a);
            float* s0 = fst + (size_t)(row * 2 + 0) * DUP + cu; float* s1 = fst + (size_t)(row * 2 + 1) * DUP + cu;
            *(f32x4*)s0 = u1; *(f32x4*)(s0 + DFF) = g1; *(f32x4*)s1 = U; *(f32x4*)(s1 + DFF) = G;
        }
    }
    __syncthreads();
}

__device__ __forceinline__ void transpose_item(const float* __restrict__ W, int K, int N, bf16* __restrict__ WT, int upmap, LAS float* scr, int item, int lane, const float* __restrict__ gain) {
    const int nblk = N / 64, kb = item / nblk, nb = item % nblk, k0 = 64 * kb, n0 = 64 * nb;
    float v[64];
#pragma unroll
    for (int i = 0; i < 64; ++i) v[i] = __builtin_nontemporal_load(W + (size_t)(k0 + i) * N + n0 + lane);
    if (gain) {
#pragma unroll
        for (int i = 0; i < 64; ++i) v[i] *= gain[k0 + i];
    }
#pragma unroll
    for (int i = 0; i < 64; ++i) scr[i * 65 + lane] = v[i];
    asm volatile("s_waitcnt lgkmcnt(0)" ::: "memory");
    int r0 = n0;
    if (upmap) { r0 = (n0 < DFF) ? (256 * (n0 / 128) + (n0 % 128)) : (256 * ((n0 - DFF) / 128) + 128 + ((n0 - DFF) % 128)); }
    const int c = lane & 7;
#pragma unroll
    for (int j = 0; j < 8; ++j) { const int n = (lane >> 3) + 8 * j; const LAS float* s = scr + (8 * c) * 65 + n;
        u32x4 o; o.x = pk2(s[0 * 65], s[1 * 65]); o.y = pk2(s[2 * 65], s[3 * 65]); o.z = pk2(s[4 * 65], s[5 * 65]); o.w = pk2(s[6 * 65], s[7 * 65]);
        *(u32x4*)(WT + (size_t)(r0 + n) * K + k0 + 8 * c) = o; }
    asm volatile("s_waitcnt lgkmcnt(0)" ::: "memory");
}
__device__ __forceinline__ void rms_row_bf16(const float* xrow, bf16* orow, int lane) {
    f32x4 v[4]; float s = 0.f;
#pragma unroll
    for (int j = 0; j < 4; ++j) { v[j] = *(const f32x4*)(xrow + 4 * lane + 256 * j); s += (v[j].x * v[j].x + v[j].y * v[j].y) + (v[j].z * v[j].z + v[j].w * v[j].w); }
    const float rs = rsqrtf(wave_sum(s) * (1.0f / DM) + EPS);
#pragma unroll
    for (int j = 0; j < 4; ++j) st_bf4(orow + 4 * lane + 256 * j, v[j] * rs);
}
__device__ __forceinline__ void init_row(const float* xrow, bf16* orow, float* ssq, int lane) {
    f32x4 v[4]; float s = 0.f;
#pragma unroll
    for (int j = 0; j < 4; ++j) { v[j] = *(const f32x4*)(xrow + 4 * lane + 256 * j); s += (v[j].x * v[j].x + v[j].y * v[j].y) + (v[j].z * v[j].z + v[j].w * v[j].w); }
    s = wave_sum(s);
#pragma unroll
    for (int j = 0; j < 4; ++j) st_bf4(orow + 4 * lane + 256 * j, v[j]);
    if (lane == 0) *(f32x4*)ssq = (f32x4){s, 0.f, 0.f, 0.f};
}
__device__ __forceinline__ void final_row(const bf16* xrow, float ssq, const float* g, float* orow, int lane) {
    const float rs = rsqrtf(ssq * (1.0f / DM) + EPS);
#pragma unroll
    for (int j = 0; j < 4; ++j) { const f32x4 v = ld_bf4(xrow + 4 * lane + 256 * j); const f32x4 gg = *(const f32x4*)(g + 4 * lane + 256 * j); *(f32x4*)(orow + 4 * lane + 256 * j) = v * gg * rs; }
}
__device__ __forceinline__ void rms_row_f32(const float* xrow, const float* g, float* orow, int lane) {
    f32x4 v[4]; float s = 0.f;
#pragma unroll
    for (int j = 0; j < 4; ++j) { v[j] = *(const f32x4*)(xrow + 4 * lane + 256 * j); s += (v[j].x * v[j].x + v[j].y * v[j].y) + (v[j].z * v[j].z + v[j].w * v[j].w); }
    const float rs = rsqrtf(wave_sum(s) * (1.0f / DM) + EPS);
#pragma unroll
    for (int j = 0; j < 4; ++j) { const f32x4 gg = *(const f32x4*)(g + 4 * lane + 256 * j); *(f32x4*)(orow + 4 * lane + 256 * j) = v[j] * gg * rs; }
}

__device__ __forceinline__ void attn_prompt_unit(LAS unsigned char* lds, int b, int t0, const bf16* Z, bf16* MG, const float* sinks, const float* gout,
                                                 float* ck_out, float* cv_out) {
    int tid_o = threadIdx.x; asm volatile("" : "+v"(tid_o)); const int tid = tid_o, h = __builtin_amdgcn_readfirstlane(tid >> 6), lane = tid & 63, qi = lane & 31, hi = lane >> 5, g = h >> 2;
    LAS bf16* Ks = (LAS bf16*)lds;
    LAS bf16* Vt = (LAS bf16*)(lds + 55296);
    LAS float* SS = (LAS float*)(lds + 55296 + 51200);
    const bool wr_cache = (t0 >= SEQ - 128);
    bf16x8 qf[2][4];
#pragma unroll
    for (int sub = 0; sub < 2; ++sub) {
        const bf16* qp = Z + (size_t)(b * SEQ + t0 + 32 * sub + qi) * DIN + ZQ + 64 * h + 8 * hi;
#pragma unroll
        for (int st = 0; st < 4; ++st) qf[sub][st] = __builtin_nontemporal_load((const bf16x8*)(qp + 16 * st));
    }
    {
        u32x4 kvr[6], vvr[6];
#pragma unroll
        for (int i = 0; i < 6; ++i) {
            const int c = tid + NTHREADS * i, row = c >> 4, part = c & 15, gg = part >> 3, d8 = part & 7, tok = t0 - 128 + row;
            kvr[i] = (u32x4){0u, 0u, 0u, 0u}; vvr[i] = (u32x4){0u, 0u, 0u, 0u};
            if (tok >= 0) { const bf16* zr = Z + (size_t)(b * SEQ + tok) * DIN + gg * 64 + d8 * 8; kvr[i] = *(const u32x4*)(zr + ZK); vvr[i] = *(const u32x4*)(zr + ZV); }
        }
#pragma unroll
        for (int i = 0; i < 6; ++i) {
            const int c = tid + NTHREADS * i, row = c >> 4, part = c & 15, gg = part >> 3, d8 = part & 7, tok = t0 - 128 + row;
            const u32x4 kv = kvr[i], vv = vvr[i];
            *(LAS u32x4*)(Ks + (gg * 192 + row) * 72 + d8 * 8) = kv;
            LAS bf16* vt = Vt + (gg * 64 + d8 * 8) * 200 + (row ^ (4 * d8));
            vt[0 * 200] = (bf16)(vv.x & 0xffffu); vt[1 * 200] = (bf16)(vv.x >> 16); vt[2 * 200] = (bf16)(vv.y & 0xffffu); vt[3 * 200] = (bf16)(vv.y >> 16);
            vt[4 * 200] = (bf16)(vv.z & 0xffffu); vt[5 * 200] = (bf16)(vv.z >> 16); vt[6 * 200] = (bf16)(vv.w & 0xffffu); vt[7 * 200] = (bf16)(vv.w >> 16);
            if (wr_cache && row >= 128) {
                const size_t o = ((size_t)(tok - (SEQ - 128)) * 2 + gg) * 64 + d8 * 8;
                *(f32x4*)(ck_out + o) = (f32x4){bf2f(kv.x & 0xffffu), bf2f(kv.x >> 16), bf2f(kv.y & 0xffffu), bf2f(kv.y >> 16)};
                *(f32x4*)(ck_out + o + 4) = (f32x4){bf2f(kv.z & 0xffffu), bf2f(kv.z >> 16), bf2f(kv.w & 0xffffu), bf2f(kv.w >> 16)};
                *(f32x4*)(cv_out + o) = (f32x4){bf2f(vv.x & 0xffffu), bf2f(vv.x >> 16), bf2f(vv.y & 0xffffu), bf2f(vv.y >> 16)};
                *(f32x4*)(cv_out + o + 4) = (f32x4){bf2f(vv.z & 0xffffu), bf2f(vv.z >> 16), bf2f(vv.w & 0xffffu), bf2f(vv.w >> 16)};
            }
        }
    }
    __syncthreads();
    const float L2E = 1.4426950408889634f;
    const float sc = 0.125f * L2E, sinkl = sinks[h] * L2E;
    f32x16 O[2][2];
#pragma unroll
    for (int sub = 0; sub < 2; ++sub) {
        f32x16 S[5];
#pragma unroll
        for (int kt = 0; kt < 5; ++kt) {
#pragma unroll
            for (int r = 0; r < 16; ++r) S[kt][r] = 0.f;
            const LAS bf16* kp = Ks + (g * 192 + 32 * sub + 32 * kt + qi) * 72 + 8 * hi;
#pragma unroll
            for (int st = 0; st < 4; ++st) { const bf16x8 kf = *(const LAS bf16x8*)(kp + 16 * st); S[kt] = __builtin_amdgcn_mfma_f32_32x32x16_bf16(kf, qf[sub][st], S[kt], 0, 0, 0); }
        }
        float m = sinkl;
#pragma unroll
        for (int kt = 0; kt < 5; ++kt)
#pragma unroll
            for (int r = 0; r < 16; ++r) {
                const int keyrow = 8 * (r >> 2) + 4 * hi + (r & 3);
                bool valid = true;
                if (kt == 0) valid = keyrow >= qi;
                if (kt == 4) valid = keyrow <= qi;
                if (t0 - 128 + 32 * sub + 32 * kt + keyrow < 0) valid = false;
                const float s = valid ? S[kt][r] * sc : -INFINITY;
                S[kt][r] = s; m = fmaxf(m, s);
            }
        m = fmaxf(m, __shfl_xor(m, 32));
        float sum = 0.f;
#pragma unroll
        for (int kt = 0; kt < 5; ++kt)
#pragma unroll
            for (int r = 0; r < 16; ++r) { const float p = __builtin_amdgcn_exp2f(S[kt][r] - m); S[kt][r] = p; sum += p; }
        sum += __shfl_xor(sum, 32);
        sum += exp2f(sinkl - m);
        const float inv = 1.0f / sum;
        f32x16 o0, o1;
#pragma unroll
        for (int r = 0; r < 16; ++r) { o0[r] = 0.f; o1[r] = 0.f; }
#pragma unroll
        for (int kt = 0; kt < 5; ++kt)
#pragma unroll
            for (int hf = 0; hf < 2; ++hf) {
                u32x4 pw; pw.x = pk2(S[kt][8 * hf + 0], S[kt][8 * hf + 1]); pw.y = pk2(S[kt][8 * hf + 2], S[kt][8 * hf + 3]);
                pw.z = pk2(S[kt][8 * hf + 4], S[kt][8 * hf + 5]); pw.w = pk2(S[kt][8 * hf + 6], S[kt][8 * hf + 7]);
                const bf16x8 pb = __builtin_bit_cast(bf16x8, pw);
                const int kb = 32 * sub + 32 * kt + 16 * hf + 4 * hi;
                const int f0 = 4 * (qi >> 3), f1 = 4 * (4 + (qi >> 3));
                const LAS bf16* v0 = Vt + (g * 64 + qi) * 200;
                const LAS bf16* v1 = Vt + (g * 64 + 32 + qi) * 200;
                u32x4 a0, a1; const u32x2 x0 = *(const LAS u32x2*)(v0 + (kb ^ f0)), x1 = *(const LAS u32x2*)(v0 + ((kb + 8) ^ f0)), y0 = *(const LAS u32x2*)(v1 + (kb ^ f1)), y1 = *(const LAS u32x2*)(v1 + ((kb + 8) ^ f1));
                a0.x = x0.x; a0.y = x0.y; a0.z = x1.x; a0.w = x1.y; a1.x = y0.x; a1.y = y0.y; a1.z = y1.x; a1.w = y1.y;
                o0 = __builtin_amdgcn_mfma_f32_32x32x16_bf16(__builtin_bit_cast(bf16x8, a0), pb, o0, 0, 0, 0);
                o1 = __builtin_amdgcn_mfma_f32_32x32x16_bf16(__builtin_bit_cast(bf16x8, a1), pb, o1, 0, 0, 0);
            }
        float q2 = 0.f;
#pragma unroll
        for (int r = 0; r < 16; ++r) { o0[r] *= inv; o1[r] *= inv; q2 += o0[r] * o0[r] + o1[r] * o1[r]; }
        q2 += __shfl_xor(q2, 32);
        if (hi == 0) SS[(sub * 8 + h) * 32 + qi] = q2;
        O[sub][0] = o0; O[sub][1] = o1;
    }
    __syncthreads();
    {
        LAS bf16* OT = (LAS bf16*)lds + h * (64 * 72);
#pragma unroll
        for (int sub = 0; sub < 2; ++sub) {
            float tot = 0.f;
#pragma unroll
            for (int hh = 0; hh < 8; ++hh) tot += SS[(sub * 8 + hh) * 32 + qi];
            const float rs = rsqrtf(tot * (1.0f / 512.0f) + EPS);
#pragma unroll
            for (int dt = 0; dt < 2; ++dt)
#pragma unroll
                for (int rq = 0; rq < 4; ++rq) {
                    const int d = 32 * dt + 8 * rq + 4 * hi;
                    const f32x4 gg = *(const f32x4*)(gout + 64 * h + d);
                    f32x4 v; v.x = O[sub][dt][4 * rq + 0]; v.y = O[sub][dt][4 * rq + 1]; v.z = O[sub][dt][4 * rq + 2]; v.w = O[sub][dt][4 * rq + 3];
                    v = v * gg * rs;
                    u32x2 w2; w2.x = pk2(v.x, v.y); w2.y = pk2(v.z, v.w);
                    *(LAS u32x2*)(OT + (32 * sub + qi) * 72 + d) = w2;
                }
        }
        asm volatile("s_waitcnt lgkmcnt(0)" ::: "memory");
#pragma unroll
        for (int i = 0; i < 8; ++i) {
            const int q = 8 * i + (lane >> 3), ch = lane & 7;
            const u32x4 w4 = *(const LAS u32x4*)(OT + q * 72 + 8 * ch);
            *(u32x4*)(MG + (size_t)(b * SEQ + t0 + q) * DM + 64 * h + 8 * ch) = w4;
        }
    }
    __syncthreads();
}

__device__ __forceinline__ void attn_sample_unit(LAS unsigned char* lds, int s, const bf16* __restrict__ ZS, bf16* __restrict__ MGS, const float* __restrict__ sinks, const float* __restrict__ gout,
                                                 const float* __restrict__ ck, const float* __restrict__ cv, float* __restrict__ cko, float* __restrict__ cvo) {
    int tid_o = threadIdx.x; asm volatile("" : "+v"(tid_o)); const int tid = tid_o, w = tid >> 6, lane = tid & 63;
    LAS float* KS = (LAS float*)lds;
    LAS float* VS = (LAS float*)(lds + 68112);
    LAS float* QS = (LAS float*)(lds + 68112 + 66048);
    LAS float* SC = QS + 512;
    LAS float* RED = SC + 8 * 132;
    const bf16* zr = ZS + (size_t)s * DIN;
    const float* ckb = ck + (size_t)s * 16384; float* ckob = cko + (size_t)s * 16384;
    const float* cvb = cv + (size_t)s * 16384; float* cvob = cvo + (size_t)s * 16384;
    {
        f32x4 kr[8], vr[8];
#pragma unroll
        for (int i = 0; i < 8; ++i) { const int e = (tid + NTHREADS * i) * 4; kr[i] = __builtin_nontemporal_load((const f32x4*)(ckb + e)); vr[i] = __builtin_nontemporal_load((const f32x4*)(cvb + e)); }
#pragma unroll
        for (int i = 0; i < 8; ++i) {
            const int e = (tid + NTHREADS * i) * 4, row = e >> 7, col = e & 127;
            *(LAS f32x4*)(KS + row * 132 + col) = kr[i]; *(LAS f32x4*)(VS + row * 128 + col) = vr[i];
            if (row >= 1) { __builtin_nontemporal_store(kr[i], (f32x4*)(ckob + e - 128)); __builtin_nontemporal_store(vr[i], (f32x4*)(cvob + e - 128)); }
        }
        QS[tid] = bf2f(zr[ZQ + tid]);
        if (tid < 128) {
            const float kn = bf2f(zr[ZK + tid]), vn = bf2f(zr[ZV + tid]);
            KS[128 * 132 + tid] = kn; VS[128 * 128 + tid] = vn;
            ckob[127 * 128 + tid] = kn; cvob[127 * 128 + tid] = vn;
        }
    }
    __syncthreads();
    {
        const int part = tid >> 7, g = part >> 1, h0 = 4 * g + 2 * (part & 1);
        for (int pass = 0; pass < 2; ++pass) {
            const int j = pass ? 128 : (tid & 127);
            if (pass && (tid & 127) != 0) break;
            const LAS float* kp = KS + j * 132 + 64 * g; const LAS float* q0 = QS + h0 * 64; const LAS float* q1 = q0 + 64;
            float a0 = 0.f, a1 = 0.f;
#pragma unroll
            for (int d = 0; d < 64; d += 4) { const f32x4 kv = *(const LAS f32x4*)(kp + d), x0 = *(const LAS f32x4*)(q0 + d), x1 = *(const LAS f32x4*)(q1 + d);
                a0 += (kv.x * x0.x + kv.y * x0.y) + (kv.z * x0.z + kv.w * x0.w); a1 += (kv.x * x1.x + kv.y * x1.y) + (kv.z * x1.z + kv.w * x1.w); }
            SC[h0 * 132 + j] = a0 * 0.125f; SC[(h0 + 1) * 132 + j] = a1 * 0.125f;
        }
    }
    __syncthreads();
    {
        const float sink = sinks[w];
        const float s0 = SC[w * 132 + lane], s1 = SC[w * 132 + 64 + lane], s2 = (lane == 0) ? SC[w * 132 + 128] : -INFINITY;
        const float m = fmaxf(wave_max(fmaxf(fmaxf(s0, s1), s2)), sink);
        const float p0 = __expf(s0 - m), p1 = __expf(s1 - m), p2 = (lane == 0) ? __expf(s2 - m) : 0.f;
        const float inv = 1.0f / (wave_sum(p0 + p1 + p2) + __expf(sink - m));
        SC[w * 132 + lane] = p0 * inv; SC[w * 132 + 64 + lane] = p1 * inv; if (lane == 0) SC[w * 132 + 128] = p2 * inv;
    }
    __syncthreads();
    float o = 0.f;
    {
        const LAS float* pp = SC + w * 132; const LAS float* vp = VS + 64 * (w >> 2) + lane;
#pragma unroll 8
        for (int jj = 0; jj < 128; jj += 4) { const f32x4 p4 = *(const LAS f32x4*)(pp + jj);
            o += p4.x * vp[(jj + 0) * 128] + p4.y * vp[(jj + 1) * 128] + p4.z * vp[(jj + 2) * 128] + p4.w * vp[(jj + 3) * 128]; }
        o += pp[128] * vp[128 * 128];
    }
    const float q2 = wave_sum(o * o);
    if (lane == 0) RED[w] = q2;
    __syncthreads();
    float tot = 0.f;
#pragma unroll
    for (int ww = 0; ww < 8; ++ww) tot += RED[ww];
    const float rs = rsqrtf(tot * (1.0f / 512.0f) + EPS);
    MGS[(size_t)s * DM + tid] = (bf16)f2bf(o * rs * gout[tid]);
    __syncthreads();
}

template <int NTW>
__device__ __forceinline__ void sconv_unit(bool sample, int b, int t0, const bf16* __restrict__ Zp, bf16* __restrict__ MGp, const float* __restrict__ cw, const float* __restrict__ gout,
                                           const float* __restrict__ sbuf, float* __restrict__ st_out) {
    int tid_o = threadIdx.x; asm volatile("" : "+v"(tid_o)); const int tid = tid_o, w = tid >> 6, lane = tid & 63, c = 4 * lane;
    const f32x4 w0 = *(const f32x4*)(cw + c), w1 = *(const f32x4*)(cw + 256 + c), w2 = *(const f32x4*)(cw + 512 + c), gg = *(const f32x4*)(gout + 768 + c);
    const f32x4 zero = (f32x4){0.f, 0.f, 0.f, 0.f};
    f32x4 co[NTW];
    if (!sample) {
        const int tb = t0 + NTW * w;
        const bf16* zb = Zp + ((size_t)b * SEQ + tb) * DIN;
        u32x2 rc[NTW + 2], ru[NTW + 2], rb[NTW];
#pragma unroll
        for (int i = 0; i < NTW + 2; ++i) {
            rc[i] = (u32x2){0u, 0u}; ru[i] = (u32x2){0u, 0u};
            if (tb + i - 2 >= 0) { rc[i] = *(const u32x2*)(zb + (long)(i - 2) * DIN + ZSC + c); ru[i] = *(const u32x2*)(zb + (long)(i - 2) * DIN + ZSU + c); }
        }
#pragma unroll
        for (int k = 0; k < NTW; ++k) rb[k] = __builtin_nontemporal_load((const u32x2*)(zb + (size_t)k * DIN + ZSB + c));
        f32x4 v[NTW + 2];
#pragma unroll
        for (int i = 0; i < NTW + 2; ++i) {
            const f32x4 cc = (f32x4){bf2f(rc[i].x & 0xffffu), bf2f(rc[i].x >> 16), bf2f(rc[i].y & 0xffffu), bf2f(rc[i].y >> 16)};
            const f32x4 uu = (f32x4){bf2f(ru[i].x & 0xffffu), bf2f(ru[i].x >> 16), bf2f(ru[i].y & 0xffffu), bf2f(ru[i].y >> 16)};
            v[i] = cc * uu;
        }
#pragma unroll
        for (int k = 0; k < NTW; ++k) {
            const f32x4 bb = (f32x4){bf2f(rb[k].x & 0xffffu), bf2f(rb[k].x >> 16), bf2f(rb[k].y & 0xffffu), bf2f(rb[k].y >> 16)};
            co[k] = bb * (w0 * v[k] + w1 * v[k + 1] + w2 * v[k + 2]);
            const int t = tb + k;
            if (t >= SEQ - 2) *(f32x4*)(st_out + (size_t)(b * 2 + (t - (SEQ - 2))) * 256 + c) = v[k + 2];
        }
    } else if constexpr (NTW == 8) {
        const size_t sb = t0 + 8 * w;
        u32x2 rc[8], ru[8], rb[8]; f32x4 p0[8], p1[8];
#pragma unroll
        for (int k = 0; k < 8; ++k) {
            const bf16* zr = Zp + (sb + k) * DIN;
            rc[k] = *(const u32x2*)(zr + ZSC + c); ru[k] = *(const u32x2*)(zr + ZSU + c); rb[k] = *(const u32x2*)(zr + ZSB + c);
            p0[k] = *(const f32x4*)(sbuf + ((sb + k) * 2 + 0) * 256 + c); p1[k] = *(const f32x4*)(sbuf + ((sb + k) * 2 + 1) * 256 + c);
        }
#pragma unroll
        for (int k = 0; k < 8; ++k) {
            const f32x4 cc = (f32x4){bf2f(rc[k].x & 0xffffu), bf2f(rc[k].x >> 16), bf2f(rc[k].y & 0xffffu), bf2f(rc[k].y >> 16)};
            const f32x4 uu = (f32x4){bf2f(ru[k].x & 0xffffu), bf2f(ru[k].x >> 16), bf2f(ru[k].y & 0xffffu), bf2f(ru[k].y >> 16)};
            const f32x4 bb = (f32x4){bf2f(rb[k].x & 0xffffu), bf2f(rb[k].x >> 16), bf2f(rb[k].y & 0xffffu), bf2f(rb[k].y >> 16)};
            const f32x4 vcur = cc * uu;
            co[k] = bb * (w0 * p0[k] + w1 * p1[k] + w2 * vcur);
            *(f32x4*)(st_out + ((sb + k) * 2 + 0) * 256 + c) = p1[k]; *(f32x4*)(st_out + ((sb + k) * 2 + 1) * 256 + c) = vcur;
        }
    }
    (void)zero;
    float q[NTW];
#pragma unroll
    for (int k = 0; k < NTW; ++k) q[k] = (co[k].x * co[k].x + co[k].y * co[k].y) + (co[k].z * co[k].z + co[k].w * co[k].w);
#pragma unroll
    for (int o = 1; o < 64; o <<= 1)
#pragma unroll
        for (int k = 0; k < NTW; ++k) q[k] += __shfl_xor(q[k], o);
#pragma unroll
    for (int k = 0; k < NTW; ++k) {
        const size_t row = sample ? (size_t)(t0 + NTW * w + k) : ((size_t)b * SEQ + t0 + NTW * w + k);
        st_bf4(MGp + row * DM + 768 + c, co[k] * gg * rsqrtf(q[k] * (1.0f / 256.0f) + EPS));
    }
}

struct LruW { const float *cw, *cb, *ba, *bi, *lam, *gout; const bf16* lwt; };
__device__ __forceinline__ void lru_unit(LAS unsigned char* lds, bool sample, int b, int t0, const bf16* __restrict__ Zp, bf16* __restrict__ MGp, const LruW W,
                                         bf16* __restrict__ hloc, bf16* __restrict__ cuma, float* __restrict__ agga, float* __restrict__ aggb,
                                         const float* __restrict__ lbuf, const float* __restrict__ h0, float* __restrict__ lc_out, float* __restrict__ rg_out) {
    int tid_o = threadIdx.x; asm volatile("" : "+v"(tid_o)); const int tid = tid_o, w = __builtin_amdgcn_readfirstlane(tid >> 6), lane = tid & 63;
    LAS float* XC = (LAS float*)lds;
    constexpr int LP = 260;
    LAS bf16* XB = (LAS bf16*)(lds + 66560);
    LAS float* AA = (LAS float*)(lds + 66560);
    {
        const int cp = tid & 127, tg = tid >> 7, c = 2 * cp;
        const f32x2 k0 = *(const f32x2*)(W.cw + c), k1 = *(const f32x2*)(W.cw + 256 + c), k2 = *(const f32x2*)(W.cw + 512 + c), k3 = *(const f32x2*)(W.cw + 768 + c), bb = *(const f32x2*)(W.cb + c);
        if (!sample) {
            const int tb = t0 + 16 * tg;
            const bf16* zc = Zp + ((size_t)b * SEQ + tb) * DIN + ZLX + c;
            unsigned xr[19];
#pragma unroll
            for (int i = 0; i < 19; ++i) { xr[i] = 0u; if (tb + i - 3 >= 0) xr[i] = __builtin_nontemporal_load((const unsigned*)(zc + (long)(i - 3) * DIN)); }
#pragma unroll
            for (int i = 0; i < 16; ++i) {
                const f32x2 xm3 = (f32x2){bf2f(xr[i] & 0xffffu), bf2f(xr[i] >> 16)}, xm2 = (f32x2){bf2f(xr[i + 1] & 0xffffu), bf2f(xr[i + 1] >> 16)};
                const f32x2 xm1 = (f32x2){bf2f(xr[i + 2] & 0xffffu), bf2f(xr[i + 2] >> 16)}, x = (f32x2){bf2f(xr[i + 3] & 0xffffu), bf2f(xr[i + 3] >> 16)};
                const f32x2 xc = k0 * xm3 + k1 * xm2 + k2 * xm1 + k3 * x + bb;
                const int tok = 16 * tg + i;
                *(LAS f32x2*)(XC + tok * LP + c) = xc; *(LAS unsigned*)(XB + tok * 264 + c) = pk2(xc.x, xc.y);
                if (tb + i >= SEQ - 3) *(f32x2*)(lc_out + (size_t)(b * 3 + (tb + i - (SEQ - 3))) * 256 + c) = x;
            }
        } else {
#pragma unroll
            for (int i = 0; i < 16; ++i) {
                const int tok = 16 * tg + i; const size_t s = t0 + tok;
                const unsigned u = *(const unsigned*)(Zp + s * DIN + ZLX + c); const f32x2 x = (f32x2){bf2f(u & 0xffffu), bf2f(u >> 16)};
                const f32x2 xm3 = *(const f32x2*)(lbuf + (s * 3 + 0) * 256 + c), xm2 = *(const f32x2*)(lbuf + (s * 3 + 1) * 256 + c), xm1 = *(const f32x2*)(lbuf + (s * 3 + 2) * 256 + c);
                const f32x2 xc = k0 * xm3 + k1 * xm2 + k2 * xm1 + k3 * x + bb;
                *(LAS f32x2*)(XC + tok * LP + c) = xc; *(LAS unsigned*)(XB + tok * 264 + c) = pk2(xc.x, xc.y);
                *(f32x2*)(lc_out + (s * 3 + 0) * 256 + c) = xm2; *(f32x2*)(lc_out + (s * 3 + 1) * 256 + c) = xm1; *(f32x2*)(lc_out + (s * 3 + 2) * 256 + c) = x;
            }
        }
    }
    __syncthreads();
    const int blk = w & 3, dh = w >> 2, qi = lane & 31, hi = lane >> 5, ch = 64 * blk + 32 * dh + qi;
    f32x16 ar[2], ai[2];
    {
        bf16x8 bw[2][4];
#pragma unroll
        for (int gt = 0; gt < 2; ++gt)
#pragma unroll
            for (int st = 0; st < 4; ++st) bw[gt][st] = *(const bf16x8*)(W.lwt + ((size_t)(gt * 4 + blk) * 64 + 32 * dh + qi) * 64 + 16 * st + 8 * hi);
#pragma unroll
        for (int tt = 0; tt < 2; ++tt) {
#pragma unroll
            for (int r = 0; r < 16; ++r) { ar[tt][r] = 0.f; ai[tt][r] = 0.f; }
#pragma unroll
            for (int st = 0; st < 4; ++st) {
                const bf16x8 af = *(const LAS bf16x8*)(XB + (32 * tt + qi) * 264 + 64 * blk + 16 * st + 8 * hi);
                ar[tt] = __builtin_amdgcn_mfma_f32_32x32x16_bf16(af, bw[0][st], ar[tt], 0, 0, 0);
                ai[tt] = __builtin_amdgcn_mfma_f32_32x32x16_bf16(af, bw[1][st], ai[tt], 0, 0, 0);
            }
        }
    }
    __syncthreads();
    {
        const float ba = W.ba[ch], bi = W.bi[ch], lam = W.lam[ch];
        const float c8 = -8.0f * log1pf(__expf(-lam));
#pragma unroll
        for (int tt = 0; tt < 2; ++tt)
#pragma unroll
            for (int r = 0; r < 16; ++r) {
                const int tok = 32 * tt + 8 * (r >> 2) + 4 * hi + (r & 3);
                const float xc = XC[tok * LP + ch];
                const float rg = sigmoidf_(ar[tt][r] + ba), ig = sigmoidf_(ai[tt][r] + bi);
                const float la = c8 * rg, a = __builtin_amdgcn_exp2f(1.4426950408889634f * la), x2 = 2.0f * la, mult = __builtin_amdgcn_sqrtf(fmaxf(-x2 * (1.0f + x2 * (0.5f + x2 * (0.16666667f + x2 * (0.041666668f + x2 * (0.0083333338f + x2 * 0.0013888889f))))), 0.f));
                AA[tok * LP + ch] = a; XC[tok * LP + ch] = mult * ig * xc;
            }
    }
    __syncthreads();
    if (!sample) {
        const int half = tid >> 8, ch = tid & 255;
        float hl[32], cl[32];
        {
            float hh = 0.f, cum = 1.f;
#pragma unroll
            for (int i = 0; i < 32; ++i) { const int tok = 32 * half + i; const float a = AA[tok * LP + ch]; hh = a * hh + XC[tok * LP + ch]; cum *= a; hl[i] = hh; cl[i] = cum; }
        }
        __syncthreads();
        if (!half) { XC[ch] = hl[31]; XC[256 + ch] = cl[31]; }
        __syncthreads();
        if (half) {
            const float h1 = XC[ch], c1 = XC[256 + ch];
#pragma unroll
            for (int i = 0; i < 32; ++i) { hl[i] += cl[i] * h1; cl[i] *= c1; }
            const int chunk = t0 >> 6;
            agga[(size_t)(b * 128 + chunk) * 256 + ch] = cl[31]; aggb[(size_t)(b * 128 + chunk) * 256 + ch] = hl[31];
        }
        const size_t rb = ((size_t)b * SEQ + t0 + 32 * half) * 256 + ch;
#pragma unroll
        for (int i = 0; i < 32; ++i) { hloc[rb + (size_t)i * 256] = (bf16)f2bf(hl[i]); cuma[rb + (size_t)i * 256] = (bf16)f2bf(cl[i]); }
    } else {
        const int c = tid & 255, tk0 = (tid >> 8) * 32;
        float h0r[32]; unsigned short gr[32];
#pragma unroll
        for (int i = 0; i < 32; ++i) { const size_t s = t0 + tk0 + i; h0r[i] = h0[s * 256 + c]; gr[i] = Zp[s * DIN + ZLG + c]; }
#pragma unroll
        for (int i = 0; i < 32; ++i) {
            const int tok = tk0 + i; const size_t s = t0 + tok;
            const float hh = AA[tok * LP + c] * h0r[i] + XC[tok * LP + c];
            rg_out[s * 256 + c] = hh;
            XC[tok * LP + c] = hh * gelu_tanh(bf2f(gr[i]));
        }
        __syncthreads();
        for (int it = 0; it < 8; ++it) {
            const int tok = it * 8 + w; const size_t s = t0 + tok;
            const f32x4 v = *(const LAS f32x4*)(XC + tok * LP + 4 * lane);
            const float rs = rsqrtf(wave_sum((v.x * v.x + v.y * v.y) + (v.z * v.z + v.w * v.w)) * (1.0f / 256.0f) + EPS);
            st_bf4(MGp + s * DM + 512 + 4 * lane, v * *(const f32x4*)(W.gout + 512 + 4 * lane) * rs);
        }
    }
    __syncthreads();
}

__device__ __forceinline__ void lru_fix_unit(LAS unsigned char* lds, int b, int chunk, const bf16* __restrict__ Z, bf16* __restrict__ MG, const float* __restrict__ gout,
                                             const bf16* __restrict__ hloc, const bf16* __restrict__ cuma, const float* __restrict__ agga, const float* __restrict__ aggb, float* __restrict__ rg_out) {
    int tid_o = threadIdx.x; asm volatile("" : "+v"(tid_o)); const int tid = tid_o, w = tid >> 6, lane = tid & 63;
    LAS float* CR = (LAS float*)lds;
    const size_t row0 = (size_t)b * SEQ + chunk * 64 + 8 * w;
    u32x2 hlr[8], car[8]; u32x2 gr[8];
#pragma unroll
    for (int k = 0; k < 8; ++k) { hlr[k] = __builtin_nontemporal_load((const u32x2*)(hloc + (row0 + k) * 256 + 4 * lane)); car[k] = __builtin_nontemporal_load((const u32x2*)(cuma + (row0 + k) * 256 + 4 * lane)); gr[k] = __builtin_nontemporal_load((const u32x2*)(Z + (row0 + k) * DIN + ZLG + 4 * lane)); }
    {
        const int half = tid >> 8, ch = tid & 255, n1 = chunk >> 1, j0 = half ? n1 : 0, j1 = half ? chunk : n1;
        const float* pa = agga + (size_t)b * 128 * 256 + ch; const float* pb = aggb + (size_t)b * 128 * 256 + ch;
        float A = 1.f, B = 0.f;
#pragma unroll 32
        for (int j = j0; j < j1; ++j) { const float a = pa[(size_t)j * 256], bb = pb[(size_t)j * 256]; B = a * B + bb; A *= a; }
        if (half) { CR[ch] = A; CR[256 + ch] = B; }
        __syncthreads();
        if (!half) CR[512 + ch] = CR[ch] * B + CR[256 + ch];
        __syncthreads();
    }
    const f32x4 cr = *(const LAS f32x4*)(CR + 512 + 4 * lane), gg = *(const f32x4*)(gout + 512 + 4 * lane);
    f32x4 bo[8]; float q[8];
#pragma unroll
    for (int k = 0; k < 8; ++k) {
        const f32x4 hlk = (f32x4){bf2f(hlr[k].x & 0xffffu), bf2f(hlr[k].x >> 16), bf2f(hlr[k].y & 0xffffu), bf2f(hlr[k].y >> 16)};
        const f32x4 cak = (f32x4){bf2f(car[k].x & 0xffffu), bf2f(car[k].x >> 16), bf2f(car[k].y & 0xffffu), bf2f(car[k].y >> 16)};
        const f32x4 hh = hlk + cak * cr;
        const f32x4 gt = (f32x4){bf2f(gr[k].x & 0xffffu), bf2f(gr[k].x >> 16), bf2f(gr[k].y & 0xffffu), bf2f(gr[k].y >> 16)};
        bo[k].x = hh.x * gelu_tanh(gt.x); bo[k].y = hh.y * gelu_tanh(gt.y); bo[k].z = hh.z * gelu_tanh(gt.z); bo[k].w = hh.w * gelu_tanh(gt.w);
        q[k] = (bo[k].x * bo[k].x + bo[k].y * bo[k].y) + (bo[k].z * bo[k].z + bo[k].w * bo[k].w);
        if (chunk * 64 + 8 * w + k == SEQ - 1) *(f32x4*)(rg_out + (size_t)b * 256 + 4 * lane) = hh;
    }
#pragma unroll
    for (int o = 1; o < 64; o <<= 1)
#pragma unroll
        for (int k = 0; k < 8; ++k) q[k] += __shfl_xor(q[k], o);
#pragma unroll
    for (int k = 0; k < 8; ++k) st_bf4(MG + (row0 + k) * DM + 512 + 4 * lane, bo[k] * gg * rsqrtf(q[k] * (1.0f / 256.0f) + EPS));
    __syncthreads();
}

#define XB_TMO      128
#define XB_XCNT(j)  (256  + 64 * (j))
#define XB_XSUB(j)  (1280 + 64 * (j))
#define XB_XGEN(j)  (2304 + 64 * (j))
#define XB_TOP      3328
#define XB_TOPGEN   3392
#define XCD_BAR_WORDS 3456
#define XB_SPIN_CAP (1u << 18)

__device__ __forceinline__ unsigned xb_ld(unsigned* p)              { return __hip_atomic_load(p, __ATOMIC_RELAXED, __HIP_MEMORY_SCOPE_AGENT); }
__device__ __forceinline__ unsigned xb_add(unsigned* p, unsigned v) { return __hip_atomic_fetch_add(p, v, __ATOMIC_RELAXED, __HIP_MEMORY_SCOPE_AGENT); }
__device__ __forceinline__ unsigned xb_xcc_id() { return (unsigned)__builtin_amdgcn_s_getreg((3 << 11) | 20) & 0xFu; }
#define XB_SPIN(cond, bar) do { unsigned _sp = 0; while (cond) { __builtin_amdgcn_s_sleep(1); \
    if ((++_sp & 255u) == 0u) { if (xb_ld(&(bar)[XB_TMO])) break; if (_sp > XB_SPIN_CAP) { atomicAdd(&(bar)[XB_TMO], 1u); break; } } } } while (0)

struct XcdBarrier {
    unsigned* bar; unsigned x;
    volatile LAS unsigned* st;
};

__device__ __forceinline__ XcdBarrier xcd_barrier_post(unsigned* bar, volatile LAS unsigned* st) {
    XcdBarrier b; b.bar = bar; b.x = xb_xcc_id(); b.st = st;
    if (threadIdx.x == 0) (void)xb_add(&bar[XB_XCNT(b.x)], 1u);
    return b;
}
__device__ __forceinline__ void xcd_barrier_complete(unsigned* bar, unsigned x, unsigned& nloc, unsigned& nx) {
    const unsigned G = gridDim.x * gridDim.y * gridDim.z;
    unsigned sum, cnt, mine, sp = 0u;
    for (;;) {
        sum = 0u; cnt = 0u; mine = 0u;
#pragma unroll
        for (unsigned j = 0; j < 16; ++j) { const unsigned c = xb_ld(&bar[XB_XCNT(j)]); sum += c; cnt += (c > 0u) ? 1u : 0u; mine = (j == x) ? c : mine; }
        if (sum == G) break;
        __builtin_amdgcn_s_sleep(1);
        if ((++sp & 255u) == 0u) { if (xb_ld(&bar[XB_TMO])) break; if (sp > XB_SPIN_CAP) { atomicAdd(&bar[XB_TMO], 1u); break; } }
    }
    nloc = mine > 0u ? mine : 1u; nx = cnt > 0u ? cnt : 1u;
}

__device__ __forceinline__ void xcd_barrier(const XcdBarrier& b) {
    asm volatile("s_waitcnt vmcnt(0)" ::: "memory");
    __syncthreads();
    if (threadIdx.x == 0) {
        unsigned* bar = b.bar;
        __builtin_amdgcn_s_waitcnt(0);
        unsigned nloc = b.st[0], nx = b.st[1];
        if (nloc == 0u) { xcd_barrier_complete(bar, b.x, nloc, nx); b.st[0] = nloc; b.st[1] = nx; }
        const unsigned old = xb_add(&bar[XB_XSUB(b.x)], 1u);
        const unsigned gen = old / nloc;
        if (old + 1u == (gen + 1u) * nloc) {
            __builtin_amdgcn_fence(__ATOMIC_RELEASE, "agent");
            asm volatile("s_waitcnt vmcnt(0)" ::: "memory");
            const unsigned og = xb_add(&bar[XB_TOP], 1u);
            const unsigned tg = og / nx;
            if (og + 1u == (tg + 1u) * nx) xb_add(&bar[XB_TOPGEN], 1u);
            else XB_SPIN(xb_ld(&bar[XB_TOPGEN]) == tg, bar);
            __builtin_amdgcn_fence(__ATOMIC_ACQUIRE, "agent");
            xb_add(&bar[XB_XGEN(b.x)], 1u);
            asm volatile("s_waitcnt vmcnt(0)" ::: "memory");
        } else {
            XB_SPIN(xb_ld(&bar[XB_XGEN(b.x)]) == gen, bar);
            __builtin_amdgcn_fence(__ATOMIC_ACQUIRE, "agent");
            asm volatile("s_waitcnt vmcnt(0)" ::: "memory");
        }
    }
    __syncthreads();
}

typedef const Args __attribute__((address_space(4))) * KArgsP;
__device__ __forceinline__ KArgsP kargs() { KArgsP p = (KArgsP)__builtin_amdgcn_kernarg_segment_ptr(); asm volatile("" : "+s"(p)); return p; }
#define IN(i) (ka->in[i])
#define WSP(T, off) ((T*)(ka->ws + (off)))
#define OUTP(off) (ka->out + (off))
#define PHASE_VARS KArgsP ka = kargs(); int tid_o = threadIdx.x; asm volatile("" : "+v"(tid_o)); const int tid = tid_o, lane = tid & 63, wave = __builtin_amdgcn_readfirstlane(tid >> 6); \
    const int G = gridDim.x, cu = blockIdx.x, gw = cu * NWAVES + wave, NGW = G * NWAVES; (void)lane; (void)gw; (void)NGW; (void)ka;

#ifndef REP_AT
#define REP_AT 1
#endif
#ifndef REP_LR
#define REP_LR 1
#endif
#ifndef REP_SC
#define REP_SC 1
#endif
#ifndef REP_LF
#define REP_LF 1
#endif
#ifndef REP_AS
#define REP_AS 1
#endif
#ifndef REP_SG
#define REP_SG 1
#endif
#ifndef REP_LS
#define REP_LS 1
#endif
#ifndef REP_P1
#define REP_P1 1
#endif
#ifndef REP_P2
#define REP_P2 1
#endif
#ifndef REP_P3
#define REP_P3 1
#endif
#ifndef REP_P5
#define REP_P5 1
#endif
#ifndef REP_P0
#define REP_P0 1
#endif
__global__ void __launch_bounds__(NTHREADS, 2) fwd_megakernel(Args args) {
    extern __shared__ __attribute__((aligned(16))) unsigned char lds_raw[];
    LAS unsigned char* lds = (LAS unsigned char*)lds_raw;
    cg::grid_group grid = cg::this_grid();
    volatile LAS unsigned* MISC = (volatile LAS unsigned*)(lds + 147392);
    if (threadIdx.x < 16) MISC[threadIdx.x] = 0u;
    __syncthreads();
    const XcdBarrier bar = xcd_barrier_post((unsigned*)(args.ws + 16384), MISC + 8);

    for (int rep_ = 0; rep_ < REP_P0; ++rep_)
    {
        PHASE_VARS
        LAS float* scr = (LAS float*)(lds + wave * 16640);
        constexpr int I_IN = 16 * 32, I_OUT = 16 * 16, I_UP = 16 * 88, I_DN = 44 * 16, I_L = I_IN + I_OUT + I_UP + I_DN;
        for (int it = gw; it < DEPTH * I_L; it += NGW) {
            const int l = it / I_L; int r = it % I_L;
            unsigned char* wl = ka->ws + WS_W + (size_t)l * W_LAYER;
            if (r < I_IN) { transpose_item(IN(9) + (size_t)l * DM * DIN, DM, DIN, (bf16*)(wl + W_IN), 0, scr, r, lane, IN(8) + (size_t)l * DM); continue; } r -= I_IN;
            if (r < I_OUT) { transpose_item(IN(20) + (size_t)l * DM * DM, DM, DM, (bf16*)(wl + W_OUT), 0, scr, r, lane, nullptr); continue; } r -= I_OUT;
            if (r < I_UP) { transpose_item(IN(22) + (size_t)l * DM * DUP, DM, DUP, (bf16*)(wl + W_UP), 1, scr, r, lane, IN(21) + (size_t)l * DM); continue; } r -= I_UP;
            transpose_item(IN(24) + (size_t)l * DFF * DM, DFF, DM, (bf16*)(wl + W_DOWN), 0, scr, r, lane, nullptr);
        }
        bf16* LWT = WSP(bf16, WS_LWT);
        for (int e = cu * NTHREADS + tid; e < DEPTH * 2 * 4 * 4096; e += G * NTHREADS) {
            const int c = e & 63, d = (e >> 6) & 63, blk = (e >> 12) & 3, gt = (e >> 14) & 1, l = e >> 15;
            const float* src = gt ? IN(15) : IN(13);
            LWT[e] = (bf16)f2bf(src[((size_t)(l * 4 + blk) * 64 + c) * 64 + d]);
        }
        const float* xp = IN(0); bf16* X = WSP(bf16, WS_X); float* SSQB = WSP(float, WS_SSQB); float* SSQA = WSP(float, WS_SSQA);
        for (int m0 = gw; m0 < MP; m0 += 4 * NGW) {
            f32x4 v[4][4];
#pragma unroll
            for (int r = 0; r < 4; ++r) { const int m = m0 + r * NGW; if (m < MP) {
#pragma unroll
                for (int j = 0; j < 4; ++j) v[r][j] = __builtin_nontemporal_load((const f32x4*)(xp + (size_t)m * DM + 4 * lane + 256 * j)); } }
#pragma unroll
            for (int r = 0; r < 4; ++r) { const int m = m0 + r * NGW; if (m < MP) {
                float q = 0.f;
#pragma unroll
                for (int j = 0; j < 4; ++j) { q += (v[r][j].x * v[r][j].x + v[r][j].y * v[r][j].y) + (v[r][j].z * v[r][j].z + v[r][j].w * v[r][j].w); st_bf4(X + (size_t)m * DM + 4 * lane + 256 * j, v[r][j]); }
                q = wave_sum(q);
                if (lane == 0) *(f32x4*)(SSQB + 4 * (size_t)m) = (f32x4){q, 0.f, 0.f, 0.f}; } }
        }
        (void)SSQA;
        { const float* xs0 = IN(1); bf16* XSB = WSP(bf16, WS_XSB);
          for (int e = (cu * NTHREADS + tid) * 4; e < NS * DM; e += G * NTHREADS * 4) st_bf4(XSB + e, *(const f32x4*)(xs0 + e)); }
    }
    xcd_barrier(bar);
    if (gridDim.x == 0x7fffffffu) grid.sync();

#pragma nounroll
    for (int l = 0; l < DEPTH; ++l) {
        for (int rep_ = 0; rep_ < REP_P1; ++rep_)
        {
            PHASE_VARS
            const bf16* Win_t = (const bf16*)(ka->ws + WS_W + (size_t)l * W_LAYER + W_IN);
            pg8::Gemm g{WSP(bf16, WS_X), Win_t, MP, DIN, DM}; pg8::StaticOrder S; S.init(MP, DIN, G, cu);
            EpiZ E{WSP(bf16, WS_Z), WSP(float, WS_SSQB)};
            pg8::gemm_phase<EpiZ, pg8::StaticOrder, true, true, false>(lds, g, S, E);
        }
        xcd_barrier(bar);

        for (int rep_ = 0; rep_ < REP_P2; ++rep_)
        {
            PHASE_VARS
            const float* gout = IN(19) + (size_t)l * DM;
            const float* sinks = IN(10) + l * 8;
            LruW LW{IN(11) + (size_t)l * 4 * 256, IN(12) + (size_t)l * 256, IN(14) + (size_t)l * 256, IN(16) + (size_t)l * 256,
                    IN(17) + (size_t)l * 256, gout, WSP(bf16, WS_LWT) + (size_t)l * 2 * 4 * 4096};
            if (G == 256) {
                if (cu < 64)
                    for (int r2 = 0; r2 < REP_SG; ++r2) small_gemm_unit<0>(lds, cu, WSP(bf16, WS_XSB), (const bf16*)(ka->ws + WS_W + (size_t)l * W_LAYER + W_IN), DM, WSP(bf16, WS_ZS), DIN, nullptr, nullptr, nullptr, nullptr, nullptr);
                { const int b = cu >> 7, qb = cu & 127;
                  for (int r2 = 0; r2 < REP_AT; ++r2) attn_prompt_unit(lds, b, qb * 64, WSP(bf16, WS_Z), WSP(bf16, WS_MG), sinks, gout, OUTP(O_CKP) + (size_t)(l * 2 + b) * 16384, OUTP(O_CVP) + (size_t)(l * 2 + b) * 16384);
                  for (int r2 = 0; r2 < REP_LR; ++r2) lru_unit(lds, false, b, qb * 64, WSP(bf16, WS_Z), WSP(bf16, WS_MG), LW, WSP(bf16, WS_HLOC), WSP(bf16, WS_CUMA), WSP(float, WS_AGGA), WSP(float, WS_AGGB),
                             nullptr, nullptr, OUTP(O_LCP) + (size_t)l * 2 * 3 * 256, nullptr); }
                if (cu >= 64) {
                    const int b = cu >> 7, tb = cu & 127;
                    for (int r2 = 0; r2 < REP_SC; ++r2) sconv_unit<8>(false, b, tb * 64, WSP(bf16, WS_Z), WSP(bf16, WS_MG), IN(18) + (size_t)l * 3 * 256, gout, nullptr, OUTP(O_SCP) + (size_t)l * 2 * 2 * 256);
                    if (cu < 192) { const int u = (cu - 64) >> 1, hf = (cu - 64) & 1;
                        sconv_unit<4>(false, 0, u * 64 + 32 * hf, WSP(bf16, WS_Z), WSP(bf16, WS_MG), IN(18) + (size_t)l * 3 * 256, gout, nullptr, OUTP(O_SCP) + (size_t)l * 2 * 2 * 256); }
                }
            } else
            for (int idx0 = cu; idx0 < 64 + 768; idx0 += G) {
                if (idx0 < 64) {
                    for (int r2 = 0; r2 < REP_SG; ++r2) small_gemm_unit<0>(lds, idx0, WSP(bf16, WS_XSB), (const bf16*)(ka->ws + WS_W + (size_t)l * W_LAYER + W_IN), DM, WSP(bf16, WS_ZS), DIN, nullptr, nullptr, nullptr, nullptr, nullptr);
                    continue;
                }
                const int idx = idx0 - 64;
                if (idx < 256) {
                    const int b = idx >> 7, qb = idx & 127;
                    for (int r2 = 0; r2 < REP_AT; ++r2) attn_prompt_unit(lds, b, qb * 64, WSP(bf16, WS_Z), WSP(bf16, WS_MG), sinks, gout, OUTP(O_CKP) + (size_t)(l * 2 + b) * 16384, OUTP(O_CVP) + (size_t)(l * 2 + b) * 16384);
                } else if (idx < 512) {
                    LruW LW{IN(11) + (size_t)l * 4 * 256, IN(12) + (size_t)l * 256, IN(14) + (size_t)l * 256, IN(16) + (size_t)l * 256,
                            IN(17) + (size_t)l * 256, gout, WSP(bf16, WS_LWT) + (size_t)l * 2 * 4 * 4096};
                    const int u = idx - 256, b = u >> 7, chunk = u & 127;
                    for (int r2 = 0; r2 < REP_LR; ++r2) lru_unit(lds, false, b, chunk * 64, WSP(bf16, WS_Z), WSP(bf16, WS_MG), LW, WSP(bf16, WS_HLOC), WSP(bf16, WS_CUMA), WSP(float, WS_AGGA), WSP(float, WS_AGGB),
                             nullptr, nullptr, OUTP(O_LCP) + (size_t)l * 2 * 3 * 256, nullptr);
                } else {
                    const int u = idx - 512, b = u >> 7, tb = u & 127;
                    for (int r2 = 0; r2 < REP_SC; ++r2) sconv_unit<8>(false, b, tb * 64, WSP(bf16, WS_Z), WSP(bf16, WS_MG), IN(18) + (size_t)l * 3 * 256, gout, nullptr, OUTP(O_SCP) + (size_t)l * 2 * 2 * 256);
                }
            }
        }
        xcd_barrier(bar);

        for (int rep_ = 0; rep_ < REP_P3; ++rep_)
        {
            PHASE_VARS
            const float* gout = IN(19) + (size_t)l * DM;
            for (int k = 0; k < 2; ++k) {
                int idx = -1;
                if (G == 256) {
                    if (k == 0) idx = (cu >= 128 && cu < 132) ? 256 + cu : cu;
                    else idx = (cu < 128) ? 256 + cu : ((cu >= 132 && cu < 136) ? cu - 4 : -1);
                    if (idx >= 384) idx = idx;
                }
                for (int i2 = (G == 256 ? idx : cu + k * 100000); i2 >= 0 && i2 < 388; i2 += (G == 256 ? 100000 : G)) {
                    const int id = i2;
                    if (id < 256) {
                        for (int r2 = 0; r2 < REP_LF; ++r2) lru_fix_unit(lds, id >> 7, id & 127, WSP(bf16, WS_Z), WSP(bf16, WS_MG), gout, WSP(bf16, WS_HLOC), WSP(bf16, WS_CUMA),
                                     WSP(float, WS_AGGA), WSP(float, WS_AGGB), OUTP(O_RGP) + (size_t)l * 2 * 256);
                    } else if (id < 384) {
                        const int s = id - 256;
                        for (int r2 = 0; r2 < REP_AS; ++r2) attn_sample_unit(lds, s, WSP(bf16, WS_ZS), WSP(bf16, WS_MGS), IN(10) + l * 8, gout, IN(2) + (size_t)l * NS * 16384, IN(3) + (size_t)l * NS * 16384,
                                         OUTP(O_CKS) + (size_t)l * NS * 16384, OUTP(O_CVS) + (size_t)l * NS * 16384);
                    } else if (id < 386) {
                        LruW LW{IN(11) + (size_t)l * 4 * 256, IN(12) + (size_t)l * 256, IN(14) + (size_t)l * 256, IN(16) + (size_t)l * 256,
                                IN(17) + (size_t)l * 256, gout, WSP(bf16, WS_LWT) + (size_t)l * 2 * 4 * 4096};
                        for (int r2 = 0; r2 < REP_LS; ++r2) lru_unit(lds, true, 0, (id - 384) * 64, WSP(bf16, WS_ZS), WSP(bf16, WS_MGS), LW, nullptr, nullptr, nullptr, nullptr, IN(5) + (size_t)l * NS * 3 * 256, IN(4) + (size_t)l * NS * 256,
                                 OUTP(O_LCS) + (size_t)l * NS * 3 * 256, OUTP(O_RGS) + (size_t)l * NS * 256);
                    } else {
                        sconv_unit<8>(true, 0, (id - 386) * 64, WSP(bf16, WS_ZS), WSP(bf16, WS_MGS), IN(18) + (size_t)l * 3 * 256, gout, IN(6) + (size_t)l * NS * 2 * 256, OUTP(O_SCS) + (size_t)l * NS * 2 * 256);
                    }
                }
                if (G != 256) break;
            }
        }
        xcd_barrier(bar);

        {
            PHASE_VARS
            const bf16* Wout_t = (const bf16*)(ka->ws + WS_W + (size_t)l * W_LAYER + W_OUT);
            if (cu < 32) {
                const float* xs_in = (l == 0) ? IN(1) : WSP(float, WS_XS);
                small_gemm_unit<1>(lds, cu, WSP(bf16, WS_MGS), Wout_t, DM, WSP(bf16, WS_XSB), 0, xs_in, WSP(float, WS_XS), nullptr, nullptr, nullptr);
            }
            pg8::Gemm g{WSP(bf16, WS_MG), Wout_t, MP, DM, DM}; pg8::StaticOrder S; S.init(MP, DM, G, cu);
            EpiRes E{WSP(bf16, WS_X), WSP(float, WS_SSQA), (LAS float*)(lds + 131072), lds, G == 256};
            if (G == 256) pg8::gemm_phase<EpiRes, pg8::StaticOrder, true, true, false, true>(lds, g, S, E);
            else pg8::gemm_phase<EpiRes, pg8::StaticOrder, true, true, false>(lds, g, S, E);
        }
        xcd_barrier(bar);

        for (int rep_ = 0; rep_ < REP_P5; ++rep_)
        {
            PHASE_VARS
            const bf16* Wup_t = (const bf16*)(ka->ws + WS_W + (size_t)l * W_LAYER + W_UP);
            const float* fcw = IN(23) + (size_t)l * 3 * DUP;
            pg8::Gemm g{WSP(bf16, WS_X), Wup_t, 66 * 256, DUP, DM}; pg8::StaticOrder S; S.init(66 * 256, DUP, G, cu);
            EpiFfn E{WSP(bf16, WS_ACT), fcw, OUTP(O_FFP) + (size_t)l * 2 * 2 * DUP, WSP(float, WS_SSQA)};
            pg8::gemm_phase<EpiFfn, pg8::StaticOrder, true, true, true>(lds, g, S, E);
            const int nwg = 66 * 22, rem = nwg % G, n_idle = rem ? G - rem : G, first_idle = G - n_idle;
            if (cu >= first_idle)
                for (int j3 = cu - first_idle; j3 < 59; j3 += n_idle)
                    small_ffn_unit(lds, j3, WSP(bf16, WS_XSB), Wup_t, WSP(bf16, WS_ACTS), fcw, IN(7) + (size_t)l * NS * 2 * DUP, OUTP(O_FFS) + (size_t)l * NS * 2 * DUP);
        }
        xcd_barrier(bar);

        {
            PHASE_VARS
            const bf16* Wdown_t = (const bf16*)(ka->ws + WS_W + (size_t)l * W_LAYER + W_DOWN);
            if (cu < 32)
                small_gemm_unit<1>(lds, cu, WSP(bf16, WS_ACTS), Wdown_t, DFF, WSP(bf16, WS_XSB), 0, WSP(float, WS_XS), WSP(float, WS_XS), nullptr, nullptr, nullptr);
            pg8::Gemm g{WSP(bf16, WS_ACT), Wdown_t, MP, DM, DFF}; pg8::StaticOrder S; S.init(MP, DM, G, cu);
            EpiRes E{WSP(bf16, WS_X), WSP(float, WS_SSQB), (LAS float*)(lds + 131072), lds, G == 256};
            if (G == 256) pg8::gemm_phase<EpiRes, pg8::StaticOrder, true, true, false, true>(lds, g, S, E);
            else pg8::gemm_phase<EpiRes, pg8::StaticOrder, true, true, false>(lds, g, S, E);
        }
        xcd_barrier(bar);
    }
    {
        PHASE_VARS
        const float* gfin = IN(25); const float* XS = WSP(float, WS_XS); float* ys = OUTP(O_YS); float* Y = OUTP(O_Y);
        const bf16* X = WSP(bf16, WS_X); const float* SSQB = WSP(float, WS_SSQB);
        f32x4 gg[4];
#pragma unroll
        for (int j = 0; j < 4; ++j) gg[j] = *(const f32x4*)(gfin + 4 * lane + 256 * j);
        for (int m0 = gw; m0 < MP; m0 += 4 * NGW) {
            u32x2 xr[4][4]; f32x4 sq[4];
#pragma unroll
            for (int r = 0; r < 4; ++r) { const int m = m0 + r * NGW; if (m < MP) { sq[r] = *(const f32x4*)(SSQB + 4 * (size_t)m);
#pragma unroll
                for (int j = 0; j < 4; ++j) xr[r][j] = *(const u32x2*)(X + (size_t)m * DM + 4 * lane + 256 * j); } }
#pragma unroll
            for (int r = 0; r < 4; ++r) { const int m = m0 + r * NGW; if (m < MP) {
                const float rs = rsqrtf(((sq[r].x + sq[r].y) + (sq[r].z + sq[r].w)) * (1.0f / DM) + EPS);
#pragma unroll
                for (int j = 0; j < 4; ++j) { const f32x4 v = (f32x4){bf2f(xr[r][j].x & 0xffffu), bf2f(xr[r][j].x >> 16), bf2f(xr[r][j].y & 0xffffu), bf2f(xr[r][j].y >> 16)};
                    __builtin_nontemporal_store(v * gg[j] * rs, (f32x4*)(Y + (size_t)m * DM + 4 * lane + 256 * j)); } } }
        }
        for (int m = gw; m < NS; m += NGW) rms_row_f32(XS + (size_t)m * DM, gfin, ys + (size_t)m * DM, lane);
    }
}

extern "C" void kernel_launch(void* const* d_in, const int* in_sizes, int n_in, void* d_out, int out_size, void* d_ws, size_t ws_size, hipStream_t stream) {
    static int grid = 0;
    if (grid == 0) {
        if (n_in != 26 || ws_size < WS_END) { fprintf(stderr, "kernel_launch: unexpected n_in %d / ws_size %zu\n", n_in, ws_size); grid = -1; return; }
        int dev = 0, cus = 0, per_cu = 0;
        hipGetDevice(&dev);
        hipDeviceGetAttribute(&cus, hipDeviceAttributeMultiprocessorCount, dev);
        hipFuncSetAttribute((const void*)fwd_megakernel, hipFuncAttributeMaxDynamicSharedMemorySize, LDS_BYTES);
        hipOccupancyMaxActiveBlocksPerMultiprocessor(&per_cu, (const void*)fwd_megakernel, NTHREADS, LDS_BYTES);
        if (per_cu < 1) per_cu = 1;
        (void)hipGetLastError();
        grid = cus;
    }
    if (grid < 0) return;
    if (hipMemsetAsync(d_ws, 0, 65536, stream) != hipSuccess) { fprintf(stderr, "memset failed\n"); return; }
    Args a{};
    for (int i = 0; i < 26; ++i) a.in[i] = (const float*)d_in[i];
    a.out = (float*)d_out; a.ws = (unsigned char*)d_ws;
    void* kargs[] = {&a};
    hipError_t e = hipLaunchCooperativeKernel((const void*)fwd_megakernel, dim3(grid), dim3(NTHREADS), kargs, LDS_BYTES, stream);
    if (e != hipSuccess) fprintf(stderr, "cooperative launch failed: %s (grid %d)\n", hipGetErrorString(e), grid);
}
```
